# Optimizing an MI355X kernel written in HIP

```python
import math
import jax
import jax.numpy as jnp
from jax import lax
import numpy as np

D_MODEL = 4096
BATCH = 4
SEQ = 2048
DEPTH = 2

HG_HEADS = 8
HG_DK = 128
HG_DV = 128
HG_WIDTH = HG_HEADS * HG_DV
HG_CHUNK = 64
POOL_WINDOWS = (2, 4, 8, 16)
POOL_GROUPS = 4
POOL_GROUP_DIM = 256
POOL_WIDTH = POOL_GROUPS * POOL_GROUP_DIM
DA_HEADS = 8
DA_HEAD_DIM = 64
DA_VDIM = 2 * DA_HEAD_DIM
DA_WIDTH = DA_HEADS * DA_VDIM
Q_BLOCK = 128
N_BRANCH = 3
FFN_HIDDEN = -(-8 * D_MODEL // (3 * 256)) * 256
NORM_EPS = 1e-6

IN_SPLITS = (
    HG_HEADS * HG_DK,
    HG_HEADS * HG_DK,
    HG_WIDTH,
    HG_WIDTH,
    POOL_WIDTH,
    DA_HEADS * 2 * DA_HEAD_DIM,
    DA_HEADS * 2 * DA_HEAD_DIM,
    DA_WIDTH,
    N_BRANCH * D_MODEL,
)
IN_COLS = sum(IN_SPLITS)

kernel_name = "hybrid_hgrn2_pool_diffattn_gated_block"


def rms_norm(x, gain):
    xf = x.astype(jnp.float32)
    y = xf * lax.rsqrt(jnp.mean(xf * xf, axis=-1, keepdims=True) + NORM_EPS)
    return (y * gain.astype(jnp.float32)).astype(x.dtype)


def split_columns(proj):
    pieces, start = [], 0
    for size in IN_SPLITS:
        pieces.append(proj[..., start:start + size])
        start += size
    return pieces


def alibi_slopes(n_heads):
    return 2.0 ** (-8.0 * jnp.arange(1, n_heads + 1, dtype=jnp.float32) / n_heads)


def hgrn2_mixer(q, f_raw, v, g, lb, out_gain):
    B, S, _ = q.shape
    nc = S // HG_CHUNK
    f = lb.astype(jnp.float32) + (1.0 - lb.astype(jnp.float32)) * jax.nn.sigmoid(f_raw.astype(jnp.float32))
    log_f = jnp.log(f)
    k = 1.0 - f

    def to_chunks(t, d):
        return t.astype(jnp.float32).reshape(B, nc, HG_CHUNK, HG_HEADS, d).transpose(1, 0, 3, 2, 4)

    qc = to_chunks(q, HG_DK) * (HG_DK ** -0.5)
    kc = to_chunks(k, HG_DK)
    gc = to_chunks(log_f, HG_DK)
    vc = to_chunks(v, HG_DV)
    causal = jnp.tril(jnp.ones((HG_CHUNK, HG_CHUNK), dtype=bool))

    def chunk_step(state, inp):
        qb, kb, vb, gb = inp
        b = jnp.cumsum(gb, axis=2)
        o_inter = jnp.einsum('bhtk,bhkv->bhtv', qb * jnp.exp(b), state)
        diff = b[:, :, :, None, :] - b[:, :, None, :, :]
        decay = jnp.exp(jnp.where(causal[:, :, None], diff, -jnp.inf))
        scores = jnp.sum(qb[:, :, :, None, :] * kb[:, :, None, :, :] * decay, axis=-1)
        o_intra = jnp.einsum('bhts,bhsv->bhtv', scores, vb)
        b_last = b[:, :, -1:, :]
        new_state = jnp.exp(b_last[:, :, 0, :])[..., None] * state + jnp.einsum(
            'bhsk,bhsv->bhkv', kb * jnp.exp(b_last - b), vb)
        return new_state, o_inter + o_intra

    state0 = jnp.zeros((B, HG_HEADS, HG_DK, HG_DV), jnp.float32)
    _, o = lax.scan(chunk_step, state0, (qc, kc, vc, gc))
    o = o.transpose(1, 0, 3, 2, 4).reshape(B, S, HG_HEADS, HG_DV)
    o = o * lax.rsqrt(jnp.mean(o * o, axis=-1, keepdims=True) + NORM_EPS)
    o = o.reshape(B, S, HG_WIDTH) * out_gain.astype(jnp.float32)
    return (o * jax.nn.silu(g.astype(jnp.float32))).astype(q.dtype)


def pool_mixer(u, w_groups, scale):
    B, S, _ = u.shape
    uf = u.astype(jnp.float32).reshape(B, S, POOL_GROUPS, POOL_GROUP_DIM)
    cs = jnp.concatenate([jnp.zeros((B, 1, POOL_GROUPS, POOL_GROUP_DIM), jnp.float32),
                          jnp.cumsum(uf, axis=1)], axis=1)
    t = jnp.arange(S)
    outs = []
    for j, w in enumerate(POOL_WINDOWS):
        start = jnp.maximum(t + 1 - w, 0)
        win_sum = cs[:, t + 1, j] - cs[:, start, j]
        count = (t + 1 - start).astype(jnp.float32)[None, :, None]
        outs.append(win_sum / count - uf[:, :, j])
    pooled = jnp.stack(outs, axis=2)
    mixed = jnp.einsum('bsgc,gcd->bsgd', pooled, w_groups.astype(jnp.float32))
    return (mixed.reshape(B, S, POOL_WIDTH) * scale.astype(jnp.float32)).astype(u.dtype)


def diff_attention(q, k, v, lam_params, subln_gain, lambda_init):
    B, S, _ = q.shape
    nb = S // Q_BLOCK
    qf = q.astype(jnp.float32).reshape(B, S, DA_HEADS, 2, DA_HEAD_DIM) * (DA_HEAD_DIM ** -0.5)
    kf = k.astype(jnp.float32).reshape(B, S, DA_HEADS, 2, DA_HEAD_DIM)
    vf = v.astype(jnp.float32).reshape(B, S, DA_HEADS, DA_VDIM)
    lp = lam_params.astype(jnp.float32)
    lam = jnp.exp(jnp.sum(lp[0] * lp[1])) - jnp.exp(jnp.sum(lp[2] * lp[3])) + lambda_init
    slopes = alibi_slopes(DA_HEADS)
    key_pos = jnp.arange(S)
    q_blocks = qf.reshape(B, nb, Q_BLOCK, DA_HEADS, 2, DA_HEAD_DIM).transpose(1, 0, 2, 3, 4, 5)

    def one_block(args):
        q_blk, blk = args
        q_pos = blk * Q_BLOCK + jnp.arange(Q_BLOCK)
        dist = (q_pos[:, None] - key_pos[None, :]).astype(jnp.float32)
        bias = -slopes[:, None, None] * dist
        s = jnp.einsum('bqhmd,bkhmd->bhmqk', q_blk, kf) + bias[None, :, None]
        s = jnp.where(dist >= 0, s, -jnp.inf)
        p = jax.nn.softmax(s, axis=-1)
        a = p[:, :, 0] - lam * p[:, :, 1]
        return jnp.einsum('bhqk,bkhv->bqhv', a, vf)

    o = lax.map(one_block, (q_blocks, jnp.arange(nb)))
    o = o.transpose(1, 0, 2, 3, 4).reshape(B, S, DA_HEADS, DA_VDIM)
    o = o * lax.rsqrt(jnp.mean(o * o, axis=-1, keepdims=True) + NORM_EPS) * subln_gain.astype(jnp.float32)
    o = o * (1.0 - lambda_init)
    return o.reshape(B, S, DA_WIDTH).astype(q.dtype)


def setup_inputs(seed: int = 0) -> dict:
    key = jax.random.key(seed)
    ks = jax.random.split(key, 20)
    L, D, F = DEPTH, D_MODEL, FFN_HIDDEN

    def nrm(k, shape, scale):
        return jax.random.normal(k, shape, jnp.float32) * scale

    def gain(k, shape):
        return 1.0 + 0.02 * jax.random.normal(k, shape, jnp.float32)

    return {
        "x": nrm(ks[0], (BATCH, SEQ, D), 1.0),
        "norm_mix_pre": gain(ks[1], (L, D)),
        "norm_mix_post": gain(ks[2], (L, D)),
        "norm_ffn_pre": gain(ks[3], (L, D)),
        "norm_ffn_post": gain(ks[4], (L, D)),
        "w_in": nrm(ks[5], (L, D, IN_COLS), D ** -0.5),
        "hgrn_lb_logits": nrm(ks[6], (L, HG_HEADS * HG_DK), 0.5),
        "hgrn_out_norm": gain(ks[7], (L, HG_WIDTH)),
        "pool_w": nrm(ks[8], (L, POOL_GROUPS, POOL_GROUP_DIM, POOL_GROUP_DIM), POOL_GROUP_DIM ** -0.5),
        "pool_scale": gain(ks[9], (L, POOL_WIDTH)),
        "diff_lambda": nrm(ks[10], (L, 4, DA_HEAD_DIM), 0.1),
        "diff_subln": gain(ks[11], (L, DA_VDIM)),
        "w_up_a": nrm(ks[12], (L, HG_WIDTH, D), HG_WIDTH ** -0.5),
        "w_up_b": nrm(ks[13], (L, POOL_WIDTH, D), POOL_WIDTH ** -0.5),
        "w_up_c": nrm(ks[14], (L, DA_WIDTH, D), DA_WIDTH ** -0.5),
        "w_out": nrm(ks[15], (L, D, D), D ** -0.5),
        "w_ffn_gate": nrm(ks[16], (L, D, F), D ** -0.5),
        "w_ffn_up": nrm(ks[17], (L, D, F), D ** -0.5),
        "w_ffn_down": nrm(ks[18], (L, F, D), F ** -0.5),
    }


def reference(x, norm_mix_pre, norm_mix_post, norm_ffn_pre, norm_ffn_post, w_in,
              hgrn_lb_logits, hgrn_out_norm, pool_w, pool_scale, diff_lambda, diff_subln,
              w_up_a, w_up_b, w_up_c, w_out, w_ffn_gate, w_ffn_up, w_ffn_down):
    B, S, D = x.shape
    lb_all = jnp.cumsum(jax.nn.softmax(hgrn_lb_logits.astype(jnp.float32), axis=0), axis=0)
    lb_all = lb_all - lb_all[0:1]
    for l in range(DEPTH):
        lambda_init = 0.8 - 0.6 * math.exp(-0.3 * l)
        h = rms_norm(x, norm_mix_pre[l])
        proj = h @ w_in[l]
        hq, hf, hv, hg, pu, dq, dk, dv, gate_logits = split_columns(proj)
        y_a = hgrn2_mixer(hq, hf, hv, hg, lb_all[l], hgrn_out_norm[l])
        y_b = pool_mixer(pu, pool_w[l], pool_scale[l])
        y_c = diff_attention(dq, dk, dv, diff_lambda[l], diff_subln[l], lambda_init)
        gates = jax.nn.sigmoid(gate_logits.astype(jnp.float32)).reshape(B, S, N_BRANCH, D)
        merged = (gates[:, :, 0] * (y_a @ w_up_a[l])
                  + gates[:, :, 1] * (y_b @ w_up_b[l])
                  + gates[:, :, 2] * (y_c @ w_up_c[l])).astype(x.dtype)
        x = x + rms_norm(merged @ w_out[l], norm_mix_post[l])
        h = rms_norm(x, norm_ffn_pre[l])
        ff = (jax.nn.silu(h @ w_ffn_gate[l]) * (h @ w_ffn_up[l])) @ w_ffn_down[l]
        x = x + rms_norm(ff, norm_ffn_post[l])
    return x
```

```cpp
#include <hip/hip_runtime.h>
#include <hip/hip_bf16.h>
#include <cstdio>
#include <cstdint>
#include <cmath>

namespace pg8 {
#define PG8_LAS __attribute__((address_space(3)))
typedef unsigned short bf16_t;
typedef short bf16x8 __attribute__((ext_vector_type(8)));
typedef float f32x4 __attribute__((ext_vector_type(4)));
typedef float f32x2 __attribute__((ext_vector_type(2)));
typedef unsigned u32x4 __attribute__((ext_vector_type(4)));
typedef unsigned u32x2 __attribute__((ext_vector_type(2)));
constexpr int BM = 256, BK = 64, HALF = 128, HTB = HALF * BK * 2  , STAGE_BYTES = 8 * HTB, NXCD = 8, WGM = 8;

__host__ __device__ __forceinline__ int lds_byte(int r, int c) { const int st = (r >> 4) * 2 + (c >> 5), rr = r & 15, cc = c & 31, ob = rr * 64 + cc * 2; return st * 1024 + (ob ^ (((ob >> 9) & 1) << 5)); }
__host__ __device__ __forceinline__ void stage_rc(int b, int& R, int& C) { const int st = b / 1024, sb = b % 1024, swz = sb ^ (((sb >> 9) & 1) << 5); R = (st >> 1) * 16 + swz / 64; C = (st & 1) * 32 + (swz % 64) / 2; }
__host__ __device__ __forceinline__ int perm32(int rho) { const int n = rho >> 4, i = rho & 15; return 8 * (i >> 2) + 4 * n + (i & 3); }

struct Unit { int pm, pn, kind; const char* a; const char* b; };

struct TileOrder {
    int nM, nN, nwg, G, c;
    __device__ __forceinline__ void init(int nM_, int nN_, int G_, int c_) { nM = nM_; nN = nN_; nwg = nM * nN; G = G_; c = c_; }
    __device__ __forceinline__ bool tile(int i, int& pm, int& pn) const {
        const long L = (long)i * G + c; if (L >= nwg) return false;
        int wgid = (int)L; { const int q = nwg / NXCD, r = nwg % NXCD, xcd = wgid % NXCD, off = wgid / NXCD; wgid = (xcd < r ? xcd * (q + 1) : r * (q + 1) + (xcd - r) * q) + off; }
        const int nig = WGM * nN, gid = wgid / nig, fm = gid * WGM, gsz = (nM - fm) < WGM ? (nM - fm) : WGM;
        pm = fm + ((wgid % nig) % gsz); pn = (wgid % nig) / gsz; return true;
    }
};

__device__ __forceinline__ unsigned cvt_pk_bf16(float lo, float hi) { unsigned r; asm volatile("v_cvt_pk_bf16_f32 %0, %1, %2" : "=v"(r) : "v"(lo), "v"(hi)); return r; }
__device__ __forceinline__ float bf_lo(unsigned w) { return __uint_as_float(w << 16); }
__device__ __forceinline__ float bf_hi(unsigned w) { return __uint_as_float(w & 0xffff0000u); }
__device__ __forceinline__ float fast_exp(float x) { return __builtin_amdgcn_exp2f(x * 1.4426950408889634f); }
__device__ __forceinline__ float fast_rcp(float x) { return __builtin_amdgcn_rcpf(x); }


template <class Epi, class Sched, bool ALIGN_EPI = false, bool SP2 = false>
__device__ __forceinline__ void gemm_phase(PG8_LAS unsigned char* lds, const int K, const int lda, const int ldb, const Sched& S, const Epi& E) {
    int tid = threadIdx.x; asm volatile("" : "+v"(tid));
    const int wid = __builtin_amdgcn_readfirstlane(tid >> 6), lane = tid & 63, wr = wid >> 2, wc = wid & 3, fr = lane & 15, fq = lane >> 4;
    int nt = K / BK; asm volatile("" : "+s"(nt));
    unsigned voffA[2], voffB[2];
#pragma unroll
    for (int i = 0; i < 2; ++i) { int R, C; stage_rc(tid * 16 + i * 8192, R, C); const int Rb = Epi::PERM ? ((R & ~31) + perm32(R & 31)) : R;
        voffA[i] = (unsigned)(R * lda + C) * 2u; voffB[i] = (unsigned)(Rb * ldb + C) * 2u; }
    const size_t kstep = (size_t)(BK * 2);
    const size_t hsA = (size_t)HALF * lda * 2, hsB = (size_t)HALF * ldb * 2;
    const unsigned ldsw = (unsigned)wid * 1024u;
    const int aoff = lds_byte(wr * 64 + fr, fq * 8), boff = lds_byte(wc * 32 + fr, fq * 8);
#define PG8_SA(b, h) (((b) * 2 + (h)) * HTB)
#define PG8_SB(b, h) ((4 + (b) * 2 + (h)) * HTB)
#define PG8_STAGE(bufoff, gbase, voff) do { _Pragma("unroll") for (int _i = 0; _i < 2; ++_i) \
        __builtin_amdgcn_global_load_lds((const unsigned*)((const char*)(gbase) + (voff)[_i]), (PG8_LAS unsigned*)(lds + (bufoff) + ldsw + _i * 8192), 16, 0, 0); } while (0)
#define PG8_LDA(dst, b, h) do { _Pragma("unroll") for (int m = 0; m < 4; ++m) _Pragma("unroll") for (int k = 0; k < 2; ++k) dst[m][k] = *(const PG8_LAS bf16x8*)(lds + PG8_SA(b, h) + aoff + m * 2048 + k * 1024); } while (0)
#define PG8_LDB(dst, b, h) do { _Pragma("unroll") for (int n = 0; n < 2; ++n) _Pragma("unroll") for (int k = 0; k < 2; ++k) dst[n][k] = *(const PG8_LAS bf16x8*)(lds + PG8_SB(b, h) + boff + n * 2048 + k * 1024); } while (0)
#define PG8_MMA(ai, bj, At, Bt) do { __builtin_amdgcn_s_setprio(1); _Pragma("unroll") for (int m = 0; m < 4; ++m) _Pragma("unroll") for (int n = 0; n < 2; ++n) _Pragma("unroll") for (int k = 0; k < 2; ++k) \
        acc[ai][bj][m][n] = __builtin_amdgcn_mfma_f32_16x16x32_bf16(Bt[n][k], At[m][k], acc[ai][bj][m][n], 0, 0, 0); __builtin_amdgcn_s_setprio(0); } while (0)
#define PG8_WAIT_V(n) asm volatile("s_waitcnt vmcnt(" #n ")" ::: "memory")
#define PG8_WAIT_L(n) asm volatile("s_waitcnt lgkmcnt(" #n ")" ::: "memory")
#define PG8_BAR __builtin_amdgcn_s_barrier()
#define PG8_SCHED __builtin_amdgcn_sched_barrier(0)
    Unit cur, nxt; int ui = 0;
    if (!S.next(0, cur)) return;
    f32x4 acc[2][2][4][2];
#pragma unroll
    for (int a = 0; a < 2; ++a)
#pragma unroll
        for (int b = 0; b < 2; ++b)
#pragma unroll
            for (int m = 0; m < 4; ++m)
#pragma unroll
                for (int n = 0; n < 2; ++n) acc[a][b][m][n] = (f32x4){0.f, 0.f, 0.f, 0.f};
    bf16x8 At[4][2], B0[2][2], B1[2][2];
    const char* cA = cur.a; const char* cB = cur.b;
    if constexpr (SP2) {
        PG8_STAGE(PG8_SB(0, 0), cB, voffB); PG8_STAGE(PG8_SB(0, 1), cB + hsB, voffB); PG8_STAGE(PG8_SA(0, 0), cA, voffA); PG8_STAGE(PG8_SA(0, 1), cA + hsA, voffA);
        if (wr == 1) PG8_BAR;
        PG8_WAIT_V(2); PG8_BAR;
        PG8_STAGE(PG8_SB(1, 0), cB + kstep, voffB); PG8_STAGE(PG8_SA(1, 0), cA + kstep, voffA); PG8_STAGE(PG8_SB(1, 1), cB + hsB + kstep, voffB);
        PG8_WAIT_V(6); PG8_BAR;
    } else {
        PG8_STAGE(PG8_SB(0, 0), cB, voffB); PG8_STAGE(PG8_SA(0, 0), cA, voffA); PG8_STAGE(PG8_SB(0, 1), cB + hsB, voffB); PG8_STAGE(PG8_SA(0, 1), cA + hsA, voffA);
        if (wr == 1) PG8_BAR;
        PG8_WAIT_V(4); PG8_BAR;
        PG8_STAGE(PG8_SB(1, 0), cB + kstep, voffB); PG8_STAGE(PG8_SA(1, 0), cA + kstep, voffA); PG8_STAGE(PG8_SB(1, 1), cB + hsB + kstep, voffB);
        PG8_WAIT_V(6); PG8_BAR;
    }
    for (;;) {
        const bool has_next = S.next(ui + 1, nxt);
        const char* nA = has_next ? nxt.a : cA; const char* nB = has_next ? nxt.b : cB;
        for (int t = 0; t < nt; t += 2) {
            const bool last = (t == nt - 2);
            const char* a1 = cA + (size_t)(t + 1) * kstep;
            const char* a2 = last ? nA : cA + (size_t)(t + 2) * kstep; const char* b2 = last ? nB : cB + (size_t)(t + 2) * kstep;
            const char* a3 = a2 + kstep; const char* b3 = b2 + kstep;
            if constexpr (SP2) {
            PG8_LDB(B0, 0, 0); PG8_LDB(B1, 0, 1); PG8_SCHED; PG8_LDA(At, 0, 0); PG8_STAGE(PG8_SA(1, 1), a1 + hsA, voffA);
            PG8_WAIT_V(8); PG8_WAIT_L(0); PG8_BAR; PG8_MMA(0, 0, At, B0); PG8_MMA(0, 1, At, B1); PG8_BAR; PG8_SCHED;
            PG8_LDA(At, 0, 1); PG8_STAGE(PG8_SB(0, 0), b2, voffB); PG8_STAGE(PG8_SB(0, 1), b2 + hsB, voffB); PG8_STAGE(PG8_SA(0, 0), a2, voffA);
            PG8_WAIT_V(8); PG8_WAIT_L(0); PG8_BAR; PG8_MMA(1, 0, At, B0); PG8_MMA(1, 1, At, B1); PG8_BAR; PG8_SCHED;
            PG8_LDB(B0, 1, 0); PG8_LDB(B1, 1, 1); PG8_SCHED; PG8_LDA(At, 1, 0); PG8_STAGE(PG8_SA(0, 1), a2 + hsA, voffA);
            PG8_WAIT_V(8); PG8_WAIT_L(0); PG8_BAR; PG8_MMA(0, 0, At, B0); PG8_MMA(0, 1, At, B1); PG8_BAR; PG8_SCHED;
            PG8_LDA(At, 1, 1); PG8_STAGE(PG8_SB(1, 0), b3, voffB); PG8_STAGE(PG8_SB(1, 1), b3 + hsB, voffB); PG8_STAGE(PG8_SA(1, 0), a3, voffA);
            PG8_WAIT_V(8); PG8_WAIT_L(0); PG8_BAR; PG8_MMA(1, 0, At, B0); PG8_MMA(1, 1, At, B1); PG8_BAR; PG8_SCHED;
            } else {
            PG8_LDB(B0, 0, 0); PG8_SCHED; PG8_LDA(At, 0, 0); PG8_STAGE(PG8_SA(1, 1), a1 + hsA, voffA);
            PG8_WAIT_L(8); PG8_BAR; PG8_WAIT_L(0); PG8_MMA(0, 0, At, B0); PG8_BAR; PG8_SCHED;
            PG8_LDB(B1, 0, 1); PG8_STAGE(PG8_SB(0, 0), b2, voffB);
            PG8_BAR; PG8_WAIT_L(0); PG8_MMA(0, 1, At, B1); PG8_BAR;
            PG8_LDA(At, 0, 1); PG8_STAGE(PG8_SA(0, 0), a2, voffA);
            PG8_BAR; PG8_WAIT_L(0); PG8_MMA(1, 0, At, B0); PG8_BAR; PG8_SCHED;
            PG8_STAGE(PG8_SB(0, 1), b2 + hsB, voffB);
            PG8_WAIT_V(6); PG8_BAR; PG8_MMA(1, 1, At, B1); PG8_BAR;
            PG8_LDB(B0, 1, 0); PG8_SCHED; PG8_LDA(At, 1, 0); PG8_STAGE(PG8_SA(0, 1), a2 + hsA, voffA);
            PG8_WAIT_L(8); PG8_BAR; PG8_WAIT_L(0); PG8_MMA(0, 0, At, B0); PG8_BAR; PG8_SCHED;
            PG8_LDB(B1, 1, 1); PG8_STAGE(PG8_SB(1, 0), b3, voffB);
            PG8_BAR; PG8_WAIT_L(0); PG8_MMA(0, 1, At, B1); PG8_BAR;
            PG8_LDA(At, 1, 1); PG8_STAGE(PG8_SA(1, 0), a3, voffA);
            PG8_BAR; PG8_WAIT_L(0); PG8_MMA(1, 0, At, B0); PG8_BAR; PG8_SCHED;
            PG8_STAGE(PG8_SB(1, 1), b3 + hsB, voffB);
            PG8_WAIT_V(6); PG8_BAR; PG8_MMA(1, 1, At, B1); PG8_BAR;
            }
        }
        if constexpr (ALIGN_EPI) { if (wr == 0) PG8_BAR; }
        E(acc, cur, wr, wc, fr, fq);
        if (!has_next) break;
        if (!E.keep(cur)) {
#pragma unroll
        for (int a = 0; a < 2; ++a)
#pragma unroll
            for (int b = 0; b < 2; ++b)
#pragma unroll
                for (int m = 0; m < 4; ++m)
#pragma unroll
                    for (int n = 0; n < 2; ++n) acc[a][b][m][n] = (f32x4){0.f, 0.f, 0.f, 0.f};
        }
        cur = nxt; cA = nA; cB = nB; ++ui;
        if constexpr (ALIGN_EPI) { if (wr == 1) PG8_BAR; }
    }
    PG8_WAIT_V(0);
    if constexpr (!ALIGN_EPI) { if (wr == 0) PG8_BAR; }
    PG8_BAR;
#undef PG8_SA
#undef PG8_SB
#undef PG8_STAGE
#undef PG8_LDA
#undef PG8_LDB
#undef PG8_MMA
#undef PG8_WAIT_V
#undef PG8_WAIT_L
#undef PG8_BAR
#undef PG8_SCHED
}
}

namespace attn_body {
using bf16=__hip_bfloat16;
using bf16x8=__attribute__((ext_vector_type(8)))short;
using s16x4=__attribute__((ext_vector_type(4)))short;
using f32x16=__attribute__((ext_vector_type(16)))float;
using u32x4=__attribute__((ext_vector_type(4)))unsigned;
constexpr int SEQ=2048,D=64,NVH=32;
constexpr int PQ=20480,PO=2048;
constexpr int NW=8,QBLK=32,QB=QBLK*NW,KVBLK=64,NQB=SEQ/QB;
constexpr int ATTN_UNIT_ROWS=QB;
__device__ __forceinline__ int crow(int r,int hi){return (r&3)+8*(r>>2)+4*hi;}
#define SBAR() __builtin_amdgcn_sched_barrier(0)
__device__ __forceinline__ void cmask(f32x16&p0,f32x16&p1,int jb,int qrel,int hi){
  const float NEG=-INFINITY; int d=qrel-64*jb-4*hi; asm volatile("":"+v"(d));
  #pragma unroll
  for(int r=0;r<16;++r){const int c=(r&3)+8*(r>>2); if(c>d)p0[r]=NEG; if(c+32>d)p1[r]=NEG;}
}

constexpr int NSLOT=3, SLOTB=8192;
constexpr int LDS_K=0, LDS_V=NSLOT*SLOTB, LDS_WS=2*NSLOT*SLOTB, LDS_OST=LDS_WS+NW*64*4, LDS_BYTES=LDS_OST+NW*4096;
constexpr float C2=0.125f*1.4426950408889634f;
__device__ __forceinline__ void glds16(const void*gsrc,unsigned lds_dst){unsigned keep;
  asm volatile("s_mov_b32 %0, m0\n\ts_mov_b32 m0, %2\n\ts_nop 0\n\tglobal_load_lds_dwordx4 %1, off\n\ts_mov_b32 m0, %0":"=&s"(keep):"v"(gsrc),"s"(lds_dst):"memory");}
__device__ __forceinline__ float max3f(float a,float b,float c){float r;asm("v_max3_f32 %0, %1, %2, %3":"=v"(r):"v"(a),"v"(b),"v"(c));return r;}
__device__ __forceinline__ float max2f(float a,float b){float r;asm("v_max_f32_e32 %0, %1, %2":"=v"(r):"v"(a),"v"(b));return r;}
__device__ __forceinline__ float fadd_s(float a,float b){float r;asm("v_add_f32_e32 %0, %1, %2":"=v"(r):"v"(a),"v"(b));return r;}
__device__ __forceinline__ float fsub_s(float a,float b){float r;asm("v_sub_f32_e32 %0, %1, %2":"=v"(r):"v"(a),"v"(b));return r;}
typedef float f32x2_t __attribute__((ext_vector_type(2))); typedef __bf16 bf16x2_t __attribute__((ext_vector_type(2)));
__device__ __forceinline__ unsigned cvtpk_s(float lo,float hi){f32x2_t v={lo,hi};bf16x2_t b=__builtin_convertvector(v,bf16x2_t);return __builtin_bit_cast(unsigned,b);}
#define WAIT_BAR(N) asm volatile("s_waitcnt vmcnt(" #N ") lgkmcnt(0)\n\ts_barrier":::"memory")

__device__ __forceinline__ void qkt(f32x16&p0,f32x16&p1,const char*Kslot,const bf16x8*qr,const f32x16&negm,int r32,int hi){
  const char*kb=Kslot+hi*1024+r32*16;
  #pragma unroll
  for(int d0=0;d0<4;++d0){
    const bf16x8 b0=*reinterpret_cast<const bf16x8*>(kb+d0*2048);
    const bf16x8 b1=*reinterpret_cast<const bf16x8*>(kb+d0*2048+512);
    if(d0==0){p0=__builtin_amdgcn_mfma_f32_32x32x16_bf16(b0,qr[0],negm,0,0,0);p1=__builtin_amdgcn_mfma_f32_32x32x16_bf16(b1,qr[0],negm,0,0,0);}
    else{p0=__builtin_amdgcn_mfma_f32_32x32x16_bf16(b0,qr[d0],p0,0,0,0);p1=__builtin_amdgcn_mfma_f32_32x32x16_bf16(b1,qr[d0],p1,0,0,0);}}
}
typedef __attribute__((address_space(3))) const char* lds_cptr;
typedef short v4i16_t __attribute__((ext_vector_type(4)));
__device__ __forceinline__ void kload8(bf16x8*kf,lds_cptr kp){
  kf[0]=*(const __attribute__((address_space(3))) bf16x8*)(kp);      kf[1]=*(const __attribute__((address_space(3))) bf16x8*)(kp+512);
  kf[2]=*(const __attribute__((address_space(3))) bf16x8*)(kp+2048); kf[3]=*(const __attribute__((address_space(3))) bf16x8*)(kp+2560);
  kf[4]=*(const __attribute__((address_space(3))) bf16x8*)(kp+4096); kf[5]=*(const __attribute__((address_space(3))) bf16x8*)(kp+4608);
  kf[6]=*(const __attribute__((address_space(3))) bf16x8*)(kp+6144); kf[7]=*(const __attribute__((address_space(3))) bf16x8*)(kp+6656);
}
__device__ __forceinline__ void kload2(bf16x8*kf,lds_cptr kp,int j){ kf[2*j]=*(const __attribute__((address_space(3))) bf16x8*)(kp+j*2048); kf[2*j+1]=*(const __attribute__((address_space(3))) bf16x8*)(kp+j*2048+512); }
__device__ __forceinline__ s16x4 vtr(lds_cptr p){ return __builtin_bit_cast(s16x4,__builtin_amdgcn_ds_read_tr16_b64_v4i16((__attribute__((address_space(3))) v4i16_t*)p)); }
__device__ __forceinline__ float rowmax(const f32x16&p0,const f32x16&p1){
  float a=max3f(p0[0],p0[1],p1[0]),b=max3f(p0[2],p0[3],p1[1]);a=max3f(a,p1[2],p1[3]);
  #pragma unroll
  for(int r=4;r<16;r+=4){a=max3f(a,p0[r],p0[r+1]);b=max3f(b,p0[r+2],p0[r+3]);a=max3f(a,p1[r],p1[r+1]);b=max3f(b,p1[r+2],p1[r+3]);}
  const float m=max2f(a,b);
  auto rr=__builtin_amdgcn_permlane32_swap(__float_as_uint(m),__float_as_uint(m),false,false);
  return max2f(__uint_as_float(rr[0]),__uint_as_float(rr[1]));
}
__device__ __forceinline__ void pv(f32x16*o,int vb,bf16x8 pa0,bf16x8 pa1,bf16x8 pa2,bf16x8 pa3){
  #pragma unroll
  for(int d0=0;d0<2;++d0){s16x4 lo[4],hi[4];
    #pragma unroll
    for(int ks=0;ks<4;++ks){
      asm volatile("ds_read_b64_tr_b16 %0,%1 offset:%c2":"=&v"(lo[ks]):"v"(vb),"i"(d0*4096+ks*1024):"memory");
      asm volatile("ds_read_b64_tr_b16 %0,%1 offset:%c2":"=&v"(hi[ks]):"v"(vb),"i"(d0*4096+ks*1024+512):"memory");}
    asm volatile("s_waitcnt lgkmcnt(0)":::"memory");SBAR();
    #define PK(k) (bf16x8){lo[k][0],lo[k][1],lo[k][2],lo[k][3],hi[k][0],hi[k][1],hi[k][2],hi[k][3]}
    o[d0]=__builtin_amdgcn_mfma_f32_32x32x16_bf16(pa0,PK(0),o[d0],0,0,0);
    o[d0]=__builtin_amdgcn_mfma_f32_32x32x16_bf16(pa1,PK(1),o[d0],0,0,0);
    o[d0]=__builtin_amdgcn_mfma_f32_32x32x16_bf16(pa2,PK(2),o[d0],0,0,0);
    o[d0]=__builtin_amdgcn_mfma_f32_32x32x16_bf16(pa3,PK(3),o[d0],0,0,0);
    #undef PK
  }
}

#ifndef ATTN_STORE16
#define ATTN_STORE16(p,v) (*(u32x4*)(p)=(v))
#endif
template<int THRL> __device__ __forceinline__ void attn_unit(int b,int vh,int qb,const bf16*Q,const bf16*__restrict__ K,const bf16*__restrict__ V,bf16*O,char*shm){
  const int hh=vh>>2, qkh=vh>>1, vhh=2*hh+(vh&1);
  const float sig=__builtin_ldexpf(1.4426950408889634f,-(hh+1));
  int tid=threadIdx.x; asm volatile("":"+v"(tid)); const int lane=tid&63,r32=lane&31,hi=lane>>5; const int wid=__builtin_amdgcn_readfirstlane(tid>>6);
  const long rowbase=(long)b*SEQ; const int q0=qb*QB;
  const bf16*Qw=Q+(rowbase+q0+wid*QBLK)*PQ+qkh*D;
  const bf16*Kh=K+rowbase*PQ+qkh*D,*Vh=V+rowbase*PQ+vhh*D;
  const unsigned lds0=(unsigned)(uintptr_t)shm;
  float*wsf=(float*)(shm+LDS_WS)+wid*64;
  const bf16*ksrc=Kh+(long)lane*PQ+wid*8;
  const bf16*vsrc=Vh+(long)(16*(wid&3)+(lane>>2))*PQ+(wid>>2)*32+(lane&3)*8;
  const unsigned kdst=lds0+LDS_K+wid*1024, vdst=lds0+LDS_V+wid*1024;
  #define DMA_K(t,slot) glds16(ksrc+(long)(t)*KVBLK*PQ,(unsigned)__builtin_amdgcn_readfirstlane(kdst+(slot)))
  #define DMA_V(t,slot) glds16(vsrc+(long)(t)*KVBLK*PQ,(unsigned)__builtin_amdgcn_readfirstlane(vdst+(slot)))
  const int vb0=(int)(lds0+LDS_V)+((lane>>4)&1)*32+(lane&3)*8+(4*hi+((lane&15)>>2))*64;
  const char*Kbase=shm+LDS_K; bf16x8 kf[8];
  const lds_cptr shm3=(lds_cptr)shm; const lds_cptr kp0=shm3+LDS_K+hi*1024+r32*16; const lds_cptr vp0=shm3+LDS_V+((lane>>4)&1)*32+(lane&3)*8+(4*hi+((lane&15)>>2))*64;
  const int NT=(q0+QB)/KVBLK;
  DMA_K(0,0);DMA_V(0,0);DMA_K(1,SLOTB);
  bf16x8 qr[4];
  #pragma unroll
  for(int d0=0;d0<4;++d0)qr[d0]=*reinterpret_cast<const bf16x8*>(&Qw[(long)r32*PQ+d0*16+hi*8]);
  float mhat=0.f,l_reg=0.f;f32x16 o[2];o[0]=f32x16{};o[1]=f32x16{};const f32x16 zero16=f32x16{};
  const int qrel=wid*QBLK+r32;
  const float sig64=sig*64.f, chi=sig*(float)(4*hi);
  float sa[16];
  #pragma unroll
  for(int r=0;r<16;++r) sa[r]=__uint_as_float(__builtin_amdgcn_readfirstlane(__float_as_uint(sig*(float)((r&3)+8*(r>>2)))));
  const float sig32=sig*32.f;
  #define ABIAS(P0,P1,t) do{ const float nb0_=fmaf(sig64,(float)((t)-NT),chi)-mhat, nb1_=nb0_+sig32; _Pragma("unroll") for(int r=0;r<16;++r){P0[r]=(P0[r]+sa[r])+nb0_;P1[r]=(P1[r]+sa[r])+nb1_;} }while(0)
  #define CMASK(P0,P1,t) do{int jb_=(t)-(NT-4); if(jb_>=0)cmask(P0,P1,jb_,qrel,hi);}while(0)
  bool resc=false;
  #define START(P0,P1) do{ const float rm=rowmax(P0,P1); resc=false; \
    { const float dl=rm; mhat=fadd_s(mhat,dl); \
      _Pragma("unroll") for(int r=0;r<16;++r){P0[r]=fsub_s(P0[r],dl);P1[r]=fsub_s(P1[r],dl);} } \
    _Pragma("unroll") for(int r=0;r<16;++r)P0[r]=__builtin_amdgcn_exp2f(P0[r]); }while(0)
  #define RESC() do{ if(resc){ asm volatile("s_waitcnt lgkmcnt(0)":::"memory"); \
      _Pragma("unroll") for(int d_=0;d_<2;++d_) _Pragma("unroll") for(int r=0;r<16;++r)o[d_][r]*=wsf[crow(r,hi)]; } }while(0)
  f32x16 pA0,pA1,pB0,pB1;
  int sl_prev=0,sl_cur=0,sl_next=SLOTB;
  #define ROT() do{sl_prev=sl_cur;sl_cur=sl_next;sl_next=(sl_next==(NSLOT-1)*SLOTB)?0:sl_next+SLOTB;}while(0)
  DMA_K(2,2*SLOTB);
  WAIT_BAR(3);
  qkt(pA0,pA1,Kbase,qr,zero16,r32,hi);asm volatile("s_nop 15\n\ts_nop 7":"+v"(pA0),"+v"(pA1));ABIAS(pA0,pA1,0);CMASK(pA0,pA1,0);
  START(pA0,pA1);
  _Pragma("unroll") for(int r=0;r<16;++r)pA1[r]=__builtin_amdgcn_exp2f(pA1[r]);
  WAIT_BAR(0);
  DMA_K(3,0);DMA_V(1,SLOTB);
  ROT();
  kload8(kf,kp0+sl_cur);
  WAIT_BAR(2);
  s16x4 vlo[8],vhi[8]; u32x4 pw0,pw1,pw2,pw3;
  #define PKW(P,B) cvtpk_s(P[B],P[B+1])
  #define PAF(k) __builtin_bit_cast(bf16x8,pw##k)
  #define VFR(i) (bf16x8){vlo[i][0],vlo[i][1],vlo[i][2],vlo[i][3],vhi[i][0],vhi[i][1],vhi[i][2],vhi[i][3]}
  #define PIN(x) asm volatile("":"+v"(x))
  #define MX3(a,b,c) __builtin_fmaxf(__builtin_fmaxf((a),(b)),(c))
  #define GAPA(MF,A0,A1,A2,A3,W0,W1,PW) do{ MF; sacc+=A0; sacc+=A1; sacc+=A2; sacc+=A3; PIN(sacc); W0; W1; PIN(PW); SBAR(); }while(0)
  #define EX(v) __builtin_amdgcn_exp2f(v)
  #define GAPB(MF,X,B) do{ MF; X[B]=EX(X[B]); X[B+1]=EX(X[B+1]); X[B+2]=EX(X[B+2]); X[B+3]=EX(X[B+3]); PIN(X); SBAR(); }while(0)
  #define VRD(i) do{ vlo[i]=vtr(vp_+(((i)>>2)*4096+((i)&3)*1024)); vhi[i]=vtr(vp_+(((i)>>2)*4096+((i)&3)*1024+512)); }while(0)
  #define KRD(G,j) do{ if(G){ kload2(kf,kp0+sl_next,j); SBAR(); } }while(0)
  #define STEP(C0,C1,P0,P1,t,GK,GV,GL) do{ SBAR(); \
    const lds_cptr vp_=vp0+sl_prev; \
    VRD(0); SBAR(); float sacc=(P0[0]+P0[1]); \
    GAPA(C0=__builtin_amdgcn_mfma_f32_32x32x16_bf16(kf[0],qr[0],zero16,0,0,0), P0[2],P0[3],P0[4],P0[5],     pw0[0]=PKW(P0,0), pw0[1]=PKW(P0,2), pw0); \
    VRD(4); SBAR(); GAPA(C1=__builtin_amdgcn_mfma_f32_32x32x16_bf16(kf[1],qr[0],zero16,0,0,0), P0[6],P0[7],P0[8],P0[9],     pw0[2]=PKW(P0,4), pw0[3]=PKW(P0,6), pw0); \
    VRD(1); SBAR(); GAPA(C0=__builtin_amdgcn_mfma_f32_32x32x16_bf16(kf[2],qr[1],C0,0,0,0),   P0[10],P0[11],P0[12],P0[13], pw1[0]=PKW(P0,8), pw1[1]=PKW(P0,10), pw1); \
    VRD(5); SBAR(); GAPA(C1=__builtin_amdgcn_mfma_f32_32x32x16_bf16(kf[3],qr[1],C1,0,0,0),   P0[14],P0[15],P1[0],P1[1],   pw1[2]=PKW(P0,12),pw1[3]=PKW(P0,14), pw1); \
    VRD(2); SBAR(); GAPA(C0=__builtin_amdgcn_mfma_f32_32x32x16_bf16(kf[4],qr[2],C0,0,0,0),   P1[2],P1[3],P1[4],P1[5],     pw2[0]=PKW(P1,0), pw2[1]=PKW(P1,2), pw2); \
    VRD(6); SBAR(); GAPA(C1=__builtin_amdgcn_mfma_f32_32x32x16_bf16(kf[5],qr[2],C1,0,0,0),   P1[6],P1[7],P1[8],P1[9],     pw2[2]=PKW(P1,4), pw2[3]=PKW(P1,6), pw2); \
    VRD(3); SBAR(); GAPA(C0=__builtin_amdgcn_mfma_f32_32x32x16_bf16(kf[6],qr[3],C0,0,0,0),   P1[10],P1[11],P1[12],P1[13], pw3[0]=PKW(P1,8), pw3[1]=PKW(P1,10), pw3); \
    VRD(7); SBAR(); GAPA(C1=__builtin_amdgcn_mfma_f32_32x32x16_bf16(kf[7],qr[3],C1,0,0,0),   P1[14],P1[15],0.f,0.f,       pw3[2]=PKW(P1,12),pw3[3]=PKW(P1,14), pw3); \
    l_reg+=sacc; \
    if(GK){DMA_K((t)+3,sl_cur);} if(GV){DMA_V((t)+1,sl_next);} \
    ABIAS(C0,C1,t); CMASK(C0,C1,t); \
    { float a=MX3(C0[0],C0[1],C1[0]),b=MX3(C0[2],C0[3],C1[1]); a=MX3(a,C1[2],C1[3]); \
      _Pragma("unroll") for(int r=4;r<16;r+=4){a=MX3(a,C0[r],C0[r+1]);b=MX3(b,C0[r+2],C0[r+3]);a=MX3(a,C1[r],C1[r+1]);b=MX3(b,C1[r+2],C1[r+3]);} \
      float rm=__builtin_fmaxf(a,b); { auto rr=__builtin_amdgcn_permlane32_swap(__float_as_uint(rm),__float_as_uint(rm),false,false); rm=__builtin_fmaxf(__uint_as_float(rr[0]),__uint_as_float(rr[1])); } \
      resc=false; \
      if(__builtin_expect(__any(rm>(float)THRL),0)){ const float dl=__builtin_fmaxf(rm,0.f); mhat+=dl; \
        _Pragma("unroll") for(int r=0;r<16;++r){C0[r]-=dl;C1[r]-=dl;} \
        const float f=__builtin_amdgcn_exp2f(-dl); l_reg*=f; if(hi==0)wsf[r32]=f; resc=true; } } \
    SBAR(); \
    GAPB(o[0]=__builtin_amdgcn_mfma_f32_32x32x16_bf16(PAF(0),VFR(0),o[0],0,0,0), C0,0); \
    GAPB(o[1]=__builtin_amdgcn_mfma_f32_32x32x16_bf16(PAF(0),VFR(4),o[1],0,0,0), C0,4); \
    KRD(GL,0); GAPB(o[0]=__builtin_amdgcn_mfma_f32_32x32x16_bf16(PAF(1),VFR(1),o[0],0,0,0), C0,8); \
    KRD(GL,1); GAPB(o[1]=__builtin_amdgcn_mfma_f32_32x32x16_bf16(PAF(1),VFR(5),o[1],0,0,0), C0,12); \
    KRD(GL,2); GAPB(o[0]=__builtin_amdgcn_mfma_f32_32x32x16_bf16(PAF(2),VFR(2),o[0],0,0,0), C1,0); \
    KRD(GL,3); GAPB(o[1]=__builtin_amdgcn_mfma_f32_32x32x16_bf16(PAF(2),VFR(6),o[1],0,0,0), C1,4); \
    GAPB(o[0]=__builtin_amdgcn_mfma_f32_32x32x16_bf16(PAF(3),VFR(3),o[0],0,0,0), C1,8); \
    GAPB(o[1]=__builtin_amdgcn_mfma_f32_32x32x16_bf16(PAF(3),VFR(7),o[1],0,0,0), C1,12); \
    }while(0)
  int t=1;
  #undef CMASK
  #define CMASK(P0,P1,t) do{}while(0)
  for(;t+5<NT;t+=2){
    STEP(pB0,pB1,pA0,pA1,t,true,true,true);     WAIT_BAR(2); RESC(); ROT();
    STEP(pA0,pA1,pB0,pB1,t+1,true,true,true);   WAIT_BAR(2); RESC(); ROT();
  }
  #undef CMASK
  #define CMASK(P0,P1,t) do{int jb_=(t)-(NT-4); if(jb_>=0)cmask(P0,P1,jb_,qrel,hi);}while(0)
  #define ENDW(tt) do{ if((tt)+3<NT){WAIT_BAR(2);} else if((tt)+2<NT){WAIT_BAR(1);} else {WAIT_BAR(0);} }while(0)
  for(;t+1<NT;t+=2){
    STEP(pB0,pB1,pA0,pA1,t,(t+3<NT),(t+1<NT),(t+1<NT));       ENDW(t);   RESC(); ROT();
    STEP(pA0,pA1,pB0,pB1,t+1,(t+4<NT),(t+2<NT),(t+2<NT));     ENDW(t+1); RESC(); ROT();
  }
  STEP(pB0,pB1,pA0,pA1,NT-1,false,false,false); RESC();
  { float sacc=pB0[0]+pB0[1]; _Pragma("unroll") for(int r=2;r<16;++r)sacc+=pB0[r]; _Pragma("unroll") for(int r=0;r<16;++r)sacc+=pB1[r]; l_reg+=sacc;
    pw0=(u32x4){PKW(pB0,0),PKW(pB0,2),PKW(pB0,4),PKW(pB0,6)};pw1=(u32x4){PKW(pB0,8),PKW(pB0,10),PKW(pB0,12),PKW(pB0,14)};pw2=(u32x4){PKW(pB1,0),PKW(pB1,2),PKW(pB1,4),PKW(pB1,6)};pw3=(u32x4){PKW(pB1,8),PKW(pB1,10),PKW(pB1,12),PKW(pB1,14)};
    SBAR(); pv(o,vb0+sl_cur,PAF(0),PAF(1),PAF(2),PAF(3)); }
  #undef PKW
  #undef PAF
  #undef VFR
  #undef PIN
  #undef MX3
  #undef GAPA
  #undef GAPB
  #undef EX
  #undef VRD
  #undef KRD
  #undef STEP
  #undef ENDW
  {auto rr=__builtin_amdgcn_permlane32_swap(__float_as_uint(l_reg),__float_as_uint(l_reg),false,false);l_reg=__uint_as_float(rr[0])+__uint_as_float(rr[1]);}
  if(hi==0)wsf[32+r32]=l_reg;asm volatile("s_waitcnt lgkmcnt(0)":::"memory");
  float rli[16];
  #pragma unroll
  for(int r=0;r<16;++r)rli[r]=__builtin_amdgcn_rcpf(wsf[32+crow(r,hi)]);
  bf16*Ow=O+(rowbase+q0+wid*QBLK)*PO+vh*D;
  { bf16*stg=(bf16*)(shm+LDS_OST)+wid*2048;
    #pragma unroll
    for(int r=0;r<16;++r){const int orow=crow(r,hi);
      #pragma unroll
      for(int d0=0;d0<2;++d0)stg[orow*64+d0*32+r32]=__float2bfloat16(o[d0][r]*rli[r]);}
    asm volatile("s_waitcnt lgkmcnt(0)":::"memory");
    #pragma unroll
    for(int i=0;i<4;++i){const int row=i*8+(lane>>3),ch=lane&7; const u32x4 v=*(const u32x4*)(stg+row*64+ch*8); ATTN_STORE16(Ow+(long)row*PO+ch*8,v);} }
  asm volatile("s_waitcnt lgkmcnt(0)\n\ts_barrier":::"memory");
  #undef DMA_K
  #undef DMA_V
  #undef CMASK
  #undef ABIAS
  #undef START
  #undef RESC
  #undef ROT
}
constexpr int ATTN_LDS_BYTES=LDS_BYTES;
struct AttnTensors { const bf16* Q; const bf16* K; const bf16* V; bf16* O; };
struct AttnUnit { int bh; int qb; };
struct StaticOrder {
  int vcu;
  __device__ __forceinline__ explicit StaticOrder(int grid,int block):vcu((block%8)*(grid/8)+block/8){}
  __device__ __forceinline__ bool next(int i,AttnUnit&u)const{ if(i>=4)return false; const int s=vcu&1; u.bh=vcu>>1; u.qb=(i==0)?s:(i==1)?3-s:(i==2)?4+s:7-s; return true; }
  __device__ __forceinline__ void a_ready(const AttnUnit&)const{}
  __device__ __forceinline__ void done(const AttnUnit&)const{}
};
template<class Sched,int THRL=8> __device__ __forceinline__ void attn_phase(char*lds,const AttnTensors&T,const Sched&S){
  AttnUnit u;
  for(int i=0;S.next(i,u);++i){ S.a_ready(u); attn_unit<THRL>(u.bh/NVH,u.bh%NVH,u.qb,T.Q,T.K,T.V,T.O,lds); S.done(u); }
}
#undef SBAR
#undef WAIT_BAR
}

constexpr int NWAVES = 8, NTHR = NWAVES * 64;
#ifndef MK_N_LAUNCHES
#define MK_N_LAUNCHES 1
#endif
constexpr int N_LAUNCHES = MK_N_LAUNCHES;

constexpr int BATCH = 4, SEQ = 2048, DM = 4096, DEPTH = 2, M = BATCH * SEQ;
constexpr int NCOL = 20480, FFN = 11008, NGU = 2 * FFN;
constexpr int C_HQ = 0, C_HF = 1024, C_HV = 2048, C_HG = 3072, C_PU = 4096, C_DQ = 5120, C_DK = 6144, C_DV = 7168, C_GATE = 8192;
constexpr float EPS = 1e-6f;
constexpr float QSCALE_HG = 0.08838834764831845f;
constexpr int PH_PER_LAYER = 10, NPHASES = 1 + PH_PER_LAYER * DEPTH;
static_assert(N_LAUNCHES == 1 || N_LAUNCHES == NPHASES, "MK_N_LAUNCHES must be 1 or 21");

constexpr size_t MiB = 1u << 20;
constexpr size_t WS_CTL = 0, CTL_ZERO_BYTES = 1 * MiB;
constexpr size_t WS_LB = 1 * MiB;
constexpr size_t WS_POOLW = 2 * MiB;
constexpr size_t WS_WUP = 4 * MiB;
constexpr size_t WS_WOUT = 52 * MiB;
constexpr size_t WS_WDN = 116 * MiB;
constexpr size_t WS_WIN = 288 * MiB;
constexpr size_t WS_WGU = 608 * MiB;
constexpr size_t WS_H = 952 * MiB;
constexpr size_t WS_PROJ = 1016 * MiB;
constexpr size_t WS_ATTO = 1336 * MiB;
constexpr size_t WS_Y = 1368 * MiB;
constexpr size_t WS_POOLED = 1416 * MiB;
constexpr size_t WS_MERGED = 1432 * MiB;
constexpr size_t WS_Z = 1496 * MiB;
constexpr size_t WS_HGL = 1624 * MiB;
constexpr size_t WS_HGS = 1688 * MiB;
constexpr size_t WS_HGD = 1752 * MiB;
constexpr size_t WS_END = 1753 * MiB;
static_assert(WS_WUP + (size_t)DEPTH * 3 * 4096 * 1024 * 2 <= WS_WOUT && WS_WOUT + (size_t)DEPTH * 4096 * 4096 * 2 <= WS_WDN && WS_WDN + (size_t)DEPTH * 4096 * FFN * 2 <= WS_WIN, "ws map 1");
static_assert(WS_WIN + (size_t)DEPTH * NCOL * 4096 * 2 <= WS_WGU && WS_WGU + (size_t)DEPTH * NGU * 4096 * 2 <= WS_H && WS_H + (size_t)M * DM * 2 <= WS_PROJ && WS_PROJ + (size_t)M * NCOL * 2 <= WS_ATTO, "ws map 2");
static_assert(WS_ATTO + (size_t)M * 2048 * 2 <= WS_Y && WS_Y + (size_t)3 * M * 1024 * 2 <= WS_POOLED && WS_POOLED + (size_t)M * 1024 * 2 <= WS_MERGED && WS_MERGED + (size_t)M * DM * 2 <= WS_Z && WS_Z + (size_t)M * DM * 4 <= WS_HGL, "ws map 3");
static_assert(WS_HGL + (size_t)1024 * 16384 * 4 <= WS_HGS && WS_HGS + (size_t)1024 * 16384 * 4 <= WS_HGD && WS_HGD + (size_t)1024 * 128 * 4 <= WS_END && (size_t)M * FFN * 2 <= (size_t)M * NCOL * 2, "ws map 4");
constexpr int CW_BAR = 4096;

constexpr int RING_OFF = 0, RING_BYTES = 131072;
constexpr int LDSCTL_OFF = RING_BYTES, MISC_OFF = LDSCTL_OFF + 320;
constexpr int LDS_BYTES = 147456;
static_assert(MISC_OFF + 128 <= LDS_BYTES, "LDS map");

#define GAS __attribute__((address_space(1)))
#define LAS __attribute__((address_space(3)))
typedef unsigned short bf16;
typedef unsigned v4u __attribute__((ext_vector_type(4)));
typedef unsigned v2u __attribute__((ext_vector_type(2)));
typedef float f32x4 __attribute__((ext_vector_type(4)));
typedef GAS unsigned gu32;
#define RLX_AGENT __ATOMIC_RELAXED, __HIP_MEMORY_SCOPE_AGENT
#define LDS_WAIT() asm volatile("s_waitcnt lgkmcnt(0)" ::: "memory")
#define VM_WAIT() asm volatile("s_waitcnt vmcnt(0)" ::: "memory")
__device__ __forceinline__ unsigned f2bf(float f) { unsigned u = __builtin_bit_cast(unsigned, f); return (u + 0x7fffu + ((u >> 16) & 1u)) >> 16; }
__device__ __forceinline__ unsigned pk2(float lo, float hi) { return f2bf(lo) | (f2bf(hi) << 16); }
__device__ __forceinline__ float bflo(unsigned w) { return __uint_as_float(w << 16); }
__device__ __forceinline__ float bfhi(unsigned w) { return __uint_as_float(w & 0xffff0000u); }
__device__ __forceinline__ void unpack8(const v4u w, float (&f)[8]) { f[0] = bflo(w.x); f[1] = bfhi(w.x); f[2] = bflo(w.y); f[3] = bfhi(w.y); f[4] = bflo(w.z); f[5] = bfhi(w.z); f[6] = bflo(w.w); f[7] = bfhi(w.w); }
__device__ __forceinline__ v4u pack8(const float (&f)[8]) { v4u w; w.x = pk2(f[0], f[1]); w.y = pk2(f[2], f[3]); w.z = pk2(f[4], f[5]); w.w = pk2(f[6], f[7]); return w; }
__device__ __forceinline__ float sigmoidf_(float z) { return 1.0f / (1.0f + __expf(-z)); }

#define XB_TMO      128
#define XB_XCNT(j)  (256  + 64 * (j))
#define XB_XSUB(j)  (1280 + 64 * (j))
#define XB_XGEN(j)  (2304 + 64 * (j))
#define XB_TOP      3328
#define XB_TOPGEN   3392
#define XCD_BAR_WORDS 3456
#define XB_SPIN_CAP (1u << 18)

__device__ __forceinline__ unsigned xb_ld(unsigned* p)              { return __hip_atomic_load(p, __ATOMIC_RELAXED, __HIP_MEMORY_SCOPE_AGENT); }
__device__ __forceinline__ unsigned xb_add(unsigned* p, unsigned v) { return __hip_atomic_fetch_add(p, v, __ATOMIC_RELAXED, __HIP_MEMORY_SCOPE_AGENT); }
__device__ __forceinline__ unsigned xb_xcc_id() { return (unsigned)__builtin_amdgcn_s_getreg((3 << 11) | 20) & 0xFu; }
#define XB_SPIN(cond, bar) do { unsigned _sp = 0; while (cond) { __builtin_amdgcn_s_sleep(1); \
    if ((++_sp & 255u) == 0u) { if (xb_ld(&(bar)[XB_TMO])) break; if (_sp > XB_SPIN_CAP) { atomicAdd(&(bar)[XB_TMO], 1u); break; } } } } while (0)

struct XcdBarrier {
    unsigned* bar; unsigned x;
    volatile LAS unsigned* st;
};

__device__ __forceinline__ XcdBarrier xcd_barrier_post(unsigned* bar, volatile LAS unsigned* st) {
    XcdBarrier b; b.bar = bar; b.x = xb_xcc_id(); b.st = st;
    if (threadIdx.x == 0) (void)xb_add(&bar[XB_XCNT(b.x)], 1u);
    return b;
}
__device__ __forceinline__ void xcd_barrier_complete(unsigned* bar, unsigned x, unsigned& nloc, unsigned& nx) {
    const unsigned G = gridDim.x * gridDim.y * gridDim.z;
    unsigned sum, cnt, mine, sp = 0u;
    for (;;) {
        sum = 0u; cnt = 0u; mine = 0u;
#pragma unroll
        for (unsigned j = 0; j < 16; ++j) { const unsigned c = xb_ld(&bar[XB_XCNT(j)]); sum += c; cnt += (c > 0u) ? 1u : 0u; mine = (j == x) ? c : mine; }
        if (sum == G) break;
        __builtin_amdgcn_s_sleep(1);
        if ((++sp & 255u) == 0u) { if (xb_ld(&bar[XB_TMO])) break; if (sp > XB_SPIN_CAP) { atomicAdd(&bar[XB_TMO], 1u); break; } }
    }
    nloc = mine > 0u ? mine : 1u; nx = cnt > 0u ? cnt : 1u;
}

__device__ __forceinline__ void xcd_barrier(const XcdBarrier& b) {
    asm volatile("s_waitcnt vmcnt(0)" ::: "memory");
    __syncthreads();
    if (threadIdx.x == 0) {
        unsigned* bar = b.bar;
        __builtin_amdgcn_s_waitcnt(0);
        unsigned nloc = b.st[0], nx = b.st[1];
        if (nloc == 0u) { xcd_barrier_complete(bar, b.x, nloc, nx); b.st[0] = nloc; b.st[1] = nx; }
        const unsigned old = xb_add(&bar[XB_XSUB(b.x)], 1u);
        const unsigned gen = old / nloc;
        if (old + 1u == (gen + 1u) * nloc) {
            __builtin_amdgcn_fence(__ATOMIC_RELEASE, "agent");
            asm volatile("s_waitcnt vmcnt(0)" ::: "memory");
            const unsigned og = xb_add(&bar[XB_TOP], 1u);
            const unsigned tg = og / nx;
            if (og + 1u == (tg + 1u) * nx) xb_add(&bar[XB_TOPGEN], 1u);
            else XB_SPIN(xb_ld(&bar[XB_TOPGEN]) == tg, bar);
            __builtin_amdgcn_fence(__ATOMIC_ACQUIRE, "agent");
            xb_add(&bar[XB_XGEN(b.x)], 1u);
            asm volatile("s_waitcnt vmcnt(0)" ::: "memory");
        } else {
            XB_SPIN(xb_ld(&bar[XB_XGEN(b.x)]) == gen, bar);
            __builtin_amdgcn_fence(__ATOMIC_ACQUIRE, "agent");
            asm volatile("s_waitcnt vmcnt(0)" ::: "memory");
        }
    }
    __syncthreads();
}


struct Frame {
    LAS unsigned char* lds;
    volatile LAS unsigned* MISC;
    unsigned char* ws; float* out;
    int tid, lane, wave;
    int vcu, G;
};
#define WSP(T, off) ((T*)(F.ws + (off)))
enum { I_X = 0, I_NMPRE, I_NMPOST, I_NFPRE, I_NFPOST, I_WIN, I_LBLOG, I_HGNORM, I_POOLW, I_POOLSC, I_LAMBDA, I_SUBLN, I_WUPA, I_WUPB, I_WUPC, I_WOUT, I_WGATE, I_WFUP, I_WDOWN };

struct Args { const float* in[19]; float* out; unsigned char* ws; int ph_lo, ph_hi; };

template <int X> __device__ __forceinline__ float xor_lane(float v) {
    if constexpr (X == 32) { const auto rr = __builtin_amdgcn_permlane32_swap(__float_as_uint(v), __float_as_uint(v), false, false); const unsigned a = rr[0], b = rr[1]; return __uint_as_float(a ^ b ^ __float_as_uint(v)); }
    else return __uint_as_float((unsigned)__builtin_amdgcn_ds_swizzle((int)__float_as_uint(v), (X << 10) | 0x1f));
}
__device__ __forceinline__ float wave_sum(float v) {
    v += xor_lane<1>(v); v += xor_lane<2>(v); v += xor_lane<4>(v); v += xor_lane<8>(v); v += xor_lane<16>(v); v += xor_lane<32>(v);
    return v;
}

__device__ __forceinline__ void p0_transpose_item(const float* W, int K, int N, bf16* WT, int drow0, LAS float* scr, int k0, int n0, int lane) {
#pragma unroll 8
    for (int i = 0; i < 32; ++i) { const int kk = 2 * i + (lane >> 5); scr[kk * 33 + (lane & 31)] = W[(size_t)(k0 + kk) * N + n0 + (lane & 31)]; }
    LDS_WAIT(); asm volatile("" ::: "memory");
    const int c = lane & 7;
#pragma unroll
    for (int j = 0; j < 4; ++j) { const int n = (lane >> 3) + 8 * j; const LAS float* s = scr + (8 * c) * 33 + n;
        v4u o; o.x = pk2(s[0 * 33], s[1 * 33]); o.y = pk2(s[2 * 33], s[3 * 33]); o.z = pk2(s[4 * 33], s[5 * 33]); o.w = pk2(s[6 * 33], s[7 * 33]);
        *(GAS v4u*)(WT + (size_t)(drow0 + n) * K + k0 + 8 * c) = o; }
    LDS_WAIT(); asm volatile("" ::: "memory");
}
__device__ __forceinline__ void rms_row_to_bf16(int lane, const float* xrow, const float* gain, bf16* orow) {
    const GAS f32x4* xr = (const GAS f32x4*)xrow + lane; const GAS f32x4* gr = (const GAS f32x4*)gain + lane;
    f32x4 v[16]; float s = 0.f;
#pragma unroll
    for (int j = 0; j < 16; ++j) { v[j] = xr[64 * j]; s += (v[j].x * v[j].x + v[j].y * v[j].y) + (v[j].z * v[j].z + v[j].w * v[j].w); }
    const float rstd = 1.0f / sqrtf(wave_sum(s) * (1.f / DM) + EPS);
    GAS v2u* o8 = (GAS v2u*)orow + lane;
#pragma unroll
    for (int j = 0; j < 16; ++j) { const f32x4 g = gr[64 * j]; v2u w; w.x = pk2(v[j].x * rstd * g.x, v[j].y * rstd * g.y); w.y = pk2(v[j].z * rstd * g.z, v[j].w * rstd * g.w); o8[64 * j] = w; }
}
#define AIN(A, i) ({ int i_ = (i); asm volatile("" : "+s"(i_)); (A).in[i_]; })
__device__ __forceinline__ void p0_prologue(Frame& F, const Args& A) {
    LAS float* scr = (LAS float*)(F.lds + RING_OFF + F.wave * 16384);
    const int gw = F.vcu * NWAVES + F.wave, NGW = F.G * NWAVES;
    constexpr int I_IN = (DM / 64) * (NCOL / 32), I_UP = (1024 / 64) * (DM / 32), I_OUT = (DM / 64) * (DM / 32), I_G = (DM / 64) * (FFN / 32), I_DN = (FFN / 64) * (DM / 32), I_PL = (256 / 64) * (256 / 32);
    constexpr int I_LAYER = I_IN + 3 * I_UP + I_OUT + 2 * I_G + I_DN + 4 * I_PL;
    for (int it = gw; it < DEPTH * I_LAYER; it += NGW) {
        const int l = it / I_LAYER; int r = it - l * I_LAYER;
        const float* W; bf16* WT; int K, N, mode = 0;
        if (r < I_IN) { W = AIN(A, I_WIN) + (size_t)l * DM * NCOL; K = DM; N = NCOL; WT = WSP(bf16, WS_WIN) + (size_t)l * NCOL * DM; }
        else if ((r -= I_IN) < 3 * I_UP) { const int j = r / I_UP; r -= j * I_UP; W = (j == 0 ? AIN(A, I_WUPA) : (j == 1 ? AIN(A, I_WUPB) : AIN(A, I_WUPC))) + (size_t)l * 1024 * DM; K = 1024; N = DM; WT = WSP(bf16, WS_WUP) + ((size_t)l * 3 + j) * DM * 1024; }
        else if ((r -= 3 * I_UP) < I_OUT) { W = AIN(A, I_WOUT) + (size_t)l * DM * DM; K = DM; N = DM; WT = WSP(bf16, WS_WOUT) + (size_t)l * DM * DM; }
        else if ((r -= I_OUT) < 2 * I_G) { const int j = r / I_G; r -= j * I_G; W = (j == 0 ? AIN(A, I_WGATE) : AIN(A, I_WFUP)) + (size_t)l * DM * FFN; K = DM; N = FFN; WT = WSP(bf16, WS_WGU) + (size_t)l * NGU * DM; mode = 1 + j; }
        else if ((r -= 2 * I_G) < I_DN) { W = AIN(A, I_WDOWN) + (size_t)l * FFN * DM; K = FFN; N = DM; WT = WSP(bf16, WS_WDN) + (size_t)l * DM * FFN; }
        else { r -= I_DN; const int g = r / I_PL; r -= g * I_PL; W = AIN(A, I_POOLW) + ((size_t)l * 4 + g) * 65536; K = 256; N = 256; WT = WSP(bf16, WS_POOLW) + ((size_t)l * 4 + g) * 65536; }
        const int nblk = N / 32, kb = r / nblk, nb = r - kb * nblk, n0 = 32 * nb;
        const int drow0 = (mode == 0) ? n0 : ((n0 >> 7) * 256 + (n0 & 127) + (mode == 2 ? 128 : 0));
        p0_transpose_item(W, K, N, WT, drow0, scr, 64 * kb, n0, F.lane);
    }
    if (blockIdx.x == 0) {
        for (int c = F.tid; c < 1024; c += NTHR) {
            float lg[DEPTH], mx = -INFINITY, den = 0.f;
#pragma unroll
            for (int l = 0; l < DEPTH; ++l) { lg[l] = AIN(A, I_LBLOG)[l * 1024 + c]; mx = fmaxf(mx, lg[l]); }
#pragma unroll
            for (int l = 0; l < DEPTH; ++l) { lg[l] = expf(lg[l] - mx); den += lg[l]; }
            float cum = 0.f;
#pragma unroll
            for (int l = 0; l < DEPTH; ++l) { if (l > 0) cum += lg[l] / den; WSP(float, WS_LB)[l * 1024 + c] = cum; }
        }
    }
    for (int m = gw; m < M; m += NGW) rms_row_to_bf16(F.lane, AIN(A, I_X) + (size_t)m * DM, AIN(A, I_NMPRE), WSP(bf16, WS_H) + (size_t)m * DM);
}

__device__ __forceinline__ void resnorm_phase(Frame& F, const float* xold, const float* gpost, const float* gnext) {
    const int gw = F.vcu * NWAVES + F.wave, NGW = F.G * NWAVES;
    for (int m = gw; m < M; m += NGW) {
        const GAS f32x4* zr = (const GAS f32x4*)(WSP(float, WS_Z) + (size_t)m * DM) + F.lane; const GAS f32x4* xr = (const GAS f32x4*)(xold + (size_t)m * DM) + F.lane;
        const GAS f32x4* gp = (const GAS f32x4*)gpost + F.lane;
        f32x4 v[16]; float s = 0.f;
#pragma unroll
        for (int j = 0; j < 16; ++j) { v[j] = zr[64 * j]; s += (v[j].x * v[j].x + v[j].y * v[j].y) + (v[j].z * v[j].z + v[j].w * v[j].w); }
        const float rz = 1.0f / sqrtf(wave_sum(s) * (1.f / DM) + EPS);
        float s2 = 0.f; GAS f32x4* orow = (GAS f32x4*)(F.out + (size_t)m * DM) + F.lane;
#pragma unroll
        for (int j = 0; j < 16; ++j) { const f32x4 x = xr[64 * j], g = gp[64 * j]; v[j] = x + v[j] * rz * g; s2 += (v[j].x * v[j].x + v[j].y * v[j].y) + (v[j].z * v[j].z + v[j].w * v[j].w); orow[64 * j] = v[j]; }
        if (gnext) {
            const float rx = 1.0f / sqrtf(wave_sum(s2) * (1.f / DM) + EPS);
            const GAS f32x4* gn = (const GAS f32x4*)gnext + F.lane; GAS v2u* o8 = (GAS v2u*)(WSP(bf16, WS_H) + (size_t)m * DM) + F.lane;
#pragma unroll
            for (int j = 0; j < 16; ++j) { const f32x4 g = gn[64 * j]; v2u w; w.x = pk2(v[j].x * rx * g.x, v[j].y * rx * g.y); w.y = pk2(v[j].z * rx * g.z, v[j].w * rx * g.w); o8[64 * j] = w; }
        }
    }
}
__device__ __forceinline__ void pooled_phase(Frame& F) {
    const int gt = F.vcu * NTHR + F.tid, NGT = F.G * NTHR;
    for (int it = gt; it < M * 128; it += NGT) {
        const int row = it >> 7, c8 = (it & 127) * 8, g = c8 >> 8, w = 2 << g, t = row & (SEQ - 1), cnt = (t + 1 < w) ? t + 1 : w;
        const bf16* p = WSP(bf16, WS_PROJ) + (size_t)row * NCOL + C_PU + c8;
        float cur[8], sum[8];
        unpack8(*(const GAS v4u*)p, cur);
#pragma unroll
        for (int j = 0; j < 8; ++j) sum[j] = cur[j];
        for (int i = 1; i < cnt; ++i) { float x[8]; unpack8(*(const GAS v4u*)(p - (size_t)i * NCOL), x);
#pragma unroll
            for (int j = 0; j < 8; ++j) sum[j] += x[j]; }
        const float inv = 1.0f / (float)cnt; float o[8];
#pragma unroll
        for (int j = 0; j < 8; ++j) o[j] = sum[j] * inv - cur[j];
        *(GAS v4u*)(WSP(bf16, WS_POOLED) + (size_t)row * 1024 + c8) = pack8(o);
    }
}
__device__ __forceinline__ void attn_combine_phase(Frame& F, const float* lp, const float* sub, float lambda_init) {
    const float lam = expf(wave_sum(lp[F.lane] * lp[64 + F.lane])) - expf(wave_sum(lp[128 + F.lane] * lp[192 + F.lane])) + lambda_init;
    bf16* yc = WSP(bf16, WS_Y) + (size_t)2 * M * 1024;
    const int gt = F.vcu * NTHR + F.tid, NGT = F.G * NTHR;
    for (int it = gt; it < M * 8 * 16; it += NGT) {
        const int l16 = it & 15, rh = it >> 4, h = rh & 7, row = rh >> 3, j = l16 >> 3, wcol = (l16 & 7) * 8;
        const bf16* o1 = WSP(bf16, WS_ATTO) + (size_t)row * 2048 + (h * 4 + j) * 64 + wcol;
        float a[8], b[8], d[8]; unpack8(*(const GAS v4u*)o1, a); unpack8(*(const GAS v4u*)(o1 + 128), b);
        float ss = 0.f;
#pragma unroll
        for (int k = 0; k < 8; ++k) { d[k] = a[k] - lam * b[k]; ss += d[k] * d[k]; }
        ss += xor_lane<1>(ss); ss += xor_lane<2>(ss); ss += xor_lane<4>(ss); ss += xor_lane<8>(ss);
        const float rstd = (1.0f / sqrtf(ss * (1.f / 128.f) + EPS)) * (1.0f - lambda_init);
#pragma unroll
        for (int k = 0; k < 8; ++k) d[k] = d[k] * rstd * sub[l16 * 8 + k];
        *(GAS v4u*)(yc + (size_t)row * 1024 + h * 128 + l16 * 8) = pack8(d);
    }
}

__device__ __forceinline__ void hg_gate(float z, float lb, float& logf_, float& k_) {
    z = fminf(fmaxf(z, -30.f), 30.f);
    const float e = expf(-z), sg = 1.0f / (1.0f + e), om = e * sg;
    logf_ = logf(lb + (1.0f - lb) * sg); k_ = (1.0f - lb) * om;
}
__device__ __forceinline__ void h1_unit(Frame& F, int layer, int u) {
    const int bh = u >> 5, c = u & 31, b = bh >> 3, h = bh & 7; const size_t r0 = (size_t)b * SEQ + c * 64;
    LAS float* gl = (LAS float*)(F.lds + RING_OFF); LAS float* kk = gl + 64 * 128; LAS float* vv = kk + 64 * 128;
    const float* lbp = WSP(float, WS_LB) + layer * 1024 + h * 128;
#pragma unroll
    for (int i = 0; i < 2; ++i) { const int vec = F.tid + NTHR * i, s = vec >> 4, k8 = (vec & 15) * 8;
        const bf16* pr = WSP(bf16, WS_PROJ) + (r0 + s) * NCOL + h * 128 + k8; float zf[8], zv[8];
        unpack8(*(const GAS v4u*)(pr + C_HF), zf); unpack8(*(const GAS v4u*)(pr + C_HV), zv);
#pragma unroll
        for (int j = 0; j < 8; ++j) { float lf, kq; hg_gate(zf[j], lbp[k8 + j], lf, kq); gl[s * 128 + k8 + j] = lf; kk[s * 128 + k8 + j] = kq; vv[s * 128 + k8 + j] = zv[j]; } }
    __syncthreads();
    if (F.tid < 128) { float a = 0.f; for (int s = 0; s < 64; ++s) { a += gl[s * 128 + F.tid]; gl[s * 128 + F.tid] = a; } }
    __syncthreads();
#pragma unroll
    for (int i = 0; i < 16; ++i) { const int idx = F.tid + NTHR * i, k = idx & 127; kk[idx] *= expf(gl[63 * 128 + k] - gl[idx]); }
    __syncthreads();
    { const int k = F.tid >> 2, vq = (F.tid & 3) * 32; f32x4 acc[8];
#pragma unroll
      for (int j = 0; j < 8; ++j) acc[j] = (f32x4){0.f, 0.f, 0.f, 0.f};
      for (int s = 0; s < 64; ++s) { const float a = kk[s * 128 + k]; const LAS f32x4* vp = (const LAS f32x4*)(vv + s * 128 + vq);
#pragma unroll
          for (int j = 0; j < 8; ++j) acc[j] += a * vp[j]; }
      GAS f32x4* lo = (GAS f32x4*)(WSP(float, WS_HGL) + ((size_t)u * 128 + k) * 128 + vq);
#pragma unroll
      for (int j = 0; j < 8; ++j) lo[j] = acc[j];
      if (F.tid < 128) WSP(float, WS_HGD)[(size_t)u * 128 + F.tid] = expf(gl[63 * 128 + F.tid]); }
    __syncthreads();
}
__device__ __forceinline__ void h2_phase(Frame& F) {
    const int gt = F.vcu * NTHR + F.tid, NGT = F.G * NTHR;
    for (int it = gt; it < 32 * 4096; it += NGT) {
        const int bh = it >> 12, e4 = it & 4095, k = e4 >> 5;
        f32x4 st = (f32x4){0.f, 0.f, 0.f, 0.f};
        for (int c = 0; c < 32; ++c) { const size_t u = (size_t)bh * 32 + c;
            *((GAS f32x4*)(WSP(float, WS_HGS) + u * 16384) + e4) = st;
            const float d = WSP(float, WS_HGD)[u * 128 + k]; const f32x4 lv = *((const GAS f32x4*)(WSP(float, WS_HGL) + u * 16384) + e4);
            st = d * st + lv; }
    }
}
__device__ __forceinline__ void h3_unit(Frame& F, int layer, int u, const float* hgnorm) {
    const int bh = u >> 5, c = u & 31, b = bh >> 3, h = bh & 7; const size_t r0 = (size_t)b * SEQ + c * 64;
    LAS float* qf = (LAS float*)(F.lds + RING_OFF); LAS float* kf = qf + 64 * 129; LAS float* bm = kf + 64 * 129; LAS float* Pm = bm + 64 * 129; LAS float* vv = kf;
    const float* lbp = WSP(float, WS_LB) + layer * 1024 + h * 128;
#pragma unroll
    for (int i = 0; i < 2; ++i) { const int vec = F.tid + NTHR * i, s = vec >> 4, k8 = (vec & 15) * 8;
        const bf16* pr = WSP(bf16, WS_PROJ) + (r0 + s) * NCOL + h * 128 + k8; float zf[8], zq[8];
        unpack8(*(const GAS v4u*)(pr + C_HF), zf); unpack8(*(const GAS v4u*)(pr + C_HQ), zq);
#pragma unroll
        for (int j = 0; j < 8; ++j) { float lf, kq; hg_gate(zf[j], lbp[k8 + j], lf, kq); bm[s * 129 + k8 + j] = lf; kf[s * 129 + k8 + j] = kq; qf[s * 129 + k8 + j] = zq[j]; } }
    __syncthreads();
    if (F.tid < 128) { float a = 0.f; for (int s = 0; s < 64; ++s) { a += bm[s * 129 + F.tid]; bm[s * 129 + F.tid] = a; } }
    __syncthreads();
    for (int i = 0; i < 8; ++i) { const int t = F.wave + 8 * i, s = F.lane; float p = 0.f;
        if (s <= t) { for (int k = 0; k < 128; ++k) p += qf[t * 129 + k] * kf[s * 129 + k] * expf(bm[t * 129 + k] - bm[s * 129 + k]); }
        Pm[t * 65 + s] = p; }
    __syncthreads();
#pragma unroll
    for (int i = 0; i < 16; ++i) { const int idx = F.tid + NTHR * i, s = idx >> 7, k = idx & 127; qf[s * 129 + k] *= expf(bm[s * 129 + k]); }
#pragma unroll
    for (int i = 0; i < 2; ++i) { const int vec = F.tid + NTHR * i, s = vec >> 4, k8 = (vec & 15) * 8; float zv[8];
        unpack8(*(const GAS v4u*)(WSP(bf16, WS_PROJ) + (r0 + s) * NCOL + C_HV + h * 128 + k8), zv);
#pragma unroll
        for (int j = 0; j < 8; ++j) vv[s * 128 + k8 + j] = zv[j]; }
    __syncthreads();
    { const int t = F.tid >> 3, vr = (F.tid & 7) * 16; f32x4 acc[4];
#pragma unroll
      for (int j = 0; j < 4; ++j) acc[j] = (f32x4){0.f, 0.f, 0.f, 0.f};
      const GAS f32x4* Sp = (const GAS f32x4*)(WSP(float, WS_HGS) + (size_t)u * 16384 + vr);
      for (int k = 0; k < 128; ++k) { const float a = qf[t * 129 + k];
#pragma unroll
          for (int j = 0; j < 4; ++j) acc[j] += a * Sp[k * 32 + j]; }
      for (int s = 0; s < 64; ++s) { const float p = Pm[t * 65 + s]; const LAS f32x4* vp = (const LAS f32x4*)(vv + s * 128 + vr);
#pragma unroll
          for (int j = 0; j < 4; ++j) acc[j] += p * vp[j]; }
      float ss = 0.f;
#pragma unroll
      for (int j = 0; j < 4; ++j) ss += (acc[j].x * acc[j].x + acc[j].y * acc[j].y) + (acc[j].z * acc[j].z + acc[j].w * acc[j].w);
      ss += xor_lane<1>(ss); ss += xor_lane<2>(ss); ss += xor_lane<4>(ss);
      const float rstd = 1.0f / sqrtf(ss * (1.f / 128.f) + EPS);
      const bf16* gp = WSP(bf16, WS_PROJ) + (r0 + t) * NCOL + C_HG + h * 128 + vr; const float* gn = hgnorm + h * 128 + vr;
      bf16* yo = WSP(bf16, WS_Y) + (r0 + t) * 1024 + h * 128 + vr;
#pragma unroll
      for (int half = 0; half < 2; ++half) { float g[8], o[8]; unpack8(*(const GAS v4u*)(gp + 8 * half), g);
#pragma unroll
          for (int j = 0; j < 8; ++j) { const float a = acc[2 * half + (j >> 2)][j & 3]; o[j] = a * rstd * gn[8 * half + j] * (g[j] * sigmoidf_(g[j])); }
          *(GAS v4u*)(yo + 8 * half) = pack8(o); } }
    __syncthreads();
}

struct SchedPlain {
    pg8::TileOrder T; const char* A; const char* B; size_t ta, tb;
    __device__ __forceinline__ bool next(int i, pg8::Unit& u) const { int pm, pn; if (!T.tile(i, pm, pn)) return false; u.pm = pm; u.pn = pn; u.kind = 0; u.a = A + (size_t)pm * ta; u.b = B + (size_t)pn * tb; return true; }
};
struct SchedUp {
    pg8::TileOrder T; const char* Y; const char* W;
    __device__ __forceinline__ bool next(int i, pg8::Unit& u) const { const int ti = i / 3, br = i - 3 * ti; int pm, pn; if (!T.tile(ti, pm, pn)) return false; u.pm = pm; u.pn = pn; u.kind = br;
        u.a = Y + ((size_t)br * M * 1024 + (size_t)pm * 256 * 1024) * 2; u.b = W + ((size_t)br * DM + (size_t)pn * 256) * 1024 * 2; return true; }
};
struct SchedPool {
    int G, c; const char* A; const char* B;
    __device__ __forceinline__ bool next(int i, pg8::Unit& u) const { const int L = i * G + c; if (L >= 128) return false; u.pm = L >> 2; u.pn = L & 3; u.kind = 0;
        u.a = A + ((size_t)u.pm * 256 * 1024 + (size_t)u.pn * 256) * 2; u.b = B + (size_t)u.pn * 65536 * 2; return true; }
};
struct EpiProj {
    static constexpr bool PERM = true; bf16* O;
    __device__ __forceinline__ bool keep(const pg8::Unit&) const { return false; }
    __device__ __forceinline__ void operator()(pg8::f32x4 (&acc)[2][2][4][2], const pg8::Unit& u, int wr, int wc, int fr, int fq) const {
        const float sc = (u.pn < 4) ? QSCALE_HG : ((u.pn >= 20 && u.pn < 24) ? attn_body::C2 : 1.0f);
        const int row0 = u.pm * 256 + wr * 64 + fr, col0 = u.pn * 256 + wc * 32 + 8 * fq;
#pragma unroll
        for (int ai = 0; ai < 2; ++ai)
#pragma unroll
            for (int m = 0; m < 4; ++m) { bf16* rowp = O + (size_t)(row0 + ai * 128 + m * 16) * NCOL + col0;
#pragma unroll
                for (int bj = 0; bj < 2; ++bj) { const pg8::f32x4 v0 = acc[ai][bj][m][0] * sc, v1 = acc[ai][bj][m][1] * sc;
                    pg8::u32x4 w; w.x = pg8::cvt_pk_bf16(v0[0], v0[1]); w.y = pg8::cvt_pk_bf16(v0[2], v0[3]); w.z = pg8::cvt_pk_bf16(v1[0], v1[1]); w.w = pg8::cvt_pk_bf16(v1[2], v1[3]);
                    *(pg8::u32x4*)(rowp + bj * 128) = w; } }
    }
};
struct EpiPool {
    static constexpr bool PERM = true; bf16* O; const float* scale;
    __device__ __forceinline__ bool keep(const pg8::Unit&) const { return false; }
    __device__ __forceinline__ void operator()(pg8::f32x4 (&acc)[2][2][4][2], const pg8::Unit& u, int wr, int wc, int fr, int fq) const {
        const int row0 = u.pm * 256 + wr * 64 + fr, col0 = u.pn * 256 + wc * 32 + 8 * fq;
        pg8::f32x4 sv[2][2];
#pragma unroll
        for (int bj = 0; bj < 2; ++bj)
#pragma unroll
            for (int n = 0; n < 2; ++n) sv[bj][n] = *(const pg8::f32x4*)(scale + col0 + bj * 128 + 4 * n);
#pragma unroll
        for (int ai = 0; ai < 2; ++ai)
#pragma unroll
            for (int m = 0; m < 4; ++m) { bf16* rowp = O + (size_t)(row0 + ai * 128 + m * 16) * 1024 + col0;
#pragma unroll
                for (int bj = 0; bj < 2; ++bj) { const pg8::f32x4 v0 = acc[ai][bj][m][0] * sv[bj][0], v1 = acc[ai][bj][m][1] * sv[bj][1];
                    pg8::u32x4 w; w.x = pg8::cvt_pk_bf16(v0[0], v0[1]); w.y = pg8::cvt_pk_bf16(v0[2], v0[3]); w.z = pg8::cvt_pk_bf16(v1[0], v1[1]); w.w = pg8::cvt_pk_bf16(v1[2], v1[3]);
                    *(pg8::u32x4*)(rowp + bj * 128) = w; } }
    }
};
struct EpiUp {
    static constexpr bool PERM = true; const bf16* gates; bf16* O;
    __device__ __forceinline__ bool keep(const pg8::Unit& u) const { return u.kind < 2; }
    __device__ __forceinline__ void operator()(pg8::f32x4 (&acc)[2][2][4][2], const pg8::Unit& u, int wr, int wc, int fr, int fq) const {
        const int row0 = u.pm * 256 + wr * 64 + fr, col0 = u.pn * 256 + wc * 32 + 8 * fq;
        if (u.kind < 2) {
#pragma unroll
            for (int ai = 0; ai < 2; ++ai)
#pragma unroll
                for (int m = 0; m < 4; ++m) { const bf16* gp = gates + (size_t)(row0 + ai * 128 + m * 16) * NCOL + (size_t)u.kind * DM + col0;
#pragma unroll
                    for (int bj = 0; bj < 2; ++bj) { float za[8], zb[8]; unpack8(*(const v4u*)(gp + bj * 128), za); unpack8(*(const v4u*)(gp + DM + bj * 128), zb);
#pragma unroll
                        for (int j = 0; j < 8; ++j) { const float r = (1.0f + __expf(-zb[j])) * pg8::fast_rcp(1.0f + __expf(-za[j])); acc[ai][bj][m][j >> 2][j & 3] *= r; } } }
        } else {
#pragma unroll
            for (int ai = 0; ai < 2; ++ai)
#pragma unroll
                for (int m = 0; m < 4; ++m) { const size_t row = (size_t)(row0 + ai * 128 + m * 16); const bf16* gp = gates + row * NCOL + (size_t)2 * DM + col0; bf16* rowp = O + row * DM + col0;
#pragma unroll
                    for (int bj = 0; bj < 2; ++bj) { float zc[8], o[8]; unpack8(*(const v4u*)(gp + bj * 128), zc);
#pragma unroll
                        for (int j = 0; j < 8; ++j) o[j] = acc[ai][bj][m][j >> 2][j & 3] * pg8::fast_rcp(1.0f + __expf(-zc[j]));
                        pg8::u32x4 w; w.x = pg8::cvt_pk_bf16(o[0], o[1]); w.y = pg8::cvt_pk_bf16(o[2], o[3]); w.z = pg8::cvt_pk_bf16(o[4], o[5]); w.w = pg8::cvt_pk_bf16(o[6], o[7]);
                        *(pg8::u32x4*)(rowp + bj * 128) = w; } }
        }
    }
};
struct EpiZ {
    static constexpr bool PERM = false; float* C;
    __device__ __forceinline__ bool keep(const pg8::Unit&) const { return false; }
    __device__ __forceinline__ void operator()(pg8::f32x4 (&acc)[2][2][4][2], const pg8::Unit& u, int wr, int wc, int fr, int fq) const {
        const int row0 = u.pm * 256 + wr * 64 + fr, col0 = u.pn * 256 + wc * 32 + 4 * fq;
#pragma unroll
        for (int ai = 0; ai < 2; ++ai)
#pragma unroll
            for (int m = 0; m < 4; ++m) { float* rowp = C + (size_t)(row0 + ai * 128 + m * 16) * DM + col0;
#pragma unroll
                for (int bj = 0; bj < 2; ++bj)
#pragma unroll
                    for (int n = 0; n < 2; ++n) *(pg8::f32x4*)(rowp + bj * 128 + n * 16) = acc[ai][bj][m][n]; }
    }
};
struct EpiSwiglu {
    static constexpr bool PERM = true; bf16* O;
    __device__ __forceinline__ bool keep(const pg8::Unit&) const { return false; }
    __device__ __forceinline__ void operator()(pg8::f32x4 (&acc)[2][2][4][2], const pg8::Unit& u, int wr, int wc, int fr, int fq) const {
        const int row0 = u.pm * 256 + wr * 64 + fr, col0 = u.pn * 128 + wc * 32 + 8 * fq;
#pragma unroll
        for (int ai = 0; ai < 2; ++ai)
#pragma unroll
            for (int m = 0; m < 4; ++m) { bf16* rowp = O + (size_t)(row0 + ai * 128 + m * 16) * FFN + col0; float o[8];
#pragma unroll
                for (int j = 0; j < 8; ++j) { const float g = acc[ai][0][m][j >> 2][j & 3], up = acc[ai][1][m][j >> 2][j & 3]; o[j] = g * pg8::fast_rcp(1.0f + __expf(-g)) * up; }
                pg8::u32x4 w; w.x = pg8::cvt_pk_bf16(o[0], o[1]); w.y = pg8::cvt_pk_bf16(o[2], o[3]); w.z = pg8::cvt_pk_bf16(o[4], o[5]); w.w = pg8::cvt_pk_bf16(o[6], o[7]);
                *(pg8::u32x4*)rowp = w; }
    }
};

#ifndef PH_ENABLE
#define PH_ENABLE 0xffff
#endif
#define PHE(b) ((PH_ENABLE >> (b)) & 1)
#define IN(k) (lo <= (k) && (k) < hi)
#define PHASE_ENTER() do { int t_ = threadIdx.x, b_ = blockIdx.x, g_ = gridDim.x; unsigned char* w_ = args.ws; asm volatile("" : "+v"(t_), "+s"(w_), "+s"(b_), "+s"(g_)); F.tid = t_; F.lane = t_ & 63; F.wave = __builtin_amdgcn_readfirstlane(t_ >> 6); F.ws = w_; \
        bid = b_; F.G = g_; F.vcu = (g_ % 8 == 0) ? (b_ % 8) * (g_ / 8) + b_ / 8 : b_; } while (0)
#define INP(i) ({ int i_ = (i); asm volatile("" : "+s"(i_)); args.in[i_]; })
#define SEAM(k) do { if (N_LAUNCHES == 1 && IN(k) && IN((k) + 1)) { XcdBarrier b_ = bar; unsigned* p_ = bar.bar; asm volatile("" : "+s"(p_)); b_.bar = p_; xcd_barrier(b_); } } while (0)
template <int l> __device__ __forceinline__ void layer_program(Frame& F, const Args& args, const XcdBarrier& bar, const int lo, const int hi, unsigned char* lds) {
    int bid = (int)blockIdx.x;
        const int pb = 1 + PH_PER_LAYER * l;
        const float lambda_init = (l == 0) ? 0.2f : 0.35550906759f;
        if (IN(pb + 0)) { PHASE_ENTER();
            SchedPlain S; S.T.init(M / 256, NCOL / 256, F.G, bid); S.A = (const char*)WSP(bf16, WS_H); S.B = (const char*)(WSP(bf16, WS_WIN) + (size_t)l * NCOL * DM); S.ta = (size_t)256 * DM * 2; S.tb = (size_t)256 * DM * 2;
            EpiProj E{WSP(bf16, WS_PROJ)};
            if constexpr (PHE(1)) pg8::gemm_phase<EpiProj, SchedPlain, true, true>(F.lds + RING_OFF, DM, DM, DM, S, E);
            SEAM(pb + 0);
        }
        if (IN(pb + 1)) { PHASE_ENTER();
            const attn_body::AttnTensors AT{(const attn_body::bf16*)(WSP(bf16, WS_PROJ) + C_DQ), (const attn_body::bf16*)(WSP(bf16, WS_PROJ) + C_DK), (const attn_body::bf16*)(WSP(bf16, WS_PROJ) + C_DV), (attn_body::bf16*)WSP(bf16, WS_ATTO)};
            const attn_body::StaticOrder S((int)F.G, bid);
            if constexpr (PHE(2)) attn_body::attn_phase<attn_body::StaticOrder>((char*)lds + RING_OFF, AT, S);
            __syncthreads();
            if constexpr (PHE(3)) { for (int u = F.vcu; u < 1024; u += F.G) h1_unit(F, l, u);
            pooled_phase(F); }
            SEAM(pb + 1);
        }
        if (IN(pb + 2)) { PHASE_ENTER();
            if constexpr (PHE(4)) { h2_phase(F);
            attn_combine_phase(F, INP(I_LAMBDA) + l * 256, INP(I_SUBLN) + l * 128, lambda_init); }
            SchedPool S; S.G = F.G; S.c = bid; S.A = (const char*)WSP(bf16, WS_POOLED); S.B = (const char*)(WSP(bf16, WS_POOLW) + (size_t)l * 4 * 65536);
            EpiPool E{WSP(bf16, WS_Y) + (size_t)M * 1024, INP(I_POOLSC) + l * 1024};
            if constexpr (PHE(4)) pg8::gemm_phase<EpiPool, SchedPool, true, true>(F.lds + RING_OFF, 256, 1024, 256, S, E);
            SEAM(pb + 2);
        }
        if (IN(pb + 3)) { PHASE_ENTER();
            if constexpr (PHE(5)) for (int u = F.vcu; u < 1024; u += F.G) h3_unit(F, l, u, INP(I_HGNORM) + l * 1024);
            SEAM(pb + 3);
        }
        if (IN(pb + 4)) { PHASE_ENTER();
            SchedUp S; S.T.init(M / 256, DM / 256, F.G, bid); S.Y = (const char*)WSP(bf16, WS_Y); S.W = (const char*)(WSP(bf16, WS_WUP) + (size_t)l * 3 * DM * 1024);
            EpiUp E{WSP(bf16, WS_PROJ) + C_GATE, WSP(bf16, WS_MERGED)};
            if constexpr (PHE(6)) pg8::gemm_phase<EpiUp, SchedUp, true, true>(F.lds + RING_OFF, 1024, 1024, 1024, S, E);
            SEAM(pb + 4);
        }
        if (IN(pb + 5)) { PHASE_ENTER();
            SchedPlain S; S.T.init(M / 256, DM / 256, F.G, bid); S.A = (const char*)WSP(bf16, WS_MERGED); S.B = (const char*)(WSP(bf16, WS_WOUT) + (size_t)l * DM * DM); S.ta = (size_t)256 * DM * 2; S.tb = (size_t)256 * DM * 2;
            EpiZ E{WSP(float, WS_Z)};
            if constexpr (PHE(7)) pg8::gemm_phase<EpiZ, SchedPlain, true, true>(F.lds + RING_OFF, DM, DM, DM, S, E);
            SEAM(pb + 5);
        }
        if (IN(pb + 6)) { PHASE_ENTER();
            if constexpr (PHE(8)) resnorm_phase(F, l == 0 ? INP(I_X) : (const float*)args.out, INP(I_NMPOST) + l * DM, INP(I_NFPRE) + l * DM);
            SEAM(pb + 6);
        }
        if (IN(pb + 7)) { PHASE_ENTER();
            SchedPlain S; S.T.init(M / 256, NGU / 256, F.G, bid); S.A = (const char*)WSP(bf16, WS_H); S.B = (const char*)(WSP(bf16, WS_WGU) + (size_t)l * NGU * DM); S.ta = (size_t)256 * DM * 2; S.tb = (size_t)256 * DM * 2;
            EpiSwiglu E{WSP(bf16, WS_PROJ)};
            if constexpr (PHE(9)) pg8::gemm_phase<EpiSwiglu, SchedPlain, true, true>(F.lds + RING_OFF, DM, DM, DM, S, E);
            SEAM(pb + 7);
        }
        if (IN(pb + 8)) { PHASE_ENTER();
            SchedPlain S; S.T.init(M / 256, DM / 256, F.G, bid); S.A = (const char*)WSP(bf16, WS_PROJ); S.B = (const char*)(WSP(bf16, WS_WDN) + (size_t)l * DM * FFN); S.ta = (size_t)256 * FFN * 2; S.tb = (size_t)256 * FFN * 2;
            EpiZ E{WSP(float, WS_Z)};
            if constexpr (PHE(10)) pg8::gemm_phase<EpiZ, SchedPlain, true, true>(F.lds + RING_OFF, FFN, FFN, FFN, S, E);
            SEAM(pb + 8);
        }
        if (IN(pb + 9)) { PHASE_ENTER();
            if constexpr (PHE(8)) resnorm_phase(F, (const float*)args.out, INP(I_NFPOST) + l * DM, (l + 1 < DEPTH) ? INP(I_NMPRE) + (l + 1) * DM : nullptr);
            SEAM(pb + 9);
        }
    }
__global__ void __launch_bounds__(NTHR, 2) trunk_fwd(Args args) {
    extern __shared__ __attribute__((aligned(16))) unsigned char lds[];
    Frame F;
    F.lds = (LAS unsigned char*)lds;
    F.MISC = (volatile LAS unsigned*)(F.lds + MISC_OFF);
    F.tid = threadIdx.x; F.lane = F.tid & 63; F.wave = __builtin_amdgcn_readfirstlane(F.tid >> 6);
    F.G = gridDim.x; { const int bx = blockIdx.x; F.vcu = (F.G % 8 == 0) ? (bx % 8) * (F.G / 8) + bx / 8 : bx; }
    F.ws = args.ws; F.out = args.out;
    gu32* const ctl = (gu32*)(args.ws + WS_CTL);
    for (int u = F.tid; u < (LDS_BYTES - LDSCTL_OFF) / 4; u += NTHR) ((LAS unsigned*)(F.lds + LDSCTL_OFF))[u] = 0u;
    __syncthreads();
    XcdBarrier bar; bar.bar = (unsigned*)(ctl + CW_BAR); bar.x = 0; bar.st = nullptr;
    if (N_LAUNCHES == 1) bar = xcd_barrier_post((unsigned*)(ctl + CW_BAR), F.MISC + 8);
    const int lo = args.ph_lo, hi = args.ph_hi;
    int bid = (int)blockIdx.x;

    if (IN(0)) { PHASE_ENTER(); if constexpr (PHE(0)) p0_prologue(F, args); SEAM(0); }

    layer_program<0>(F, args, bar, lo, hi, lds);
    layer_program<1>(F, args, bar, lo, hi, lds);
#undef IN
#undef SEAM
#undef PHASE_ENTER
#undef INP
}

extern "C" void kernel_launch(void* const* d_in, const int* in_sizes, int n_in, void* d_out, int out_size, void* d_ws, size_t ws_size, hipStream_t stream) {
    static int grid = 0;
    if (grid == 0) {
        if (n_in != 19 || in_sizes[0] != M * DM || out_size != M * DM || ws_size < WS_END) { fprintf(stderr, "kernel_launch: built for 19 inputs, x and out of %d floats, >= %zu bytes of workspace; got n_in %d, in0 %d, out %d, ws %zu; nothing launched\n", M * DM, (size_t)WS_END, n_in, n_in > 0 ? in_sizes[0] : -1, out_size, ws_size); grid = -1; return; }
        int dev = 0, cus = 0, per_cu = 0;
        if (hipGetDevice(&dev) != hipSuccess || hipDeviceGetAttribute(&cus, hipDeviceAttributeMultiprocessorCount, dev) != hipSuccess) { fprintf(stderr, "kernel_launch: hipGetDevice / hipDeviceGetAttribute failed; nothing launched\n"); grid = -1; return; }
        if (hipFuncSetAttribute((const void*)trunk_fwd, hipFuncAttributeMaxDynamicSharedMemorySize, LDS_BYTES) != hipSuccess) { fprintf(stderr, "kernel_launch: hipFuncSetAttribute failed; nothing launched\n"); grid = -1; return; }
        if (hipOccupancyMaxActiveBlocksPerMultiprocessor(&per_cu, (const void*)trunk_fwd, NTHR, LDS_BYTES) != hipSuccess || per_cu < 1)
            fprintf(stderr, "kernel_launch: note: the occupancy query reports %d workgroups per CU\n", per_cu);
        (void)hipGetLastError();
        grid = cus;
        if (grid != 256) fprintf(stderr, "kernel_launch: %d CUs; the attention unit order is built for 256\n", grid);
    }
    if (grid < 0) return;
    if (hipMemsetAsync((char*)d_ws + WS_CTL, 0, CTL_ZERO_BYTES, stream) != hipSuccess) { fprintf(stderr, "kernel_launch: hipMemsetAsync of the control words failed; nothing launched\n"); return; }
    Args a{};
    for (int i = 0; i < 19; ++i) a.in[i] = (const float*)d_in[i];
    a.out = (float*)d_out; a.ws = (unsigned char*)d_ws;
    for (int li = 0; li < N_LAUNCHES; ++li) {
        a.ph_lo = (N_LAUNCHES == 1) ? 0 : li; a.ph_hi = (N_LAUNCHES == 1) ? NPHASES : li + 1;
        hipLaunchKernelGGL(trunk_fwd, dim3(grid), dim3(NTHR), LDS_BYTES, stream, a);
        const hipError_t le = hipPeekAtLastError();
        if (le != hipSuccess) { fprintf(stderr, "kernel_launch: launch %d failed: %s\n", li, hipGetErrorName(le)); break; }
    }
}
```

```cpp
#include <hip/hip_runtime.h>
#include <hip/hip_bf16.h>
#include <cstdio>
#include <cstdint>
#include <cmath>

namespace pg8 {
#define PG8_LAS __attribute__((address_space(3)))
typedef unsigned short bf16_t;
typedef short bf16x8 __attribute__((ext_vector_type(8)));
typedef float f32x4 __attribute__((ext_vector_type(4)));
typedef float f32x2 __attribute__((ext_vector_type(2)));
typedef unsigned u32x4 __attribute__((ext_vector_type(4)));
typedef unsigned u32x2 __attribute__((ext_vector_type(2)));
constexpr int BM = 256, BK = 64, HALF = 128, HTB = HALF * BK * 2  , STAGE_BYTES = 8 * HTB, NXCD = 8, WGM = 8;

__host__ __device__ __forceinline__ int lds_byte(int r, int c) { const int st = (r >> 4) * 2 + (c >> 5), rr = r & 15, cc = c & 31, ob = rr * 64 + cc * 2; return st * 1024 + (ob ^ (((ob >> 9) & 1) << 5)); }
__host__ __device__ __forceinline__ void stage_rc(int b, int& R, int& C) { const int st = b / 1024, sb = b % 1024, swz = sb ^ (((sb >> 9) & 1) << 5); R = (st >> 1) * 16 + swz / 64; C = (st & 1) * 32 + (swz % 64) / 2; }
__host__ __device__ __forceinline__ int perm32(int rho) { const int n = rho >> 4, i = rho & 15; return 8 * (i >> 2) + 4 * n + (i & 3); }

struct Unit { int pm, pn, kind; const char* a; const char* b; };

struct TileOrder {
    int nM, nN, nwg, G, c;
    __device__ __forceinline__ void init(int nM_, int nN_, int G_, int c_) { nM = nM_; nN = nN_; nwg = nM * nN; G = G_; c = c_; }
    __device__ __forceinline__ bool tile(int i, int& pm, int& pn) const {
        const long L = (long)i * G + c; if (L >= nwg) return false;
        int wgid = (int)L; { const int q = nwg / NXCD, r = nwg % NXCD, xcd = wgid % NXCD, off = wgid / NXCD; wgid = (xcd < r ? xcd * (q + 1) : r * (q + 1) + (xcd - r) * q) + off; }
        const int nig = WGM * nN, gid = wgid / nig, fm = gid * WGM, gsz = (nM - fm) < WGM ? (nM - fm) : WGM;
        pm = fm + ((wgid % nig) % gsz); pn = (wgid % nig) / gsz; return true;
    }
};

__device__ __forceinline__ unsigned cvt_pk_bf16(float lo, float hi) { unsigned r; asm volatile("v_cvt_pk_bf16_f32 %0, %1, %2" : "=v"(r) : "v"(lo), "v"(hi)); return r; }
__device__ __forceinline__ float bf_lo(unsigned w) { return __uint_as_float(w << 16); }
__device__ __forceinline__ float bf_hi(unsigned w) { return __uint_as_float(w & 0xffff0000u); }
__device__ __forceinline__ float fast_exp(float x) { return __builtin_amdgcn_exp2f(x * 1.4426950408889634f); }
__device__ __forceinline__ float fast_rcp(float x) { return __builtin_amdgcn_rcpf(x); }


template <class Epi, class Sched, bool ALIGN_EPI = false, bool SP2 = false>
__device__ __forceinline__ void gemm_phase(PG8_LAS unsigned char* lds, const int K, const int lda, const int ldb, const Sched& S, const Epi& E) {
    int tid = threadIdx.x; asm volatile("" : "+v"(tid));
    const int wid = __builtin_amdgcn_readfirstlane(tid >> 6), lane = tid & 63, wr = wid >> 2, wc = wid & 3, fr = lane & 15, fq = lane >> 4;
    int nt = K / BK; asm volatile("" : "+s"(nt));
    unsigned voffA[2], voffB[2];
#pragma unroll
    for (int i = 0; i < 2; ++i) { int R, C; stage_rc(tid * 16 + i * 8192, R, C); const int Rb = Epi::PERM ? ((R & ~31) + perm32(R & 31)) : R;
        voffA[i] = (unsigned)(R * lda + C) * 2u; voffB[i] = (unsigned)(Rb * ldb + C) * 2u; }
    const size_t kstep = (size_t)(BK * 2);
    const size_t hsA = (size_t)HALF * lda * 2, hsB = (size_t)HALF * ldb * 2;
    const unsigned ldsw = (unsigned)wid * 1024u;
    const int aoff = lds_byte(wr * 64 + fr, fq * 8), boff = lds_byte(wc * 32 + fr, fq * 8);
#define PG8_SA(b, h) (((b) * 2 + (h)) * HTB)
#define PG8_SB(b, h) ((4 + (b) * 2 + (h)) * HTB)
#define PG8_STAGE(bufoff, gbase, voff) do { _Pragma("unroll") for (int _i = 0; _i < 2; ++_i) \
        __builtin_amdgcn_global_load_lds((const unsigned*)((const char*)(gbase) + (voff)[_i]), (PG8_LAS unsigned*)(lds + (bufoff) + ldsw + _i * 8192), 16, 0, 0); } while (0)
#define PG8_LDA(dst, b, h) do { _Pragma("unroll") for (int m = 0; m < 4; ++m) _Pragma("unroll") for (int k = 0; k < 2; ++k) dst[m][k] = *(const PG8_LAS bf16x8*)(lds + PG8_SA(b, h) + aoff + m * 2048 + k * 1024); } while (0)
#define PG8_LDB(dst, b, h) do { _Pragma("unroll") for (int n = 0; n < 2; ++n) _Pragma("unroll") for (int k = 0; k < 2; ++k) dst[n][k] = *(const PG8_LAS bf16x8*)(lds + PG8_SB(b, h) + boff + n * 2048 + k * 1024); } while (0)
#define PG8_MMA(ai, bj, At, Bt) do { __builtin_amdgcn_s_setprio(1); _Pragma("unroll") for (int m = 0; m < 4; ++m) _Pragma("unroll") for (int n = 0; n < 2; ++n) _Pragma("unroll") for (int k = 0; k < 2; ++k) \
        acc[ai][bj][m][n] = __builtin_amdgcn_mfma_f32_16x16x32_bf16(Bt[n][k], At[m][k], acc[ai][bj][m][n], 0, 0, 0); __builtin_amdgcn_s_setprio(0); } while (0)
#define PG8_WAIT_V(n) asm volatile("s_waitcnt vmcnt(" #n ")" ::: "memory")
#define PG8_WAIT_L(n) asm volatile("s_waitcnt lgkmcnt(" #n ")" ::: "memory")
#define PG8_BAR __builtin_amdgcn_s_barrier()
#define PG8_SCHED __builtin_amdgcn_sched_barrier(0)
    Unit cur, nxt; int ui = 0;
    if (!S.next(0, cur)) return;
    f32x4 acc[2][2][4][2];
#pragma unroll
    for (int a = 0; a < 2; ++a)
#pragma unroll
        for (int b = 0; b < 2; ++b)
#pragma unroll
            for (int m = 0; m < 4; ++m)
#pragma unroll
                for (int n = 0; n < 2; ++n) acc[a][b][m][n] = (f32x4){0.f, 0.f, 0.f, 0.f};
    bf16x8 At[4][2], B0[2][2], B1[2][2];
    const char* cA = cur.a; const char* cB = cur.b;
    if constexpr (SP2) {
        PG8_STAGE(PG8_SB(0, 0), cB, voffB); PG8_STAGE(PG8_SB(0, 1), cB + hsB, voffB); PG8_STAGE(PG8_SA(0, 0), cA, voffA); PG8_STAGE(PG8_SA(0, 1), cA + hsA, voffA);
        if (wr == 1) PG8_BAR;
        PG8_WAIT_V(2); PG8_BAR;
        PG8_STAGE(PG8_SB(1, 0), cB + kstep, voffB); PG8_STAGE(PG8_SA(1, 0), cA + kstep, voffA); PG8_STAGE(PG8_SB(1, 1), cB + hsB + kstep, voffB);
        PG8_WAIT_V(6); PG8_BAR;
    } else {
        PG8_STAGE(PG8_SB(0, 0), cB, voffB); PG8_STAGE(PG8_SA(0, 0), cA, voffA); PG8_STAGE(PG8_SB(0, 1), cB + hsB, voffB); PG8_STAGE(PG8_SA(0, 1), cA + hsA, voffA);
        if (wr == 1) PG8_BAR;
        PG8_WAIT_V(4); PG8_BAR;
        PG8_STAGE(PG8_SB(1, 0), cB + kstep, voffB); PG8_STAGE(PG8_SA(1, 0), cA + kstep, voffA); PG8_STAGE(PG8_SB(1, 1), cB + hsB + kstep, voffB);
        PG8_WAIT_V(6); PG8_BAR;
    }
    for (;;) {
        const bool has_next = S.next(ui + 1, nxt);
        const char* nA = has_next ? nxt.a : cA; const char* nB = has_next ? nxt.b : cB;
        for (int t = 0; t < nt; t += 2) {
            const bool last = (t == nt - 2);
            const char* a1 = cA + (size_t)(t + 1) * kstep;
            const char* a2 = last ? nA : cA + (size_t)(t + 2) * kstep; const char* b2 = last ? nB : cB + (size_t)(t + 2) * kstep;
            const char* a3 = a2 + kstep; const char* b3 = b2 + kstep;
            if constexpr (SP2) {
            PG8_LDB(B0, 0, 0); PG8_LDB(B1, 0, 1); PG8_SCHED; PG8_LDA(At, 0, 0); PG8_STAGE(PG8_SA(1, 1), a1 + hsA, voffA);
            PG8_WAIT_V(8); PG8_WAIT_L(0); PG8_BAR; PG8_MMA(0, 0, At, B0); PG8_MMA(0, 1, At, B1); PG8_BAR; PG8_SCHED;
            PG8_LDA(At, 0, 1); PG8_STAGE(PG8_SB(0, 0), b2, voffB); PG8_STAGE(PG8_SB(0, 1), b2 + hsB, voffB); PG8_STAGE(PG8_SA(0, 0), a2, voffA);
            PG8_WAIT_V(8); PG8_WAIT_L(0); PG8_BAR; PG8_MMA(1, 0, At, B0); PG8_MMA(1, 1, At, B1); PG8_BAR; PG8_SCHED;
            PG8_LDB(B0, 1, 0); PG8_LDB(B1, 1, 1); PG8_SCHED; PG8_LDA(At, 1, 0); PG8_STAGE(PG8_SA(0, 1), a2 + hsA, voffA);
            PG8_WAIT_V(8); PG8_WAIT_L(0); PG8_BAR; PG8_MMA(0, 0, At, B0); PG8_MMA(0, 1, At, B1); PG8_BAR; PG8_SCHED;
            PG8_LDA(At, 1, 1); PG8_STAGE(PG8_SB(1, 0), b3, voffB); PG8_STAGE(PG8_SB(1, 1), b3 + hsB, voffB); PG8_STAGE(PG8_SA(1, 0), a3, voffA);
            PG8_WAIT_V(8); PG8_WAIT_L(0); PG8_BAR; PG8_MMA(1, 0, At, B0); PG8_MMA(1, 1, At, B1); PG8_BAR; PG8_SCHED;
            } else {
            PG8_LDB(B0, 0, 0); PG8_SCHED; PG8_LDA(At, 0, 0); PG8_STAGE(PG8_SA(1, 1), a1 + hsA, voffA);
            PG8_WAIT_L(8); PG8_BAR; PG8_WAIT_L(0); PG8_MMA(0, 0, At, B0); PG8_BAR; PG8_SCHED;
            PG8_LDB(B1, 0, 1); PG8_STAGE(PG8_SB(0, 0), b2, voffB);
            PG8_BAR; PG8_WAIT_L(0); PG8_MMA(0, 1, At, B1); PG8_BAR;
            PG8_LDA(At, 0, 1); PG8_STAGE(PG8_SA(0, 0), a2, voffA);
            PG8_BAR; PG8_WAIT_L(0); PG8_MMA(1, 0, At, B0); PG8_BAR; PG8_SCHED;
            PG8_STAGE(PG8_SB(0, 1), b2 + hsB, voffB);
            PG8_WAIT_V(6); PG8_BAR; PG8_MMA(1, 1, At, B1); PG8_BAR;
            PG8_LDB(B0, 1, 0); PG8_SCHED; PG8_LDA(At, 1, 0); PG8_STAGE(PG8_SA(0, 1), a2 + hsA, voffA);
            PG8_WAIT_L(8); PG8_BAR; PG8_WAIT_L(0); PG8_MMA(0, 0, At, B0); PG8_BAR; PG8_SCHED;
            PG8_LDB(B1, 1, 1); PG8_STAGE(PG8_SB(1, 0), b3, voffB);
            PG8_BAR; PG8_WAIT_L(0); PG8_MMA(0, 1, At, B1); PG8_BAR;
            PG8_LDA(At, 1, 1); PG8_STAGE(PG8_SA(1, 0), a3, voffA);
            PG8_BAR; PG8_WAIT_L(0); PG8_MMA(1, 0, At, B0); PG8_BAR; PG8_SCHED;
            PG8_STAGE(PG8_SB(1, 1), b3 + hsB, voffB);
            PG8_WAIT_V(6); PG8_BAR; PG8_MMA(1, 1, At, B1); PG8_BAR;
            }
        }
        if constexpr (ALIGN_EPI) { if (wr == 0) PG8_BAR; }
        E(acc, cur, wr, wc, fr, fq);
        if (!has_next) break;
        if (!E.keep(cur)) {
#pragma unroll
        for (int a = 0; a < 2; ++a)
#pragma unroll
            for (int b = 0; b < 2; ++b)
#pragma unroll
                for (int m = 0; m < 4; ++m)
#pragma unroll
                    for (int n = 0; n < 2; ++n) acc[a][b][m][n] = (f32x4){0.f, 0.f, 0.f, 0.f};
        }
        cur = nxt; cA = nA; cB = nB; ++ui;
        if constexpr (ALIGN_EPI) { if (wr == 1) PG8_BAR; }
    }
    PG8_WAIT_V(0);
    if constexpr (!ALIGN_EPI) { if (wr == 0) PG8_BAR; }
    PG8_BAR;
#undef PG8_SA
#undef PG8_SB
#undef PG8_STAGE
#undef PG8_LDA
#undef PG8_LDB
#undef PG8_MMA
#undef PG8_WAIT_V
#undef PG8_WAIT_L
#undef PG8_BAR
#undef PG8_SCHED
}
}

namespace attn_body {
using bf16=__hip_bfloat16;
using bf16x8=__attribute__((ext_vector_type(8)))short;
using s16x4=__attribute__((ext_vector_type(4)))short;
using f32x16=__attribute__((ext_vector_type(16)))float;
using u32x4=__attribute__((ext_vector_type(4)))unsigned;
constexpr int SEQ=2048,D=64,NVH=32;
constexpr int PQ=20480,PO=2048;
constexpr int NW=8,QBLK=32,QB=QBLK*NW,KVBLK=64,NQB=SEQ/QB;
constexpr int ATTN_UNIT_ROWS=QB;
__device__ __forceinline__ int crow(int r,int hi){return (r&3)+8*(r>>2)+4*hi;}
#define SBAR() __builtin_amdgcn_sched_barrier(0)
__device__ __forceinline__ void cmask(f32x16&p0,f32x16&p1,int jb,int qrel,int hi){
  const float NEG=-INFINITY; int d=qrel-64*jb-4*hi; asm volatile("":"+v"(d));
  #pragma unroll
  for(int r=0;r<16;++r){const int c=(r&3)+8*(r>>2); if(c>d)p0[r]=NEG; if(c+32>d)p1[r]=NEG;}
}

constexpr int NSLOT=3, SLOTB=8192;
constexpr int LDS_K=0, LDS_V=NSLOT*SLOTB, LDS_WS=2*NSLOT*SLOTB, LDS_OST=LDS_WS+NW*64*4, LDS_BYTES=LDS_OST+NW*4096;
constexpr float C2=0.125f*1.4426950408889634f;
__device__ __forceinline__ void glds16(const void*gsrc,unsigned lds_dst){unsigned keep;
  asm volatile("s_mov_b32 %0, m0\n\ts_mov_b32 m0, %2\n\ts_nop 0\n\tglobal_load_lds_dwordx4 %1, off\n\ts_mov_b32 m0, %0":"=&s"(keep):"v"(gsrc),"s"(lds_dst):"memory");}
__device__ __forceinline__ float max3f(float a,float b,float c){float r;asm("v_max3_f32 %0, %1, %2, %3":"=v"(r):"v"(a),"v"(b),"v"(c));return r;}
__device__ __forceinline__ float max2f(float a,float b){float r;asm("v_max_f32_e32 %0, %1, %2":"=v"(r):"v"(a),"v"(b));return r;}
__device__ __forceinline__ float fadd_s(float a,float b){float r;asm("v_add_f32_e32 %0, %1, %2":"=v"(r):"v"(a),"v"(b));return r;}
__device__ __forceinline__ float fsub_s(float a,float b){float r;asm("v_sub_f32_e32 %0, %1, %2":"=v"(r):"v"(a),"v"(b));return r;}
typedef float f32x2_t __attribute__((ext_vector_type(2))); typedef __bf16 bf16x2_t __attribute__((ext_vector_type(2)));
__device__ __forceinline__ unsigned cvtpk_s(float lo,float hi){f32x2_t v={lo,hi};bf16x2_t b=__builtin_convertvector(v,bf16x2_t);return __builtin_bit_cast(unsigned,b);}
#define WAIT_BAR(N) asm volatile("s_waitcnt vmcnt(" #N ") lgkmcnt(0)\n\ts_barrier":::"memory")

__device__ __forceinline__ void qkt(f32x16&p0,f32x16&p1,const char*Kslot,const bf16x8*qr,const f32x16&negm,int r32,int hi){
  const char*kb=Kslot+hi*1024+r32*16;
  #pragma unroll
  for(int d0=0;d0<4;++d0){
    const bf16x8 b0=*reinterpret_cast<const bf16x8*>(kb+d0*2048);
    const bf16x8 b1=*reinterpret_cast<const bf16x8*>(kb+d0*2048+512);
    if(d0==0){p0=__builtin_amdgcn_mfma_f32_32x32x16_bf16(b0,qr[0],negm,0,0,0);p1=__builtin_amdgcn_mfma_f32_32x32x16_bf16(b1,qr[0],negm,0,0,0);}
    else{p0=__builtin_amdgcn_mfma_f32_32x32x16_bf16(b0,qr[d0],p0,0,0,0);p1=__builtin_amdgcn_mfma_f32_32x32x16_bf16(b1,qr[d0],p1,0,0,0);}}
}
typedef __attribute__((address_space(3))) const char* lds_cptr;
typedef short v4i16_t __attribute__((ext_vector_type(4)));
__device__ __forceinline__ void kload8(bf16x8*kf,lds_cptr kp){
  kf[0]=*(const __attribute__((address_space(3))) bf16x8*)(kp);      kf[1]=*(const __attribute__((address_space(3))) bf16x8*)(kp+512);
  kf[2]=*(const __attribute__((address_space(3))) bf16x8*)(kp+2048); kf[3]=*(const __attribute__((address_space(3))) bf16x8*)(kp+2560);
  kf[4]=*(const __attribute__((address_space(3))) bf16x8*)(kp+4096); kf[5]=*(const __attribute__((address_space(3))) bf16x8*)(kp+4608);
  kf[6]=*(const __attribute__((address_space(3))) bf16x8*)(kp+6144); kf[7]=*(const __attribute__((address_space(3))) bf16x8*)(kp+6656);
}
__device__ __forceinline__ void kload2(bf16x8*kf,lds_cptr kp,int j){ kf[2*j]=*(const __attribute__((address_space(3))) bf16x8*)(kp+j*2048); kf[2*j+1]=*(const __attribute__((address_space(3))) bf16x8*)(kp+j*2048+512); }
__device__ __forceinline__ s16x4 vtr(lds_cptr p){ return __builtin_bit_cast(s16x4,__builtin_amdgcn_ds_read_tr16_b64_v4i16((__attribute__((address_space(3))) v4i16_t*)p)); }
__device__ __forceinline__ float rowmax(const f32x16&p0,const f32x16&p1){
  float a=max3f(p0[0],p0[1],p1[0]),b=max3f(p0[2],p0[3],p1[1]);a=max3f(a,p1[2],p1[3]);
  #pragma unroll
  for(int r=4;r<16;r+=4){a=max3f(a,p0[r],p0[r+1]);b=max3f(b,p0[r+2],p0[r+3]);a=max3f(a,p1[r],p1[r+1]);b=max3f(b,p1[r+2],p1[r+3]);}
  const float m=max2f(a,b);
  auto rr=__builtin_amdgcn_permlane32_swap(__float_as_uint(m),__float_as_uint(m),false,false);
  return max2f(__uint_as_float(rr[0]),__uint_as_float(rr[1]));
}
__device__ __forceinline__ void pv(f32x16*o,int vb,bf16x8 pa0,bf16x8 pa1,bf16x8 pa2,bf16x8 pa3){
  #pragma unroll
  for(int d0=0;d0<2;++d0){s16x4 lo[4],hi[4];
    #pragma unroll
    for(int ks=0;ks<4;++ks){
      asm volatile("ds_read_b64_tr_b16 %0,%1 offset:%c2":"=&v"(lo[ks]):"v"(vb),"i"(d0*4096+ks*1024):"memory");
      asm volatile("ds_read_b64_tr_b16 %0,%1 offset:%c2":"=&v"(hi[ks]):"v"(vb),"i"(d0*4096+ks*1024+512):"memory");}
    asm volatile("s_waitcnt lgkmcnt(0)":::"memory");SBAR();
    #define PK(k) (bf16x8){lo[k][0],lo[k][1],lo[k][2],lo[k][3],hi[k][0],hi[k][1],hi[k][2],hi[k][3]}
    o[d0]=__builtin_amdgcn_mfma_f32_32x32x16_bf16(pa0,PK(0),o[d0],0,0,0);
    o[d0]=__builtin_amdgcn_mfma_f32_32x32x16_bf16(pa1,PK(1),o[d0],0,0,0);
    o[d0]=__builtin_amdgcn_mfma_f32_32x32x16_bf16(pa2,PK(2),o[d0],0,0,0);
    o[d0]=__builtin_amdgcn_mfma_f32_32x32x16_bf16(pa3,PK(3),o[d0],0,0,0);
    #undef PK
  }
}

#ifndef ATTN_STORE16
#define ATTN_STORE16(p,v) (*(u32x4*)(p)=(v))
#endif
template<int THRL> __device__ __forceinline__ void attn_unit(int b,int vh,int qb,const bf16*Q,const bf16*__restrict__ K,const bf16*__restrict__ V,bf16*O,char*shm){
  const int hh=vh>>2, qkh=vh>>1, vhh=2*hh+(vh&1);
  const float sig=__builtin_ldexpf(1.4426950408889634f,-(hh+1));
  int tid=threadIdx.x; asm volatile("":"+v"(tid)); const int lane=tid&63,r32=lane&31,hi=lane>>5; const int wid=__builtin_amdgcn_readfirstlane(tid>>6);
  const long rowbase=(long)b*SEQ; const int q0=qb*QB;
  const bf16*Qw=Q+(rowbase+q0+wid*QBLK)*PQ+qkh*D;
  const bf16*Kh=K+rowbase*PQ+qkh*D,*Vh=V+rowbase*PQ+vhh*D;
  const unsigned lds0=(unsigned)(uintptr_t)shm;
  float*wsf=(float*)(shm+LDS_WS)+wid*64;
  const bf16*ksrc=Kh+(long)lane*PQ+wid*8;
  const bf16*vsrc=Vh+(long)(16*(wid&3)+(lane>>2))*PQ+(wid>>2)*32+(lane&3)*8;
  const unsigned kdst=lds0+LDS_K+wid*1024, vdst=lds0+LDS_V+wid*1024;
  #define DMA_K(t,slot) glds16(ksrc+(long)(t)*KVBLK*PQ,(unsigned)__builtin_amdgcn_readfirstlane(kdst+(slot)))
  #define DMA_V(t,slot) glds16(vsrc+(long)(t)*KVBLK*PQ,(unsigned)__builtin_amdgcn_readfirstlane(vdst+(slot)))
  const int vb0=(int)(lds0+LDS_V)+((lane>>4)&1)*32+(lane&3)*8+(4*hi+((lane&15)>>2))*64;
  const char*Kbase=shm+LDS_K; bf16x8 kf[8];
  const lds_cptr shm3=(lds_cptr)shm; const lds_cptr kp0=shm3+LDS_K+hi*1024+r32*16; const lds_cptr vp0=shm3+LDS_V+((lane>>4)&1)*32+(lane&3)*8+(4*hi+((lane&15)>>2))*64;
  const int NT=(q0+QB)/KVBLK;
  DMA_K(0,0);DMA_V(0,0);DMA_K(1,SLOTB);
  bf16x8 qr[4];
  #pragma unroll
  for(int d0=0;d0<4;++d0)qr[d0]=*reinterpret_cast<const bf16x8*>(&Qw[(long)r32*PQ+d0*16+hi*8]);
  float mhat=0.f,l_reg=0.f;f32x16 o[2];o[0]=f32x16{};o[1]=f32x16{};const f32x16 zero16=f32x16{};
  const int qrel=wid*QBLK+r32;
  const float sig64=sig*64.f, chi=sig*(float)(4*hi);
  float sa[16];
  #pragma unroll
  for(int r=0;r<16;++r) sa[r]=__uint_as_float(__builtin_amdgcn_readfirstlane(__float_as_uint(sig*(float)((r&3)+8*(r>>2)))));
  const float sig32=sig*32.f;
  #define ABIAS(P0,P1,t) do{ const float nb0_=fmaf(sig64,(float)((t)-NT),chi)-mhat, nb1_=nb0_+sig32; _Pragma("unroll") for(int r=0;r<16;++r){P0[r]=(P0[r]+sa[r])+nb0_;P1[r]=(P1[r]+sa[r])+nb1_;} }while(0)
  #define CMASK(P0,P1,t) do{int jb_=(t)-(NT-4); if(jb_>=0)cmask(P0,P1,jb_,qrel,hi);}while(0)
  bool resc=false;
  #define START(P0,P1) do{ const float rm=rowmax(P0,P1); resc=false; \
    { const float dl=rm; mhat=fadd_s(mhat,dl); \
      _Pragma("unroll") for(int r=0;r<16;++r){P0[r]=fsub_s(P0[r],dl);P1[r]=fsub_s(P1[r],dl);} } \
    _Pragma("unroll") for(int r=0;r<16;++r)P0[r]=__builtin_amdgcn_exp2f(P0[r]); }while(0)
  #define RESC() do{ if(resc){ asm volatile("s_waitcnt lgkmcnt(0)":::"memory"); \
      _Pragma("unroll") for(int d_=0;d_<2;++d_) _Pragma("unroll") for(int r=0;r<16;++r)o[d_][r]*=wsf[crow(r,hi)]; } }while(0)
  f32x16 pA0,pA1,pB0,pB1;
  int sl_prev=0,sl_cur=0,sl_next=SLOTB;
  #define ROT() do{sl_prev=sl_cur;sl_cur=sl_next;sl_next=(sl_next==(NSLOT-1)*SLOTB)?0:sl_next+SLOTB;}while(0)
  DMA_K(2,2*SLOTB);
  WAIT_BAR(3);
  qkt(pA0,pA1,Kbase,qr,zero16,r32,hi);asm volatile("s_nop 15\n\ts_nop 7":"+v"(pA0),"+v"(pA1));ABIAS(pA0,pA1,0);CMASK(pA0,pA1,0);
  START(pA0,pA1);
  _Pragma("unroll") for(int r=0;r<16;++r)pA1[r]=__builtin_amdgcn_exp2f(pA1[r]);
  WAIT_BAR(0);
  DMA_K(3,0);DMA_V(1,SLOTB);
  ROT();
  kload8(kf,kp0+sl_cur);
  WAIT_BAR(2);
  s16x4 vlo[8],vhi[8]; u32x4 pw0,pw1,pw2,pw3;
  #define PKW(P,B) cvtpk_s(P[B],P[B+1])
  #define PAF(k) __builtin_bit_cast(bf16x8,pw##k)
  #define VFR(i) (bf16x8){vlo[i][0],vlo[i][1],vlo[i][2],vlo[i][3],vhi[i][0],vhi[i][1],vhi[i][2],vhi[i][3]}
  #define PIN(x) asm volatile("":"+v"(x))
  #define MX3(a,b,c) __builtin_fmaxf(__builtin_fmaxf((a),(b)),(c))
  #define GAPA(MF,A0,A1,A2,A3,W0,W1,PW) do{ MF; sacc+=A0; sacc+=A1; sacc+=A2; sacc+=A3; PIN(sacc); W0; W1; PIN(PW); SBAR(); }while(0)
  #define EX(v) __builtin_amdgcn_exp2f(v)
  #define GAPB(MF,X,B) do{ MF; X[B]=EX(X[B]); X[B+1]=EX(X[B+1]); X[B+2]=EX(X[B+2]); X[B+3]=EX(X[B+3]); PIN(X); SBAR(); }while(0)
  #define VRD(i) do{ vlo[i]=vtr(vp_+(((i)>>2)*4096+((i)&3)*1024)); vhi[i]=vtr(vp_+(((i)>>2)*4096+((i)&3)*1024+512)); }while(0)
  #define KRD(G,j) do{ if(G){ kload2(kf,kp0+sl_next,j); SBAR(); } }while(0)
  #define STEP(C0,C1,P0,P1,t,GK,GV,GL) do{ SBAR(); \
    const lds_cptr vp_=vp0+sl_prev; \
    VRD(0); SBAR(); float sacc=(P0[0]+P0[1]); \
    GAPA(C0=__builtin_amdgcn_mfma_f32_32x32x16_bf16(kf[0],qr[0],zero16,0,0,0), P0[2],P0[3],P0[4],P0[5],     pw0[0]=PKW(P0,0), pw0[1]=PKW(P0,2), pw0); \
    VRD(4); SBAR(); GAPA(C1=__builtin_amdgcn_mfma_f32_32x32x16_bf16(kf[1],qr[0],zero16,0,0,0), P0[6],P0[7],P0[8],P0[9],     pw0[2]=PKW(P0,4), pw0[3]=PKW(P0,6), pw0); \
    VRD(1); SBAR(); GAPA(C0=__builtin_amdgcn_mfma_f32_32x32x16_bf16(kf[2],qr[1],C0,0,0,0),   P0[10],P0[11],P0[12],P0[13], pw1[0]=PKW(P0,8), pw1[1]=PKW(P0,10), pw1); \
    VRD(5); SBAR(); GAPA(C1=__builtin_amdgcn_mfma_f32_32x32x16_bf16(kf[3],qr[1],C1,0,0,0),   P0[14],P0[15],P1[0],P1[1],   pw1[2]=PKW(P0,12),pw1[3]=PKW(P0,14), pw1); \
    VRD(2); SBAR(); GAPA(C0=__builtin_amdgcn_mfma_f32_32x32x16_bf16(kf[4],qr[2],C0,0,0,0),   P1[2],P1[3],P1[4],P1[5],     pw2[0]=PKW(P1,0), pw2[1]=PKW(P1,2), pw2); \
    VRD(6); SBAR(); GAPA(C1=__builtin_amdgcn_mfma_f32_32x32x16_bf16(kf[5],qr[2],C1,0,0,0),   P1[6],P1[7],P1[8],P1[9],     pw2[2]=PKW(P1,4), pw2[3]=PKW(P1,6), pw2); \
    VRD(3); SBAR(); GAPA(C0=__builtin_amdgcn_mfma_f32_32x32x16_bf16(kf[6],qr[3],C0,0,0,0),   P1[10],P1[11],P1[12],P1[13], pw3[0]=PKW(P1,8), pw3[1]=PKW(P1,10), pw3); \
    VRD(7); SBAR(); GAPA(C1=__builtin_amdgcn_mfma_f32_32x32x16_bf16(kf[7],qr[3],C1,0,0,0),   P1[14],P1[15],0.f,0.f,       pw3[2]=PKW(P1,12),pw3[3]=PKW(P1,14), pw3); \
    l_reg+=sacc; \
    if(GK){DMA_K((t)+3,sl_cur);} if(GV){DMA_V((t)+1,sl_next);} \
    ABIAS(C0,C1,t); CMASK(C0,C1,t); \
    { float a=MX3(C0[0],C0[1],C1[0]),b=MX3(C0[2],C0[3],C1[1]); a=MX3(a,C1[2],C1[3]); \
      _Pragma("unroll") for(int r=4;r<16;r+=4){a=MX3(a,C0[r],C0[r+1]);b=MX3(b,C0[r+2],C0[r+3]);a=MX3(a,C1[r],C1[r+1]);b=MX3(b,C1[r+2],C1[r+3]);} \
      float rm=__builtin_fmaxf(a,b); { auto rr=__builtin_amdgcn_permlane32_swap(__float_as_uint(rm),__float_as_uint(rm),false,false); rm=__builtin_fmaxf(__uint_as_float(rr[0]),__uint_as_float(rr[1])); } \
      resc=false; \
      if(__builtin_expect(__any(rm>(float)THRL),0)){ const float dl=__builtin_fmaxf(rm,0.f); mhat+=dl; \
        _Pragma("unroll") for(int r=0;r<16;++r){C0[r]-=dl;C1[r]-=dl;} \
        const float f=__builtin_amdgcn_exp2f(-dl); l_reg*=f; if(hi==0)wsf[r32]=f; resc=true; } } \
    SBAR(); \
    GAPB(o[0]=__builtin_amdgcn_mfma_f32_32x32x16_bf16(PAF(0),VFR(0),o[0],0,0,0), C0,0); \
    GAPB(o[1]=__builtin_amdgcn_mfma_f32_32x32x16_bf16(PAF(0),VFR(4),o[1],0,0,0), C0,4); \
    KRD(GL,0); GAPB(o[0]=__builtin_amdgcn_mfma_f32_32x32x16_bf16(PAF(1),VFR(1),o[0],0,0,0), C0,8); \
    KRD(GL,1); GAPB(o[1]=__builtin_amdgcn_mfma_f32_32x32x16_bf16(PAF(1),VFR(5),o[1],0,0,0), C0,12); \
    KRD(GL,2); GAPB(o[0]=__builtin_amdgcn_mfma_f32_32x32x16_bf16(PAF(2),VFR(2),o[0],0,0,0), C1,0); \
    KRD(GL,3); GAPB(o[1]=__builtin_amdgcn_mfma_f32_32x32x16_bf16(PAF(2),VFR(6),o[1],0,0,0), C1,4); \
    GAPB(o[0]=__builtin_amdgcn_mfma_f32_32x32x16_bf16(PAF(3),VFR(3),o[0],0,0,0), C1,8); \
    GAPB(o[1]=__builtin_amdgcn_mfma_f32_32x32x16_bf16(PAF(3),VFR(7),o[1],0,0,0), C1,12); \
    }while(0)
  int t=1;
  #undef CMASK
  #define CMASK(P0,P1,t) do{}while(0)
  for(;t+5<NT;t+=2){
    STEP(pB0,pB1,pA0,pA1,t,true,true,true);     WAIT_BAR(2); RESC(); ROT();
    STEP(pA0,pA1,pB0,pB1,t+1,true,true,true);   WAIT_BAR(2); RESC(); ROT();
  }
  #undef CMASK
  #define CMASK(P0,P1,t) do{int jb_=(t)-(NT-4); if(jb_>=0)cmask(P0,P1,jb_,qrel,hi);}while(0)
  #define ENDW(tt) do{ if((tt)+3<NT){WAIT_BAR(2);} else if((tt)+2<NT){WAIT_BAR(1);} else {WAIT_BAR(0);} }while(0)
  for(;t+1<NT;t+=2){
    STEP(pB0,pB1,pA0,pA1,t,(t+3<NT),(t+1<NT),(t+1<NT));       ENDW(t);   RESC(); ROT();
    STEP(pA0,pA1,pB0,pB1,t+1,(t+4<NT),(t+2<NT),(t+2<NT));     ENDW(t+1); RESC(); ROT();
  }
  STEP(pB0,pB1,pA0,pA1,NT-1,false,false,false); RESC();
  { float sacc=pB0[0]+pB0[1]; _Pragma("unroll") for(int r=2;r<16;++r)sacc+=pB0[r]; _Pragma("unroll") for(int r=0;r<16;++r)sacc+=pB1[r]; l_reg+=sacc;
    pw0=(u32x4){PKW(pB0,0),PKW(pB0,2),PKW(pB0,4),PKW(pB0,6)};pw1=(u32x4){PKW(pB0,8),PKW(pB0,10),PKW(pB0,12),PKW(pB0,14)};pw2=(u32x4){PKW(pB1,0),PKW(pB1,2),PKW(pB1,4),PKW(pB1,6)};pw3=(u32x4){PKW(pB1,8),PKW(pB1,10),PKW(pB1,12),PKW(pB1,14)};
    SBAR(); pv(o,vb0+sl_cur,PAF(0),PAF(1),PAF(2),PAF(3)); }
  #undef PKW
  #undef PAF
  #undef VFR
  #undef PIN
  #undef MX3
  #undef GAPA
  #undef GAPB
  #undef EX
  #undef VRD
  #undef KRD
  #undef STEP
  #undef ENDW
  {auto rr=__builtin_amdgcn_permlane32_swap(__float_as_uint(l_reg),__float_as_uint(l_reg),false,false);l_reg=__uint_as_float(rr[0])+__uint_as_float(rr[1]);}
  if(hi==0)wsf[32+r32]=l_reg;asm volatile("s_waitcnt lgkmcnt(0)":::"memory");
  float rli[16];
  #pragma unroll
  for(int r=0;r<16;++r)rli[r]=__builtin_amdgcn_rcpf(wsf[32+crow(r,hi)]);
  bf16*Ow=O+(rowbase+q0+wid*QBLK)*PO+vh*D;
  { bf16*stg=(bf16*)(shm+LDS_OST)+wid*2048;
    #pragma unroll
    for(int r=0;r<16;++r){const int orow=crow(r,hi);
      #pragma unroll
      for(int d0=0;d0<2;++d0)stg[orow*64+d0*32+r32]=__float2bfloat16(o[d0][r]*rli[r]);}
    asm volatile("s_waitcnt lgkmcnt(0)":::"memory");
    #pragma unroll
    for(int i=0;i<4;++i){const int row=i*8+(lane>>3),ch=lane&7; const u32x4 v=*(const u32x4*)(stg+row*64+ch*8); ATTN_STORE16(Ow+(long)row*PO+ch*8,v);} }
  asm volatile("s_waitcnt lgkmcnt(0)\n\ts_barrier":::"memory");
  #undef DMA_K
  #undef DMA_V
  #undef CMASK
  #undef ABIAS
  #undef START
  #undef RESC
  #undef ROT
}
constexpr int ATTN_LDS_BYTES=LDS_BYTES;
struct AttnTensors { const bf16* Q; const bf16* K; const bf16* V; bf16* O; };
struct AttnUnit { int bh; int qb; };
struct StaticOrder {
  int vcu;
  __device__ __forceinline__ explicit StaticOrder(int grid,int block):vcu((block%8)*(grid/8)+block/8){}
  __device__ __forceinline__ bool next(int i,AttnUnit&u)const{ if(i>=4)return false; const int s=vcu&1; u.bh=vcu>>1; u.qb=(i==0)?s:(i==1)?3-s:(i==2)?4+s:7-s; return true; }
  __device__ __forceinline__ void a_ready(const AttnUnit&)const{}
  __device__ __forceinline__ void done(const AttnUnit&)const{}
};
template<class Sched,int THRL=8> __device__ __forceinline__ void attn_phase(char*lds,const AttnTensors&T,const Sched&S){
  AttnUnit u;
  for(int i=0;S.next(i,u);++i){ S.a_ready(u); attn_unit<THRL>(u.bh/NVH,u.bh%NVH,u.qb,T.Q,T.K,T.V,T.O,lds); S.done(u); }
}
#undef SBAR
#undef WAIT_BAR
}

constexpr int NWAVES = 8, NTHR = NWAVES * 64;
#ifndef MK_N_LAUNCHES
#define MK_N_LAUNCHES 1
#endif
constexpr int N_LAUNCHES = MK_N_LAUNCHES;

constexpr int BATCH = 4, SEQ = 2048, DM = 4096, DEPTH = 2, M = BATCH * SEQ;
constexpr int NCOL = 20480, FFN = 11008, NGU = 2 * FFN;
constexpr int C_HQ = 0, C_HF = 1024, C_HV = 2048, C_HG = 3072, C_PU = 4096, C_DQ = 5120, C_DK = 6144, C_DV = 7168, C_GATE = 8192;
constexpr float EPS = 1e-6f;
constexpr float QSCALE_HG = 0.08838834764831845f;
constexpr int PH_PER_LAYER = 10, NPHASES = 1 + PH_PER_LAYER * DEPTH;
static_assert(N_LAUNCHES == 1 || N_LAUNCHES == NPHASES, "MK_N_LAUNCHES must be 1 or 21");

constexpr size_t MiB = 1u << 20;
constexpr size_t WS_CTL = 0, CTL_ZERO_BYTES = 1 * MiB;
constexpr size_t WS_LB = 1 * MiB;
constexpr size_t WS_POOLW = 2 * MiB;
constexpr size_t WS_WUP = 4 * MiB;
constexpr size_t WS_WOUT = 52 * MiB;
constexpr size_t WS_WDN = 116 * MiB;
constexpr size_t WS_WIN = 288 * MiB;
constexpr size_t WS_WGU = 608 * MiB;
constexpr size_t WS_H = 952 * MiB;
constexpr size_t WS_PROJ = 1016 * MiB;
constexpr size_t WS_ATTO = 1336 * MiB;
constexpr size_t WS_Y = 1368 * MiB;
constexpr size_t WS_POOLED = 1416 * MiB;
constexpr size_t WS_MERGED = 1432 * MiB;
constexpr size_t WS_Z = 1496 * MiB;
constexpr size_t WS_HGL = 1624 * MiB;
constexpr size_t WS_HGS = 1688 * MiB;
constexpr size_t WS_HGD = 1752 * MiB;
constexpr size_t WS_END = 1753 * MiB;
static_assert(WS_WUP + (size_t)DEPTH * 3 * 4096 * 1024 * 2 <= WS_WOUT && WS_WOUT + (size_t)DEPTH * 4096 * 4096 * 2 <= WS_WDN && WS_WDN + (size_t)DEPTH * 4096 * FFN * 2 <= WS_WIN, "ws map 1");
static_assert(WS_WIN + (size_t)DEPTH * NCOL * 4096 * 2 <= WS_WGU && WS_WGU + (size_t)DEPTH * NGU * 4096 * 2 <= WS_H && WS_H + (size_t)M * DM * 2 <= WS_PROJ && WS_PROJ + (size_t)M * NCOL * 2 <= WS_ATTO, "ws map 2");
static_assert(WS_ATTO + (size_t)M * 2048 * 2 <= WS_Y && WS_Y + (size_t)3 * M * 1024 * 2 <= WS_POOLED && WS_POOLED + (size_t)M * 1024 * 2 <= WS_MERGED && WS_MERGED + (size_t)M * DM * 2 <= WS_Z && WS_Z + (size_t)M * DM * 4 <= WS_HGL, "ws map 3");
static_assert(WS_HGL + (size_t)1024 * 16384 * 4 <= WS_HGS && WS_HGS + (size_t)1024 * 16384 * 4 <= WS_HGD && WS_HGD + (size_t)1024 * 128 * 4 <= WS_END && (size_t)M * FFN * 2 <= (size_t)M * NCOL * 2, "ws map 4");
constexpr int CW_BAR = 4096;

constexpr int RING_OFF = 0, RING_BYTES = 131072;
constexpr int LDSCTL_OFF = RING_BYTES, MISC_OFF = LDSCTL_OFF + 320;
constexpr int LDS_BYTES = 147456;
static_assert(MISC_OFF + 128 <= LDS_BYTES, "LDS map");

#define GAS __attribute__((address_space(1)))
#define LAS __attribute__((address_space(3)))
typedef unsigned short bf16;
typedef unsigned v4u __attribute__((ext_vector_type(4)));
typedef unsigned v2u __attribute__((ext_vector_type(2)));
typedef float f32x4 __attribute__((ext_vector_type(4)));
typedef GAS unsigned gu32;
#define RLX_AGENT __ATOMIC_RELAXED, __HIP_MEMORY_SCOPE_AGENT
#define LDS_WAIT() asm volatile("s_waitcnt lgkmcnt(0)" ::: "memory")
#define VM_WAIT() asm volatile("s_waitcnt vmcnt(0)" ::: "memory")
__device__ __forceinline__ unsigned f2bf(float f) { unsigned u = __builtin_bit_cast(unsigned, f); return (u + 0x7fffu + ((u >> 16) & 1u)) >> 16; }
__device__ __forceinline__ unsigned pk2(float lo, float hi) { return f2bf(lo) | (f2bf(hi) << 16); }
__device__ __forceinline__ float bflo(unsigned w) { return __uint_as_float(w << 16); }
__device__ __forceinline__ float bfhi(unsigned w) { return __uint_as_float(w & 0xffff0000u); }
__device__ __forceinline__ void unpack8(const v4u w, float (&f)[8]) { f[0] = bflo(w.x); f[1] = bfhi(w.x); f[2] = bflo(w.y); f[3] = bfhi(w.y); f[4] = bflo(w.z); f[5] = bfhi(w.z); f[6] = bflo(w.w); f[7] = bfhi(w.w); }
__device__ __forceinline__ v4u pack8(const float (&f)[8]) { v4u w; w.x = pk2(f[0], f[1]); w.y = pk2(f[2], f[3]); w.z = pk2(f[4], f[5]); w.w = pk2(f[6], f[7]); return w; }
__device__ __forceinline__ float sigmoidf_(float z) { return 1.0f / (1.0f + __expf(-z)); }

#define XB_TMO      128
#define XB_XCNT(j)  (256  + 64 * (j))
#define XB_XSUB(j)  (1280 + 64 * (j))
#define XB_XGEN(j)  (2304 + 64 * (j))
#define XB_TOP      3328
#define XB_TOPGEN   3392
#define XCD_BAR_WORDS 3456
#define XB_SPIN_CAP (1u << 18)

__device__ __forceinline__ unsigned xb_ld(unsigned* p)              { return __hip_atomic_load(p, __ATOMIC_RELAXED, __HIP_MEMORY_SCOPE_AGENT); }
__device__ __forceinline__ unsigned xb_add(unsigned* p, unsigned v) { return __hip_atomic_fetch_add(p, v, __ATOMIC_RELAXED, __HIP_MEMORY_SCOPE_AGENT); }
__device__ __forceinline__ unsigned xb_xcc_id() { return (unsigned)__builtin_amdgcn_s_getreg((3 << 11) | 20) & 0xFu; }
#define XB_SPIN(cond, bar) do { unsigned _sp = 0; while (cond) { __builtin_amdgcn_s_sleep(1); \
    if ((++_sp & 255u) == 0u) { if (xb_ld(&(bar)[XB_TMO])) break; if (_sp > XB_SPIN_CAP) { atomicAdd(&(bar)[XB_TMO], 1u); break; } } } } while (0)

struct XcdBarrier {
    unsigned* bar; unsigned x;
    volatile LAS unsigned* st;
};

__device__ __forceinline__ XcdBarrier xcd_barrier_post(unsigned* bar, volatile LAS unsigned* st) {
    XcdBarrier b; b.bar = bar; b.x = xb_xcc_id(); b.st = st;
    if (threadIdx.x == 0) (void)xb_add(&bar[XB_XCNT(b.x)], 1u);
    return b;
}
__device__ __forceinline__ void xcd_barrier_complete(unsigned* bar, unsigned x, unsigned& nloc, unsigned& nx) {
    const unsigned G = gridDim.x * gridDim.y * gridDim.z;
    unsigned sum, cnt, mine, sp = 0u;
    for (;;) {
        sum = 0u; cnt = 0u; mine = 0u;
#pragma unroll
        for (unsigned j = 0; j < 16; ++j) { const unsigned c = xb_ld(&bar[XB_XCNT(j)]); sum += c; cnt += (c > 0u) ? 1u : 0u; mine = (j == x) ? c : mine; }
        if (sum == G) break;
        __builtin_amdgcn_s_sleep(1);
        if ((++sp & 255u) == 0u) { if (xb_ld(&bar[XB_TMO])) break; if (sp > XB_SPIN_CAP) { atomicAdd(&bar[XB_TMO], 1u); break; } }
    }
    nloc = mine > 0u ? mine : 1u; nx = cnt > 0u ? cnt : 1u;
}

__device__ __forceinline__ void xcd_barrier(const XcdBarrier& b) {
    asm volatile("s_waitcnt vmcnt(0)" ::: "memory");
    __syncthreads();
    if (threadIdx.x == 0) {
        unsigned* bar = b.bar;
        __builtin_amdgcn_s_waitcnt(0);
        unsigned nloc = b.st[0], nx = b.st[1];
        if (nloc == 0u) { xcd_barrier_complete(bar, b.x, nloc, nx); b.st[0] = nloc; b.st[1] = nx; }
        const unsigned old = xb_add(&bar[XB_XSUB(b.x)], 1u);
        const unsigned gen = old / nloc;
        if (old + 1u == (gen + 1u) * nloc) {
            __builtin_amdgcn_fence(__ATOMIC_RELEASE, "agent");
            asm volatile("s_waitcnt vmcnt(0)" ::: "memory");
            const unsigned og = xb_add(&bar[XB_TOP], 1u);
            const unsigned tg = og / nx;
            if (og + 1u == (tg + 1u) * nx) xb_add(&bar[XB_TOPGEN], 1u);
            else XB_SPIN(xb_ld(&bar[XB_TOPGEN]) == tg, bar);
            __builtin_amdgcn_fence(__ATOMIC_ACQUIRE, "agent");
            xb_add(&bar[XB_XGEN(b.x)], 1u);
            asm volatile("s_waitcnt vmcnt(0)" ::: "memory");
        } else {
            XB_SPIN(xb_ld(&bar[XB_XGEN(b.x)]) == gen, bar);
            __builtin_amdgcn_fence(__ATOMIC_ACQUIRE, "agent");
            asm volatile("s_waitcnt vmcnt(0)" ::: "memory");
        }
    }
    __syncthreads();
}


struct Frame {
    LAS unsigned char* lds;
    volatile LAS unsigned* MISC;
    unsigned char* ws; float* out;
    int tid, lane, wave;
    int vcu, G;
};
#define WSP(T, off) ((T*)(F.ws + (off)))
enum { I_X = 0, I_NMPRE, I_NMPOST, I_NFPRE, I_NFPOST, I_WIN, I_LBLOG, I_HGNORM, I_POOLW, I_POOLSC, I_LAMBDA, I_SUBLN, I_WUPA, I_WUPB, I_WUPC, I_WOUT, I_WGATE, I_WFUP, I_WDOWN };

struct Args { const float* in[19]; float* out; unsigned char* ws; int ph_lo, ph_hi; };

template <int X> __device__ __forceinline__ float xor_lane(float v) {
    if constexpr (X == 32) { const auto rr = __builtin_amdgcn_permlane32_swap(__float_as_uint(v), __float_as_uint(v), false, false); const unsigned a = rr[0], b = rr[1]; return __uint_as_float(a ^ b ^ __float_as_uint(v)); }
    else return __uint_as_float((unsigned)__builtin_amdgcn_ds_swizzle((int)__float_as_uint(v), (X << 10) | 0x1f));
}
__device__ __forceinline__ float wave_sum(float v) {
    v += xor_lane<1>(v); v += xor_lane<2>(v); v += xor_lane<4>(v); v += xor_lane<8>(v); v += xor_lane<16>(v); v += xor_lane<32>(v);
    return v;
}

__device__ __forceinline__ void p0_transpose_item(const float* W, int K, int N, bf16* WT, int drow0, LAS float* scr, int k0, int n0, int lane) {
#pragma unroll 8
    for (int i = 0; i < 32; ++i) { const int kk = 2 * i + (lane >> 5); scr[kk * 33 + (lane & 31)] = W[(size_t)(k0 + kk) * N + n0 + (lane & 31)]; }
    LDS_WAIT(); asm volatile("" ::: "memory");
    const int c = lane & 7;
#pragma unroll
    for (int j = 0; j < 4; ++j) { const int n = (lane >> 3) + 8 * j; const LAS float* s = scr + (8 * c) * 33 + n;
        v4u o; o.x = pk2(s[0 * 33], s[1 * 33]); o.y = pk2(s[2 * 33], s[3 * 33]); o.z = pk2(s[4 * 33], s[5 * 33]); o.w = pk2(s[6 * 33], s[7 * 33]);
        *(GAS v4u*)(WT + (size_t)(drow0 + n) * K + k0 + 8 * c) = o; }
    LDS_WAIT(); asm volatile("" ::: "memory");
}
__device__ __forceinline__ void rms_row_to_bf16(int lane, const float* xrow, const float* gain, bf16* orow) {
    const GAS f32x4* xr = (const GAS f32x4*)xrow + lane; const GAS f32x4* gr = (const GAS f32x4*)gain + lane;
    f32x4 v[16]; float s = 0.f;
#pragma unroll
    for (int j = 0; j < 16; ++j) { v[j] = xr[64 * j]; s += (v[j].x * v[j].x + v[j].y * v[j].y) + (v[j].z * v[j].z + v[j].w * v[j].w); }
    const float rstd = 1.0f / sqrtf(wave_sum(s) * (1.f / DM) + EPS);
    GAS v2u* o8 = (GAS v2u*)orow + lane;
#pragma unroll
    for (int j = 0; j < 16; ++j) { const f32x4 g = gr[64 * j]; v2u w; w.x = pk2(v[j].x * rstd * g.x, v[j].y * rstd * g.y); w.y = pk2(v[j].z * rstd * g.z, v[j].w * rstd * g.w); o8[64 * j] = w; }
}
#define AIN(A, i) ({ int i_ = (i); asm volatile("" : "+s"(i_)); (A).in[i_]; })
__device__ __forceinline__ void p0_prologue(Frame& F, const Args& A) {
    LAS float* scr = (LAS float*)(F.lds + RING_OFF + F.wave * 16384);
    const int gw = F.vcu * NWAVES + F.wave, NGW = F.G * NWAVES;
    constexpr int I_IN = (DM / 64) * (NCOL / 32), I_UP = (1024 / 64) * (DM / 32), I_OUT = (DM / 64) * (DM / 32), I_G = (DM / 64) * (FFN / 32), I_DN = (FFN / 64) * (DM / 32), I_PL = (256 / 64) * (256 / 32);
    constexpr int I_LAYER = I_IN + 3 * I_UP + I_OUT + 2 * I_G + I_DN + 4 * I_PL;
    for (int it = gw; it < DEPTH * I_LAYER; it += NGW) {
        const int l = it / I_LAYER; int r = it - l * I_LAYER;
        const float* W; bf16* WT; int K, N, mode = 0;
        if (r < I_IN) { W = AIN(A, I_WIN) + (size_t)l * DM * NCOL; K = DM; N = NCOL; WT = WSP(bf16, WS_WIN) + (size_t)l * NCOL * DM; }
        else if ((r -= I_IN) < 3 * I_UP) { const int j = r / I_UP; r -= j * I_UP; W = (j == 0 ? AIN(A, I_WUPA) : (j == 1 ? AIN(A, I_WUPB) : AIN(A, I_WUPC))) + (size_t)l * 1024 * DM; K = 1024; N = DM; WT = WSP(bf16, WS_WUP) + ((size_t)l * 3 + j) * DM * 1024; }
        else if ((r -= 3 * I_UP) < I_OUT) { W = AIN(A, I_WOUT) + (size_t)l * DM * DM; K = DM; N = DM; WT = WSP(bf16, WS_WOUT) + (size_t)l * DM * DM; }
        else if ((r -= I_OUT) < 2 * I_G) { const int j = r / I_G; r -= j * I_G; W = (j == 0 ? AIN(A, I_WGATE) : AIN(A, I_WFUP)) + (size_t)l * DM * FFN; K = DM; N = FFN; WT = WSP(bf16, WS_WGU) + (size_t)l * NGU * DM; mode = 1 + j; }
        else if ((r -= 2 * I_G) < I_DN) { W = AIN(A, I_WDOWN) + (size_t)l * FFN * DM; K = FFN; N = DM; WT = WSP(bf16, WS_WDN) + (size_t)l * DM * FFN; }
        else { r -= I_DN; const int g = r / I_PL; r -= g * I_PL; W = AIN(A, I_POOLW) + ((size_t)l * 4 + g) * 65536; K = 256; N = 256; WT = WSP(bf16, WS_POOLW) + ((size_t)l * 4 + g) * 65536; }
        const int nblk = N / 32, kb = r / nblk, nb = r - kb * nblk, n0 = 32 * nb;
        const int drow0 = (mode == 0) ? n0 : ((n0 >> 7) * 256 + (n0 & 127) + (mode == 2 ? 128 : 0));
        p0_transpose_item(W, K, N, WT, drow0, scr, 64 * kb, n0, F.lane);
    }
    if (blockIdx.x == 0) {
        for (int c = F.tid; c < 1024; c += NTHR) {
            float lg[DEPTH], mx = -INFINITY, den = 0.f;
#pragma unroll
            for (int l = 0; l < DEPTH; ++l) { lg[l] = AIN(A, I_LBLOG)[l * 1024 + c]; mx = fmaxf(mx, lg[l]); }
#pragma unroll
            for (int l = 0; l < DEPTH; ++l) { lg[l] = expf(lg[l] - mx); den += lg[l]; }
            float cum = 0.f;
#pragma unroll
            for (int l = 0; l < DEPTH; ++l) { if (l > 0) cum += lg[l] / den; WSP(float, WS_LB)[l * 1024 + c] = cum; }
        }
    }
    for (int m = gw; m < M; m += NGW) rms_row_to_bf16(F.lane, AIN(A, I_X) + (size_t)m * DM, AIN(A, I_NMPRE), WSP(bf16, WS_H) + (size_t)m * DM);
}

__device__ __forceinline__ void resnorm_phase(Frame& F, const float* xold, const float* gpost, const float* gnext) {
    const int gw = F.vcu * NWAVES + F.wave, NGW = F.G * NWAVES;
    for (int m = gw; m < M; m += NGW) {
        const GAS f32x4* zr = (const GAS f32x4*)(WSP(float, WS_Z) + (size_t)m * DM) + F.lane; const GAS f32x4* xr = (const GAS f32x4*)(xold + (size_t)m * DM) + F.lane;
        const GAS f32x4* gp = (const GAS f32x4*)gpost + F.lane;
        f32x4 v[16]; float s = 0.f;
#pragma unroll
        for (int j = 0; j < 16; ++j) { v[j] = zr[64 * j]; s += (v[j].x * v[j].x + v[j].y * v[j].y) + (v[j].z * v[j].z + v[j].w * v[j].w); }
        const float rz = 1.0f / sqrtf(wave_sum(s) * (1.f / DM) + EPS);
        float s2 = 0.f; GAS f32x4* orow = (GAS f32x4*)(F.out + (size_t)m * DM) + F.lane;
#pragma unroll
        for (int j = 0; j < 16; ++j) { const f32x4 x = xr[64 * j], g = gp[64 * j]; v[j] = x + v[j] * rz * g; s2 += (v[j].x * v[j].x + v[j].y * v[j].y) + (v[j].z * v[j].z + v[j].w * v[j].w); orow[64 * j] = v[j]; }
        if (gnext) {
            const float rx = 1.0f / sqrtf(wave_sum(s2) * (1.f / DM) + EPS);
            const GAS f32x4* gn = (const GAS f32x4*)gnext + F.lane; GAS v2u* o8 = (GAS v2u*)(WSP(bf16, WS_H) + (size_t)m * DM) + F.lane;
#pragma unroll
            for (int j = 0; j < 16; ++j) { const f32x4 g = gn[64 * j]; v2u w; w.x = pk2(v[j].x * rx * g.x, v[j].y * rx * g.y); w.y = pk2(v[j].z * rx * g.z, v[j].w * rx * g.w); o8[64 * j] = w; }
        }
    }
}
__device__ __forceinline__ void pooled_phase(Frame& F) {
    const int gt = F.vcu * NTHR + F.tid, NGT = F.G * NTHR;
    for (int it = gt; it < M * 128; it += NGT) {
        const int row = it >> 7, c8 = (it & 127) * 8, g = c8 >> 8, w = 2 << g, t = row & (SEQ - 1), cnt = (t + 1 < w) ? t + 1 : w;
        const bf16* p = WSP(bf16, WS_PROJ) + (size_t)row * NCOL + C_PU + c8;
        float cur[8], sum[8];
        unpack8(*(const GAS v4u*)p, cur);
#pragma unroll
        for (int j = 0; j < 8; ++j) sum[j] = cur[j];
        for (int i = 1; i < cnt; ++i) { float x[8]; unpack8(*(const GAS v4u*)(p - (size_t)i * NCOL), x);
#pragma unroll
            for (int j = 0; j < 8; ++j) sum[j] += x[j]; }
        const float inv = 1.0f / (float)cnt; float o[8];
#pragma unroll
        for (int j = 0; j < 8; ++j) o[j] = sum[j] * inv - cur[j];
        *(GAS v4u*)(WSP(bf16, WS_POOLED) + (size_t)row * 1024 + c8) = pack8(o);
    }
}
__device__ __forceinline__ void attn_combine_phase(Frame& F, const float* lp, const float* sub, float lambda_init) {
    const float lam = expf(wave_sum(lp[F.lane] * lp[64 + F.lane])) - expf(wave_sum(lp[128 + F.lane] * lp[192 + F.lane])) + lambda_init;
    bf16* yc = WSP(bf16, WS_Y) + (size_t)2 * M * 1024;
    const int gt = F.vcu * NTHR + F.tid, NGT = F.G * NTHR;
    for (int it = gt; it < M * 8 * 16; it += NGT) {
        const int l16 = it & 15, rh = it >> 4, h = rh & 7, row = rh >> 3, j = l16 >> 3, wcol = (l16 & 7) * 8;
        const bf16* o1 = WSP(bf16, WS_ATTO) + (size_t)row * 2048 + (h * 4 + j) * 64 + wcol;
        float a[8], b[8], d[8]; unpack8(*(const GAS v4u*)o1, a); unpack8(*(const GAS v4u*)(o1 + 128), b);
        float ss = 0.f;
#pragma unroll
        for (int k = 0; k < 8; ++k) { d[k] = a[k] - lam * b[k]; ss += d[k] * d[k]; }
        ss += xor_lane<1>(ss); ss += xor_lane<2>(ss); ss += xor_lane<4>(ss); ss += xor_lane<8>(ss);
        const float rstd = (1.0f / sqrtf(ss * (1.f / 128.f) + EPS)) * (1.0f - lambda_init);
#pragma unroll
        for (int k = 0; k < 8; ++k) d[k] = d[k] * rstd * sub[l16 * 8 + k];
        *(GAS v4u*)(yc + (size_t)row * 1024 + h * 128 + l16 * 8) = pack8(d);
    }
}

__device__ __forceinline__ void hg_gate(float z, float lb, float& logf_, float& k_) {
    z = fminf(fmaxf(z, -30.f), 30.f);
    const float e = expf(-z), sg = 1.0f / (1.0f + e), om = e * sg;
    logf_ = logf(lb + (1.0f - lb) * sg); k_ = (1.0f - lb) * om;
}
typedef short hbf16x8 __attribute__((ext_vector_type(8)));
__device__ __forceinline__ unsigned short ldg_u16(const bf16* p) { return *(const GAS unsigned short*)p; }
constexpr int HP = 72, QP = 136;
__device__ __forceinline__ void h1_unit(Frame& F, int layer, int u) {
    const int bh = u >> 5, c = u & 31, b = bh >> 3, h = bh & 7; const size_t r0 = (size_t)b * SEQ + c * 64;
    LAS bf16* KDT = (LAS bf16*)(F.lds + RING_OFF); LAS bf16* VT = KDT + 128 * HP; LAS float* TOT = (LAS float*)(F.lds + RING_OFF + 2 * 128 * HP * 2);
    const int ch = F.tid & 127, sc = F.tid >> 7, g = F.lane >> 4, c16 = F.lane & 15;
    const bf16* pf = WSP(bf16, WS_PROJ) + (r0 + 16 * sc) * NCOL + C_HF + h * 128 + ch; const bf16* pv = pf + (C_HV - C_HF);
    const float lb = WSP(float, WS_LB)[layer * 1024 + h * 128 + ch];
    float bl[16], kq[16]; float run = 0.f;
#pragma unroll
    for (int i = 0; i < 16; ++i) { float lf; hg_gate(__uint_as_float((unsigned)ldg_u16(pf + (size_t)i * NCOL) << 16), lb, lf, kq[i]); run += lf; bl[i] = run; }
    TOT[sc * 128 + ch] = run;
    { v4u w0, w1; unsigned w[8];
#pragma unroll
      for (int i = 0; i < 8; ++i) w[i] = (unsigned)ldg_u16(pv + (size_t)(2 * i) * NCOL) | ((unsigned)ldg_u16(pv + (size_t)(2 * i + 1) * NCOL) << 16);
      w0.x = w[0]; w0.y = w[1]; w0.z = w[2]; w0.w = w[3]; w1.x = w[4]; w1.y = w[5]; w1.z = w[6]; w1.w = w[7];
      *(LAS v4u*)(VT + ch * HP + 16 * sc) = w0; *(LAS v4u*)(VT + ch * HP + 16 * sc + 8) = w1; }
    __syncthreads();
    { const float t0 = TOT[ch], t1 = TOT[128 + ch], t2 = TOT[256 + ch], t3 = TOT[384 + ch];
      const float r1 = t0, r2 = t0 + t1, r3 = r2 + t2, tot = r3 + t3, off = (sc == 0) ? 0.f : ((sc == 1) ? r1 : ((sc == 2) ? r2 : r3));
      float kd[16];
#pragma unroll
      for (int i = 0; i < 16; ++i) kd[i] = kq[i] * expf(tot - (off + bl[i]));
      v4u w0, w1; w0.x = pk2(kd[0], kd[1]); w0.y = pk2(kd[2], kd[3]); w0.z = pk2(kd[4], kd[5]); w0.w = pk2(kd[6], kd[7]); w1.x = pk2(kd[8], kd[9]); w1.y = pk2(kd[10], kd[11]); w1.z = pk2(kd[12], kd[13]); w1.w = pk2(kd[14], kd[15]);
      *(LAS v4u*)(KDT + ch * HP + 16 * sc) = w0; *(LAS v4u*)(KDT + ch * HP + 16 * sc + 8) = w1;
      if (sc == 0) WSP(float, WS_HGD)[(size_t)u * 128 + ch] = expf(tot); }
    __syncthreads();
    { const int w = F.wave;
      const hbf16x8 a0 = *(const LAS hbf16x8*)(KDT + (16 * w + c16) * HP + 8 * g), a1 = *(const LAS hbf16x8*)(KDT + (16 * w + c16) * HP + 32 + 8 * g);
      bf16* lt = WSP(bf16, WS_HGL) + (size_t)u * 16384 + 16 * w + 4 * g;
#pragma unroll
      for (int n = 0; n < 8; ++n) {
          const hbf16x8 b0 = *(const LAS hbf16x8*)(VT + (16 * n + c16) * HP + 8 * g), b1 = *(const LAS hbf16x8*)(VT + (16 * n + c16) * HP + 32 + 8 * g);
          f32x4 acc = (f32x4){0.f, 0.f, 0.f, 0.f};
          acc = __builtin_amdgcn_mfma_f32_16x16x32_bf16(a0, b0, acc, 0, 0, 0); acc = __builtin_amdgcn_mfma_f32_16x16x32_bf16(a1, b1, acc, 0, 0, 0);
          v2u o; o.x = pk2(acc[0], acc[1]); o.y = pk2(acc[2], acc[3]);
          *(GAS v2u*)(lt + (size_t)(16 * n + c16) * 128) = o; } }
    __syncthreads();
}
__device__ __forceinline__ void h2_phase(Frame& F) {
    const int gt = F.vcu * NTHR + F.tid, NGT = F.G * NTHR;
    for (int it = gt; it < 32 * 4096; it += NGT) {
        const int bh = it >> 12, e4 = it & 4095, k4 = e4 & 31;
        f32x4 st = (f32x4){0.f, 0.f, 0.f, 0.f};
        for (int c = 0; c < 32; ++c) { const size_t u = (size_t)bh * 32 + c;
            v2u so; so.x = pk2(st[0], st[1]); so.y = pk2(st[2], st[3]);
            *((GAS v2u*)(WSP(bf16, WS_HGS) + u * 16384) + e4) = so;
            const f32x4 d = *((const GAS f32x4*)(WSP(float, WS_HGD) + u * 128) + k4); const v2u lw = *((const GAS v2u*)(WSP(bf16, WS_HGL) + u * 16384) + e4);
            st[0] = d[0] * st[0] + bflo(lw.x); st[1] = d[1] * st[1] + bfhi(lw.x); st[2] = d[2] * st[2] + bflo(lw.y); st[3] = d[3] * st[3] + bfhi(lw.y); }
    }
}
__device__ __forceinline__ void h3_unit(Frame& F, int layer, int u, const float* hgnorm) {
    const int bh = u >> 5, c = u & 31, b = bh >> 3, h = bh & 7; const size_t r0 = (size_t)b * SEQ + c * 64;
    LAS bf16* QE = (LAS bf16*)(F.lds + RING_OFF); LAS bf16* QI = QE + 64 * QP; LAS bf16* KT = QI + 64 * QP; LAS bf16* VT = KT + 160 * QP; LAS bf16* PM = VT + 128 * HP;
    LAS float* TOT = (LAS float*)(PM + 64 * HP); LAS float* SS = TOT + 512;
    static_assert((2 * 64 * QP + 160 * QP + 128 * HP + 64 * HP) * 2 + 512 * 4 + 128 * 4 <= RING_BYTES, "H3 LDS");
    const int ch = F.tid & 127, sc = F.tid >> 7, g = F.lane >> 4, c16 = F.lane & 15;
    const bf16* pf = WSP(bf16, WS_PROJ) + (r0 + 16 * sc) * NCOL + C_HF + h * 128 + ch; const bf16* pq = pf + (C_HQ - C_HF); const bf16* pv = pf + (C_HV - C_HF);
    const float lb = WSP(float, WS_LB)[layer * 1024 + h * 128 + ch];
    float bl[16], kq[16], q[16]; float run = 0.f;
#pragma unroll
    for (int i = 0; i < 16; ++i) { float lf; hg_gate(__uint_as_float((unsigned)ldg_u16(pf + (size_t)i * NCOL) << 16), lb, lf, kq[i]); run += lf; bl[i] = run; q[i] = __uint_as_float((unsigned)ldg_u16(pq + (size_t)i * NCOL) << 16); }
    TOT[sc * 128 + ch] = run;
    { v4u w0, w1; unsigned w[8];
#pragma unroll
      for (int i = 0; i < 8; ++i) w[i] = (unsigned)ldg_u16(pv + (size_t)(2 * i) * NCOL) | ((unsigned)ldg_u16(pv + (size_t)(2 * i + 1) * NCOL) << 16);
      w0.x = w[0]; w0.y = w[1]; w0.z = w[2]; w0.w = w[3]; w1.x = w[4]; w1.y = w[5]; w1.z = w[6]; w1.w = w[7];
      *(LAS v4u*)(VT + ch * HP + 16 * sc) = w0; *(LAS v4u*)(VT + ch * HP + 16 * sc + 8) = w1; }
    for (int i = F.tid; i < 64 * HP * 2 / 16; i += NTHR) ((LAS v4u*)PM)[i] = (v4u){0u, 0u, 0u, 0u};
    __syncthreads();
    { const float t0 = TOT[ch], t1 = TOT[128 + ch], t2 = TOT[256 + ch];
      float rr[4]; rr[0] = 0.f; rr[1] = t0; rr[2] = t0 + t1; rr[3] = rr[2] + t2;
      const float off = (sc == 0) ? rr[0] : ((sc == 1) ? rr[1] : ((sc == 2) ? rr[2] : rr[3]));
#pragma unroll
      for (int i = 0; i < 16; ++i) { const int t = 16 * sc + i; const float bt = off + bl[i];
          QE[t * QP + ch] = (bf16)f2bf(q[i] * expf(bt)); QI[t * QP + ch] = (bf16)f2bf(q[i] * expf(bl[i]));
#pragma unroll
          for (int ii = 0; ii < 4; ++ii) if (ii >= sc) KT[(8 * ii * (ii + 1) + t) * QP + ch] = (bf16)f2bf(kq[i] * expf(rr[ii] - bt)); } }
    __syncthreads();
#pragma unroll
    for (int rep = 0; rep < 2; ++rep) { const int blk = F.wave + 8 * rep;
        if (blk < 10) { const int i = (blk >= 6) ? 3 : ((blk >= 3) ? 2 : ((blk >= 1) ? 1 : 0)), j = blk - (i * (i + 1)) / 2;
            f32x4 acc = (f32x4){0.f, 0.f, 0.f, 0.f};
#pragma unroll
            for (int ks = 0; ks < 4; ++ks) { const hbf16x8 a = *(const LAS hbf16x8*)(QI + (16 * i + c16) * QP + 32 * ks + 8 * g), bb = *(const LAS hbf16x8*)(KT + (8 * i * (i + 1) + 16 * j + c16) * QP + 32 * ks + 8 * g);
                acc = __builtin_amdgcn_mfma_f32_16x16x32_bf16(a, bb, acc, 0, 0, 0); }
#pragma unroll
            for (int r = 0; r < 4; ++r) { const int tl = 4 * g + r; const float val = (i == j && c16 > tl) ? 0.f : acc[r]; PM[(16 * i + tl) * HP + 16 * j + c16] = (bf16)f2bf(val); } } }
    __syncthreads();
    { const int tb = F.wave & 3, vh = F.wave >> 2; f32x4 acc[4];
#pragma unroll
      for (int n = 0; n < 4; ++n) acc[n] = (f32x4){0.f, 0.f, 0.f, 0.f};
      const bf16* st = WSP(bf16, WS_HGS) + (size_t)u * 16384 + (size_t)(64 * vh + c16) * 128 + 8 * g;
#pragma unroll
      for (int ks = 0; ks < 4; ++ks) { const hbf16x8 a = *(const LAS hbf16x8*)(QE + (16 * tb + c16) * QP + 32 * ks + 8 * g);
#pragma unroll
          for (int n = 0; n < 4; ++n) { const hbf16x8 bb = *(const GAS hbf16x8*)(st + (size_t)(16 * n) * 128 + 32 * ks); acc[n] = __builtin_amdgcn_mfma_f32_16x16x32_bf16(a, bb, acc[n], 0, 0, 0); } }
      const int nss = (tb >= 2) ? 2 : 1;
      for (int ss = 0; ss < nss; ++ss) { const hbf16x8 a = *(const LAS hbf16x8*)(PM + (16 * tb + c16) * HP + 32 * ss + 8 * g);
#pragma unroll
          for (int n = 0; n < 4; ++n) { const hbf16x8 bb = *(const LAS hbf16x8*)(VT + (64 * vh + 16 * n + c16) * HP + 32 * ss + 8 * g); acc[n] = __builtin_amdgcn_mfma_f32_16x16x32_bf16(a, bb, acc[n], 0, 0, 0); } }
      float part[4];
#pragma unroll
      for (int r = 0; r < 4; ++r) { float s = 0.f;
#pragma unroll
          for (int n = 0; n < 4; ++n) s += acc[n][r] * acc[n][r];
          s += xor_lane<1>(s); s += xor_lane<2>(s); s += xor_lane<4>(s); s += xor_lane<8>(s); part[r] = s; }
      if (c16 == 0) {
#pragma unroll
          for (int r = 0; r < 4; ++r) SS[vh * 64 + 16 * tb + 4 * g + r] = part[r]; }
      __syncthreads();
#pragma unroll
      for (int r = 0; r < 4; ++r) { const int t = 16 * tb + 4 * g + r; const float rstd = 1.0f / sqrtf((SS[t] + SS[64 + t]) * (1.f / 128.f) + EPS);
          const bf16* gp = WSP(bf16, WS_PROJ) + (r0 + t) * NCOL + C_HG + h * 128 + 64 * vh + c16; bf16* yo = WSP(bf16, WS_Y) + (r0 + t) * 1024 + h * 128 + 64 * vh + c16;
#pragma unroll
          for (int n = 0; n < 4; ++n) { const float gz = __uint_as_float((unsigned)ldg_u16(gp + 16 * n) << 16); const float y = acc[n][r] * rstd * hgnorm[h * 128 + 64 * vh + 16 * n + c16] * (gz * sigmoidf_(gz));
              *(GAS unsigned short*)(yo + 16 * n) = (unsigned short)f2bf(y); } } }
    __syncthreads();
}

struct SchedPlain {
    pg8::TileOrder T; const char* A; const char* B; size_t ta, tb;
    __device__ __forceinline__ bool next(int i, pg8::Unit& u) const { int pm, pn; if (!T.tile(i, pm, pn)) return false; u.pm = pm; u.pn = pn; u.kind = 0; u.a = A + (size_t)pm * ta; u.b = B + (size_t)pn * tb; return true; }
};
struct SchedUp {
    pg8::TileOrder T; const char* Y; const char* W;
    __device__ __forceinline__ bool next(int i, pg8::Unit& u) const { const int ti = i / 3, br = i - 3 * ti; int pm, pn; if (!T.tile(ti, pm, pn)) return false; u.pm = pm; u.pn = pn; u.kind = br;
        u.a = Y + ((size_t)br * M * 1024 + (size_t)pm * 256 * 1024) * 2; u.b = W + ((size_t)br * DM + (size_t)pn * 256) * 1024 * 2; return true; }
};
struct SchedPool {
    int G, c; const char* A; const char* B;
    __device__ __forceinline__ bool next(int i, pg8::Unit& u) const { const int L = i * G + c; if (L >= 128) return false; u.pm = L >> 2; u.pn = L & 3; u.kind = 0;
        u.a = A + ((size_t)u.pm * 256 * 1024 + (size_t)u.pn * 256) * 2; u.b = B + (size_t)u.pn * 65536 * 2; return true; }
};
struct EpiProj {
    static constexpr bool PERM = true; bf16* O;
    __device__ __forceinline__ bool keep(const pg8::Unit&) const { return false; }
    __device__ __forceinline__ void operator()(pg8::f32x4 (&acc)[2][2][4][2], const pg8::Unit& u, int wr, int wc, int fr, int fq) const {
        const float sc = (u.pn < 4) ? QSCALE_HG : ((u.pn >= 20 && u.pn < 24) ? attn_body::C2 : 1.0f);
        const int row0 = u.pm * 256 + wr * 64 + fr, col0 = u.pn * 256 + wc * 32 + 8 * fq;
#pragma unroll
        for (int ai = 0; ai < 2; ++ai)
#pragma unroll
            for (int m = 0; m < 4; ++m) { bf16* rowp = O + (size_t)(row0 + ai * 128 + m * 16) * NCOL + col0;
#pragma unroll
                for (int bj = 0; bj < 2; ++bj) { const pg8::f32x4 v0 = acc[ai][bj][m][0] * sc, v1 = acc[ai][bj][m][1] * sc;
                    pg8::u32x4 w; w.x = pg8::cvt_pk_bf16(v0[0], v0[1]); w.y = pg8::cvt_pk_bf16(v0[2], v0[3]); w.z = pg8::cvt_pk_bf16(v1[0], v1[1]); w.w = pg8::cvt_pk_bf16(v1[2], v1[3]);
                    *(pg8::u32x4*)(rowp + bj * 128) = w; } }
    }
};
struct EpiPool {
    static constexpr bool PERM = true; bf16* O; const float* scale;
    __device__ __forceinline__ bool keep(const pg8::Unit&) const { return false; }
    __device__ __forceinline__ void operator()(pg8::f32x4 (&acc)[2][2][4][2], const pg8::Unit& u, int wr, int wc, int fr, int fq) const {
        const int row0 = u.pm * 256 + wr * 64 + fr, col0 = u.pn * 256 + wc * 32 + 8 * fq;
        pg8::f32x4 sv[2][2];
#pragma unroll
        for (int bj = 0; bj < 2; ++bj)
#pragma unroll
            for (int n = 0; n < 2; ++n) sv[bj][n] = *(const pg8::f32x4*)(scale + col0 + bj * 128 + 4 * n);
#pragma unroll
        for (int ai = 0; ai < 2; ++ai)
#pragma unroll
            for (int m = 0; m < 4; ++m) { bf16* rowp = O + (size_t)(row0 + ai * 128 + m * 16) * 1024 + col0;
#pragma unroll
                for (int bj = 0; bj < 2; ++bj) { const pg8::f32x4 v0 = acc[ai][bj][m][0] * sv[bj][0], v1 = acc[ai][bj][m][1] * sv[bj][1];
                    pg8::u32x4 w; w.x = pg8::cvt_pk_bf16(v0[0], v0[1]); w.y = pg8::cvt_pk_bf16(v0[2], v0[3]); w.z = pg8::cvt_pk_bf16(v1[0], v1[1]); w.w = pg8::cvt_pk_bf16(v1[2], v1[3]);
                    *(pg8::u32x4*)(rowp + bj * 128) = w; } }
    }
};
struct EpiUp {
    static constexpr bool PERM = true; const bf16* gates; bf16* O;
    __device__ __forceinline__ bool keep(const pg8::Unit& u) const { return u.kind < 2; }
    __device__ __forceinline__ void operator()(pg8::f32x4 (&acc)[2][2][4][2], const pg8::Unit& u, int wr, int wc, int fr, int fq) const {
        const int row0 = u.pm * 256 + wr * 64 + fr, col0 = u.pn * 256 + wc * 32 + 8 * fq;
        if (u.kind < 2) {
#pragma unroll
            for (int ai = 0; ai < 2; ++ai)
#pragma unroll
                for (int m = 0; m < 4; ++m) { const bf16* gp = gates + (size_t)(row0 + ai * 128 + m * 16) * NCOL + (size_t)u.kind * DM + col0;
#pragma unroll
                    for (int bj = 0; bj < 2; ++bj) { float za[8], zb[8]; unpack8(*(const v4u*)(gp + bj * 128), za); unpack8(*(const v4u*)(gp + DM + bj * 128), zb);
#pragma unroll
                        for (int j = 0; j < 8; ++j) { const float r = (1.0f + __expf(-zb[j])) * pg8::fast_rcp(1.0f + __expf(-za[j])); acc[ai][bj][m][j >> 2][j & 3] *= r; } } }
        } else {
#pragma unroll
            for (int ai = 0; ai < 2; ++ai)
#pragma unroll
                for (int m = 0; m < 4; ++m) { const size_t row = (size_t)(row0 + ai * 128 + m * 16); const bf16* gp = gates + row * NCOL + (size_t)2 * DM + col0; bf16* rowp = O + row * DM + col0;
#pragma unroll
                    for (int bj = 0; bj < 2; ++bj) { float zc[8], o[8]; unpack8(*(const v4u*)(gp + bj * 128), zc);
#pragma unroll
                        for (int j = 0; j < 8; ++j) o[j] = acc[ai][bj][m][j >> 2][j & 3] * pg8::fast_rcp(1.0f + __expf(-zc[j]));
                        pg8::u32x4 w; w.x = pg8::cvt_pk_bf16(o[0], o[1]); w.y = pg8::cvt_pk_bf16(o[2], o[3]); w.z = pg8::cvt_pk_bf16(o[4], o[5]); w.w = pg8::cvt_pk_bf16(o[6], o[7]);
                        *(pg8::u32x4*)(rowp + bj * 128) = w; } }
        }
    }
};
struct EpiZ {
    static constexpr bool PERM = false; float* C;
    __device__ __forceinline__ bool keep(const pg8::Unit&) const { return false; }
    __device__ __forceinline__ void operator()(pg8::f32x4 (&acc)[2][2][4][2], const pg8::Unit& u, int wr, int wc, int fr, int fq) const {
        const int row0 = u.pm * 256 + wr * 64 + fr, col0 = u.pn * 256 + wc * 32 + 4 * fq;
#pragma unroll
        for (int ai = 0; ai < 2; ++ai)
#pragma unroll
            for (int m = 0; m < 4; ++m) { float* rowp = C + (size_t)(row0 + ai * 128 + m * 16) * DM + col0;
#pragma unroll
                for (int bj = 0; bj < 2; ++bj)
#pragma unroll
                    for (int n = 0; n < 2; ++n) *(pg8::f32x4*)(rowp + bj * 128 + n * 16) = acc[ai][bj][m][n]; }
    }
};
struct EpiSwiglu {
    static constexpr bool PERM = true; bf16* O;
    __device__ __forceinline__ bool keep(const pg8::Unit&) const { return false; }
    __device__ __forceinline__ void operator()(pg8::f32x4 (&acc)[2][2][4][2], const pg8::Unit& u, int wr, int wc, int fr, int fq) const {
        const int row0 = u.pm * 256 + wr * 64 + fr, col0 = u.pn * 128 + wc * 32 + 8 * fq;
#pragma unroll
        for (int ai = 0; ai < 2; ++ai)
#pragma unroll
            for (int m = 0; m < 4; ++m) { bf16* rowp = O + (size_t)(row0 + ai * 128 + m * 16) * FFN + col0; float o[8];
#pragma unroll
                for (int j = 0; j < 8; ++j) { const float g = acc[ai][0][m][j >> 2][j & 3], up = acc[ai][1][m][j >> 2][j & 3]; o[j] = g * pg8::fast_rcp(1.0f + __expf(-g)) * up; }
                pg8::u32x4 w; w.x = pg8::cvt_pk_bf16(o[0], o[1]); w.y = pg8::cvt_pk_bf16(o[2], o[3]); w.z = pg8::cvt_pk_bf16(o[4], o[5]); w.w = pg8::cvt_pk_bf16(o[6], o[7]);
                *(pg8::u32x4*)rowp = w; }
    }
};

#ifndef PH_ENABLE
#define PH_ENABLE 0xffff
#endif
#define PHE(b) ((PH_ENABLE >> (b)) & 1)
#ifndef PH_REPEAT
#define PH_REPEAT 0x0
#endif
#define PHR(b) ((PH_REPEAT >> (b)) & 1)
#define RUN(b, ...) do { if constexpr (PHE(b)) { __VA_ARGS__; } if constexpr (PHR(b)) { __syncthreads(); __VA_ARGS__; } } while (0)
#define IN(k) (lo <= (k) && (k) < hi)
#define PHASE_ENTER() do { int t_ = threadIdx.x, b_ = blockIdx.x, g_ = gridDim.x; unsigned char* w_ = args.ws; asm volatile("" : "+v"(t_), "+s"(w_), "+s"(b_), "+s"(g_)); F.tid = t_; F.lane = t_ & 63; F.wave = __builtin_amdgcn_readfirstlane(t_ >> 6); F.ws = w_; \
        bid = b_; F.G = g_; F.vcu = (g_ % 8 == 0) ? (b_ % 8) * (g_ / 8) + b_ / 8 : b_; } while (0)
#define INP(i) ({ int i_ = (i); asm volatile("" : "+s"(i_)); args.in[i_]; })
#define SEAM(k) do { if (N_LAUNCHES == 1 && IN(k) && IN((k) + 1)) { XcdBarrier b_ = bar; unsigned* p_ = bar.bar; asm volatile("" : "+s"(p_)); b_.bar = p_; xcd_barrier(b_); } } while (0)
template <int l> __device__ __forceinline__ void layer_program(Frame& F, const Args& args, const XcdBarrier& bar, const int lo, const int hi, unsigned char* lds) {
    int bid = (int)blockIdx.x;
        const int pb = 1 + PH_PER_LAYER * l;
        const float lambda_init = (l == 0) ? 0.2f : 0.35550906759f;
        if (IN(pb + 0)) { PHASE_ENTER();
            SchedPlain S; S.T.init(M / 256, NCOL / 256, F.G, bid); S.A = (const char*)WSP(bf16, WS_H); S.B = (const char*)(WSP(bf16, WS_WIN) + (size_t)l * NCOL * DM); S.ta = (size_t)256 * DM * 2; S.tb = (size_t)256 * DM * 2;
            EpiProj E{WSP(bf16, WS_PROJ)};
            RUN(1, pg8::gemm_phase<EpiProj, SchedPlain, true, true>(F.lds + RING_OFF, DM, DM, DM, S, E));
            SEAM(pb + 0);
        }
        if (IN(pb + 1)) { PHASE_ENTER();
            const attn_body::AttnTensors AT{(const attn_body::bf16*)(WSP(bf16, WS_PROJ) + C_DQ), (const attn_body::bf16*)(WSP(bf16, WS_PROJ) + C_DK), (const attn_body::bf16*)(WSP(bf16, WS_PROJ) + C_DV), (attn_body::bf16*)WSP(bf16, WS_ATTO)};
            const attn_body::StaticOrder S((int)F.G, bid);
            RUN(2, attn_body::attn_phase<attn_body::StaticOrder>((char*)lds + RING_OFF, AT, S));
            __syncthreads();
            RUN(3, for (int u = F.vcu; u < 1024; u += F.G) h1_unit(F, l, u); pooled_phase(F));
            SEAM(pb + 1);
        }
        if (IN(pb + 2)) { PHASE_ENTER();
            RUN(4, h2_phase(F); attn_combine_phase(F, INP(I_LAMBDA) + l * 256, INP(I_SUBLN) + l * 128, lambda_init));
            SchedPool S; S.G = F.G; S.c = bid; S.A = (const char*)WSP(bf16, WS_POOLED); S.B = (const char*)(WSP(bf16, WS_POOLW) + (size_t)l * 4 * 65536);
            EpiPool E{WSP(bf16, WS_Y) + (size_t)M * 1024, INP(I_POOLSC) + l * 1024};
            RUN(4, pg8::gemm_phase<EpiPool, SchedPool, true, true>(F.lds + RING_OFF, 256, 1024, 256, S, E));
            SEAM(pb + 2);
        }
        if (IN(pb + 3)) { PHASE_ENTER();
            RUN(5, for (int u = F.vcu; u < 1024; u += F.G) h3_unit(F, l, u, INP(I_HGNORM) + l * 1024));
            SEAM(pb + 3);
        }
        if (IN(pb + 4)) { PHASE_ENTER();
            SchedUp S; S.T.init(M / 256, DM / 256, F.G, bid); S.Y = (const char*)WSP(bf16, WS_Y); S.W = (const char*)(WSP(bf16, WS_WUP) + (size_t)l * 3 * DM * 1024);
            EpiUp E{WSP(bf16, WS_PROJ) + C_GATE, WSP(bf16, WS_MERGED)};
            RUN(6, pg8::gemm_phase<EpiUp, SchedUp, true, true>(F.lds + RING_OFF, 1024, 1024, 1024, S, E));
            SEAM(pb + 4);
        }
        if (IN(pb + 5)) { PHASE_ENTER();
            SchedPlain S; S.T.init(M / 256, DM / 256, F.G, bid); S.A = (const char*)WSP(bf16, WS_MERGED); S.B = (const char*)(WSP(bf16, WS_WOUT) + (size_t)l * DM * DM); S.ta = (size_t)256 * DM * 2; S.tb = (size_t)256 * DM * 2;
            EpiZ E{WSP(float, WS_Z)};
            RUN(7, pg8::gemm_phase<EpiZ, SchedPlain, true, true>(F.lds + RING_OFF, DM, DM, DM, S, E));
            SEAM(pb + 5);
        }
        if (IN(pb + 6)) { PHASE_ENTER();
            RUN(8, resnorm_phase(F, l == 0 ? INP(I_X) : (const float*)args.out, INP(I_NMPOST) + l * DM, INP(I_NFPRE) + l * DM));
            SEAM(pb + 6);
        }
        if (IN(pb + 7)) { PHASE_ENTER();
            SchedPlain S; S.T.init(M / 256, NGU / 256, F.G, bid); S.A = (const char*)WSP(bf16, WS_H); S.B = (const char*)(WSP(bf16, WS_WGU) + (size_t)l * NGU * DM); S.ta = (size_t)256 * DM * 2; S.tb = (size_t)256 * DM * 2;
            EpiSwiglu E{WSP(bf16, WS_PROJ)};
            RUN(9, pg8::gemm_phase<EpiSwiglu, SchedPlain, true, true>(F.lds + RING_OFF, DM, DM, DM, S, E));
            SEAM(pb + 7);
        }
        if (IN(pb + 8)) { PHASE_ENTER();
            SchedPlain S; S.T.init(M / 256, DM / 256, F.G, bid); S.A = (const char*)WSP(bf16, WS_PROJ); S.B = (const char*)(WSP(bf16, WS_WDN) + (size_t)l * DM * FFN); S.ta = (size_t)256 * FFN * 2; S.tb = (size_t)256 * FFN * 2;
            EpiZ E{WSP(float, WS_Z)};
            RUN(10, pg8::gemm_phase<EpiZ, SchedPlain, true, true>(F.lds + RING_OFF, FFN, FFN, FFN, S, E));
            SEAM(pb + 8);
        }
        if (IN(pb + 9)) { PHASE_ENTER();
            RUN(8, resnorm_phase(F, (const float*)args.out, INP(I_NFPOST) + l * DM, (l + 1 < DEPTH) ? INP(I_NMPRE) + (l + 1) * DM : nullptr));
            SEAM(pb + 9);
        }
    }
__global__ void __launch_bounds__(NTHR, 2) trunk_fwd(Args args) {
    extern __shared__ __attribute__((aligned(16))) unsigned char lds[];
    Frame F;
    F.lds = (LAS unsigned char*)lds;
    F.MISC = (volatile LAS unsigned*)(F.lds + MISC_OFF);
    F.tid = threadIdx.x; F.lane = F.tid & 63; F.wave = __builtin_amdgcn_readfirstlane(F.tid >> 6);
    F.G = gridDim.x; { const int bx = blockIdx.x; F.vcu = (F.G % 8 == 0) ? (bx % 8) * (F.G / 8) + bx / 8 : bx; }
    F.ws = args.ws; F.out = args.out;
    gu32* const ctl = (gu32*)(args.ws + WS_CTL);
    for (int u = F.tid; u < (LDS_BYTES - LDSCTL_OFF) / 4; u += NTHR) ((LAS unsigned*)(F.lds + LDSCTL_OFF))[u] = 0u;
    __syncthreads();
    XcdBarrier bar; bar.bar = (unsigned*)(ctl + CW_BAR); bar.x = 0; bar.st = nullptr;
    if (N_LAUNCHES == 1) bar = xcd_barrier_post((unsigned*)(ctl + CW_BAR), F.MISC + 8);
    const int lo = args.ph_lo, hi = args.ph_hi;
    int bid = (int)blockIdx.x;

    if (IN(0)) { PHASE_ENTER(); RUN(0, p0_prologue(F, args)); SEAM(0); }

    layer_program<0>(F, args, bar, lo, hi, lds);
    layer_program<1>(F, args, bar, lo, hi, lds);
#undef IN
#undef SEAM
#undef PHASE_ENTER
#undef INP
}

extern "C" void kernel_launch(void* const* d_in, const int* in_sizes, int n_in, void* d_out, int out_size, void* d_ws, size_t ws_size, hipStream_t stream) {
    static int grid = 0;
    if (grid == 0) {
        if (n_in != 19 || in_sizes[0] != M * DM || out_size != M * DM || ws_size < WS_END) { fprintf(stderr, "kernel_launch: built for 19 inputs, x and out of %d floats, >= %zu bytes of workspace; got n_in %d, in0 %d, out %d, ws %zu; nothing launched\n", M * DM, (size_t)WS_END, n_in, n_in > 0 ? in_sizes[0] : -1, out_size, ws_size); grid = -1; return; }
        int dev = 0, cus = 0, per_cu = 0;
        if (hipGetDevice(&dev) != hipSuccess || hipDeviceGetAttribute(&cus, hipDeviceAttributeMultiprocessorCount, dev) != hipSuccess) { fprintf(stderr, "kernel_launch: hipGetDevice / hipDeviceGetAttribute failed; nothing launched\n"); grid = -1; return; }
        if (hipFuncSetAttribute((const void*)trunk_fwd, hipFuncAttributeMaxDynamicSharedMemorySize, LDS_BYTES) != hipSuccess) { fprintf(stderr, "kernel_launch: hipFuncSetAttribute failed; nothing launched\n"); grid = -1; return; }
        if (hipOccupancyMaxActiveBlocksPerMultiprocessor(&per_cu, (const void*)trunk_fwd, NTHR, LDS_BYTES) != hipSuccess || per_cu < 1)
            fprintf(stderr, "kernel_launch: note: the occupancy query reports %d workgroups per CU\n", per_cu);
        (void)hipGetLastError();
        grid = cus;
        if (grid != 256) fprintf(stderr, "kernel_launch: %d CUs; the attention unit order is built for 256\n", grid);
    }
    if (grid < 0) return;
    if (hipMemsetAsync((char*)d_ws + WS_CTL, 0, CTL_ZERO_BYTES, stream) != hipSuccess) { fprintf(stderr, "kernel_launch: hipMemsetAsync of the control words failed; nothing launched\n"); return; }
    Args a{};
    for (int i = 0; i < 19; ++i) a.in[i] = (const float*)d_in[i];
    a.out = (float*)d_out; a.ws = (unsigned char*)d_ws;
    for (int li = 0; li < N_LAUNCHES; ++li) {
        a.ph_lo = (N_LAUNCHES == 1) ? 0 : li; a.ph_hi = (N_LAUNCHES == 1) ? NPHASES : li + 1;
        hipLaunchKernelGGL(trunk_fwd, dim3(grid), dim3(NTHR), LDS_BYTES, stream, a);
        const hipError_t le = hipPeekAtLastError();
        if (le != hipSuccess) { fprintf(stderr, "kernel_launch: launch %d failed: %s\n", li, hipGetErrorName(le)); break; }
    }
}
```

```cpp
#include <hip/hip_runtime.h>
#include <hip/hip_bf16.h>
#include <cstdio>
#include <cstdint>
#include <cmath>

namespace pg8 {
#define PG8_LAS __attribute__((address_space(3)))
typedef unsigned short bf16_t;
typedef short bf16x8 __attribute__((ext_vector_type(8)));
typedef float f32x4 __attribute__((ext_vector_type(4)));
typedef float f32x2 __attribute__((ext_vector_type(2)));
typedef unsigned u32x4 __attribute__((ext_vector_type(4)));
typedef unsigned u32x2 __attribute__((ext_vector_type(2)));
constexpr int BM = 256, BK = 64, HALF = 128, HTB = HALF * BK * 2  , STAGE_BYTES = 8 * HTB, NXCD = 8, WGM = 8;

__host__ __device__ __forceinline__ int lds_byte(int r, int c) { const int st = (r >> 4) * 2 + (c >> 5), rr = r & 15, cc = c & 31, ob = rr * 64 + cc * 2; return st * 1024 + (ob ^ (((ob >> 9) & 1) << 5)); }
__host__ __device__ __forceinline__ void stage_rc(int b, int& R, int& C) { const int st = b / 1024, sb = b % 1024, swz = sb ^ (((sb >> 9) & 1) << 5); R = (st >> 1) * 16 + swz / 64; C = (st & 1) * 32 + (swz % 64) / 2; }
__host__ __device__ __forceinline__ int perm32(int rho) { const int n = rho >> 4, i = rho & 15; return 8 * (i >> 2) + 4 * n + (i & 3); }

struct Unit { int pm, pn, kind; const char* a; const char* b; };

struct TileOrder {
    int nM, nN, nwg, G, c;
    __device__ __forceinline__ void init(int nM_, int nN_, int G_, int c_) { nM = nM_; nN = nN_; nwg = nM * nN; G = G_; c = c_; }
    __device__ __forceinline__ bool tile(int i, int& pm, int& pn) const {
        const long L = (long)i * G + c; if (L >= nwg) return false;
        int wgid = (int)L; { const int q = nwg / NXCD, r = nwg % NXCD, xcd = wgid % NXCD, off = wgid / NXCD; wgid = (xcd < r ? xcd * (q + 1) : r * (q + 1) + (xcd - r) * q) + off; }
        const int nig = WGM * nN, gid = wgid / nig, fm = gid * WGM, gsz = (nM - fm) < WGM ? (nM - fm) : WGM;
        pm = fm + ((wgid % nig) % gsz); pn = (wgid % nig) / gsz; return true;
    }
};

__device__ __forceinline__ unsigned cvt_pk_bf16(float lo, float hi) { unsigned r; asm volatile("v_cvt_pk_bf16_f32 %0, %1, %2" : "=v"(r) : "v"(lo), "v"(hi)); return r; }
__device__ __forceinline__ float bf_lo(unsigned w) { return __uint_as_float(w << 16); }
__device__ __forceinline__ float bf_hi(unsigned w) { return __uint_as_float(w & 0xffff0000u); }
__device__ __forceinline__ float fast_exp(float x) { return __builtin_amdgcn_exp2f(x * 1.4426950408889634f); }
__device__ __forceinline__ float fast_rcp(float x) { return __builtin_amdgcn_rcpf(x); }


template <class Epi, class Sched, bool ALIGN_EPI = false, bool SP2 = false>
__device__ __forceinline__ void gemm_phase(PG8_LAS unsigned char* lds, const int K, const int lda, const int ldb, const Sched& S, const Epi& E) {
    int tid = threadIdx.x; asm volatile("" : "+v"(tid));
    const int wid = __builtin_amdgcn_readfirstlane(tid >> 6), lane = tid & 63, wr = wid >> 2, wc = wid & 3, fr = lane & 15, fq = lane >> 4;
    int nt = K / BK; asm volatile("" : "+s"(nt));
    unsigned voffA[2], voffB[2];
#pragma unroll
    for (int i = 0; i < 2; ++i) { int R, C; stage_rc(tid * 16 + i * 8192, R, C); const int Rb = Epi::PERM ? ((R & ~31) + perm32(R & 31)) : R;
        voffA[i] = (unsigned)(R * lda + C) * 2u; voffB[i] = (unsigned)(Rb * ldb + C) * 2u; }
    const size_t kstep = (size_t)(BK * 2);
    const size_t hsA = (size_t)HALF * lda * 2, hsB = (size_t)HALF * ldb * 2;
    const unsigned ldsw = (unsigned)wid * 1024u;
    const int aoff = lds_byte(wr * 64 + fr, fq * 8), boff = lds_byte(wc * 32 + fr, fq * 8);
#define PG8_SA(b, h) (((b) * 2 + (h)) * HTB)
#define PG8_SB(b, h) ((4 + (b) * 2 + (h)) * HTB)
#define PG8_STAGE(bufoff, gbase, voff) do { _Pragma("unroll") for (int _i = 0; _i < 2; ++_i) \
        __builtin_amdgcn_global_load_lds((const unsigned*)((const char*)(gbase) + (voff)[_i]), (PG8_LAS unsigned*)(lds + (bufoff) + ldsw + _i * 8192), 16, 0, 0); } while (0)
#define PG8_LDA(dst, b, h) do { _Pragma("unroll") for (int m = 0; m < 4; ++m) _Pragma("unroll") for (int k = 0; k < 2; ++k) dst[m][k] = *(const PG8_LAS bf16x8*)(lds + PG8_SA(b, h) + aoff + m * 2048 + k * 1024); } while (0)
#define PG8_LDB(dst, b, h) do { _Pragma("unroll") for (int n = 0; n < 2; ++n) _Pragma("unroll") for (int k = 0; k < 2; ++k) dst[n][k] = *(const PG8_LAS bf16x8*)(lds + PG8_SB(b, h) + boff + n * 2048 + k * 1024); } while (0)
#define PG8_MMA(ai, bj, At, Bt) do { __builtin_amdgcn_s_setprio(1); _Pragma("unroll") for (int m = 0; m < 4; ++m) _Pragma("unroll") for (int n = 0; n < 2; ++n) _Pragma("unroll") for (int k = 0; k < 2; ++k) \
        acc[ai][bj][m][n] = __builtin_amdgcn_mfma_f32_16x16x32_bf16(Bt[n][k], At[m][k], acc[ai][bj][m][n], 0, 0, 0); __builtin_amdgcn_s_setprio(0); } while (0)
#define PG8_WAIT_V(n) asm volatile("s_waitcnt vmcnt(" #n ")" ::: "memory")
#define PG8_WAIT_L(n) asm volatile("s_waitcnt lgkmcnt(" #n ")" ::: "memory")
#define PG8_BAR __builtin_amdgcn_s_barrier()
#define PG8_SCHED __builtin_amdgcn_sched_barrier(0)
    Unit cur, nxt; int ui = 0;
    if (!S.next(0, cur)) return;
    f32x4 acc[2][2][4][2];
#pragma unroll
    for (int a = 0; a < 2; ++a)
#pragma unroll
        for (int b = 0; b < 2; ++b)
#pragma unroll
            for (int m = 0; m < 4; ++m)
#pragma unroll
                for (int n = 0; n < 2; ++n) acc[a][b][m][n] = (f32x4){0.f, 0.f, 0.f, 0.f};
    bf16x8 At[4][2], B0[2][2], B1[2][2];
    const char* cA = cur.a; const char* cB = cur.b;
    if constexpr (SP2) {
        PG8_STAGE(PG8_SB(0, 0), cB, voffB); PG8_STAGE(PG8_SB(0, 1), cB + hsB, voffB); PG8_STAGE(PG8_SA(0, 0), cA, voffA); PG8_STAGE(PG8_SA(0, 1), cA + hsA, voffA);
        if (wr == 1) PG8_BAR;
        PG8_WAIT_V(2); PG8_BAR;
        PG8_STAGE(PG8_SB(1, 0), cB + kstep, voffB); PG8_STAGE(PG8_SA(1, 0), cA + kstep, voffA); PG8_STAGE(PG8_SB(1, 1), cB + hsB + kstep, voffB);
        PG8_WAIT_V(6); PG8_BAR;
    } else {
        PG8_STAGE(PG8_SB(0, 0), cB, voffB); PG8_STAGE(PG8_SA(0, 0), cA, voffA); PG8_STAGE(PG8_SB(0, 1), cB + hsB, voffB); PG8_STAGE(PG8_SA(0, 1), cA + hsA, voffA);
        if (wr == 1) PG8_BAR;
        PG8_WAIT_V(4); PG8_BAR;
        PG8_STAGE(PG8_SB(1, 0), cB + kstep, voffB); PG8_STAGE(PG8_SA(1, 0), cA + kstep, voffA); PG8_STAGE(PG8_SB(1, 1), cB + hsB + kstep, voffB);
        PG8_WAIT_V(6); PG8_BAR;
    }
    for (;;) {
        const bool has_next = S.next(ui + 1, nxt);
        const char* nA = has_next ? nxt.a : cA; const char* nB = has_next ? nxt.b : cB;
        for (int t = 0; t < nt; t += 2) {
            const bool last = (t == nt - 2);
            const char* a1 = cA + (size_t)(t + 1) * kstep;
            const char* a2 = last ? nA : cA + (size_t)(t + 2) * kstep; const char* b2 = last ? nB : cB + (size_t)(t + 2) * kstep;
            const char* a3 = a2 + kstep; const char* b3 = b2 + kstep;
            if constexpr (SP2) {
            PG8_LDB(B0, 0, 0); PG8_LDB(B1, 0, 1); PG8_SCHED; PG8_LDA(At, 0, 0); PG8_STAGE(PG8_SA(1, 1), a1 + hsA, voffA);
            PG8_WAIT_V(8); PG8_WAIT_L(0); PG8_BAR; PG8_MMA(0, 0, At, B0); PG8_MMA(0, 1, At, B1); PG8_BAR; PG8_SCHED;
            PG8_LDA(At, 0, 1); PG8_STAGE(PG8_SB(0, 0), b2, voffB); PG8_STAGE(PG8_SB(0, 1), b2 + hsB, voffB); PG8_STAGE(PG8_SA(0, 0), a2, voffA);
            PG8_WAIT_V(8); PG8_WAIT_L(0); PG8_BAR; PG8_MMA(1, 0, At, B0); PG8_MMA(1, 1, At, B1); PG8_BAR; PG8_SCHED;
            PG8_LDB(B0, 1, 0); PG8_LDB(B1, 1, 1); PG8_SCHED; PG8_LDA(At, 1, 0); PG8_STAGE(PG8_SA(0, 1), a2 + hsA, voffA);
            PG8_WAIT_V(8); PG8_WAIT_L(0); PG8_BAR; PG8_MMA(0, 0, At, B0); PG8_MMA(0, 1, At, B1); PG8_BAR; PG8_SCHED;
            PG8_LDA(At, 1, 1); PG8_STAGE(PG8_SB(1, 0), b3, voffB); PG8_STAGE(PG8_SB(1, 1), b3 + hsB, voffB); PG8_STAGE(PG8_SA(1, 0), a3, voffA);
            PG8_WAIT_V(8); PG8_WAIT_L(0); PG8_BAR; PG8_MMA(1, 0, At, B0); PG8_MMA(1, 1, At, B1); PG8_BAR; PG8_SCHED;
            } else {
            PG8_LDB(B0, 0, 0); PG8_SCHED; PG8_LDA(At, 0, 0); PG8_STAGE(PG8_SA(1, 1), a1 + hsA, voffA);
            PG8_WAIT_L(8); PG8_BAR; PG8_WAIT_L(0); PG8_MMA(0, 0, At, B0); PG8_BAR; PG8_SCHED;
            PG8_LDB(B1, 0, 1); PG8_STAGE(PG8_SB(0, 0), b2, voffB);
            PG8_BAR; PG8_WAIT_L(0); PG8_MMA(0, 1, At, B1); PG8_BAR;
            PG8_LDA(At, 0, 1); PG8_STAGE(PG8_SA(0, 0), a2, voffA);
            PG8_BAR; PG8_WAIT_L(0); PG8_MMA(1, 0, At, B0); PG8_BAR; PG8_SCHED;
            PG8_STAGE(PG8_SB(0, 1), b2 + hsB, voffB);
            PG8_WAIT_V(6); PG8_BAR; PG8_MMA(1, 1, At, B1); PG8_BAR;
            PG8_LDB(B0, 1, 0); PG8_SCHED; PG8_LDA(At, 1, 0); PG8_STAGE(PG8_SA(0, 1), a2 + hsA, voffA);
            PG8_WAIT_L(8); PG8_BAR; PG8_WAIT_L(0); PG8_MMA(0, 0, At, B0); PG8_BAR; PG8_SCHED;
            PG8_LDB(B1, 1, 1); PG8_STAGE(PG8_SB(1, 0), b3, voffB);
            PG8_BAR; PG8_WAIT_L(0); PG8_MMA(0, 1, At, B1); PG8_BAR;
            PG8_LDA(At, 1, 1); PG8_STAGE(PG8_SA(1, 0), a3, voffA);
            PG8_BAR; PG8_WAIT_L(0); PG8_MMA(1, 0, At, B0); PG8_BAR; PG8_SCHED;
            PG8_STAGE(PG8_SB(1, 1), b3 + hsB, voffB);
            PG8_WAIT_V(6); PG8_BAR; PG8_MMA(1, 1, At, B1); PG8_BAR;
            }
        }
        if constexpr (ALIGN_EPI) { if (wr == 0) PG8_BAR; }
        E(acc, cur, wr, wc, fr, fq);
        if (!has_next) break;
        if (!E.keep(cur)) {
#pragma unroll
        for (int a = 0; a < 2; ++a)
#pragma unroll
            for (int b = 0; b < 2; ++b)
#pragma unroll
                for (int m = 0; m < 4; ++m)
#pragma unroll
                    for (int n = 0; n < 2; ++n) acc[a][b][m][n] = (f32x4){0.f, 0.f, 0.f, 0.f};
        }
        cur = nxt; cA = nA; cB = nB; ++ui;
        if constexpr (ALIGN_EPI) { if (wr == 1) PG8_BAR; }
    }
    PG8_WAIT_V(0);
    if constexpr (!ALIGN_EPI) { if (wr == 0) PG8_BAR; }
    PG8_BAR;
#undef PG8_SA
#undef PG8_SB
#undef PG8_STAGE
#undef PG8_LDA
#undef PG8_LDB
#undef PG8_MMA
#undef PG8_WAIT_V
#undef PG8_WAIT_L
#undef PG8_BAR
#undef PG8_SCHED
}
}

namespace attn_body {
using bf16=__hip_bfloat16;
using bf16x8=__attribute__((ext_vector_type(8)))short;
using s16x4=__attribute__((ext_vector_type(4)))short;
using f32x16=__attribute__((ext_vector_type(16)))float;
using u32x4=__attribute__((ext_vector_type(4)))unsigned;
constexpr int SEQ=2048,D=64,NVH=32;
constexpr int PQ=20480,PO=2048;
constexpr int NW=8,QBLK=32,QB=QBLK*NW,KVBLK=64,NQB=SEQ/QB;
constexpr int ATTN_UNIT_ROWS=QB;
__device__ __forceinline__ int crow(int r,int hi){return (r&3)+8*(r>>2)+4*hi;}
#define SBAR() __builtin_amdgcn_sched_barrier(0)
__device__ __forceinline__ void cmask(f32x16&p0,f32x16&p1,int jb,int qrel,int hi){
  const float NEG=-INFINITY; int d=qrel-64*jb-4*hi; asm volatile("":"+v"(d));
  #pragma unroll
  for(int r=0;r<16;++r){const int c=(r&3)+8*(r>>2); if(c>d)p0[r]=NEG; if(c+32>d)p1[r]=NEG;}
}

constexpr int NSLOT=3, SLOTB=8192;
constexpr int LDS_K=0, LDS_V=NSLOT*SLOTB, LDS_WS=2*NSLOT*SLOTB, LDS_OST=LDS_WS+NW*64*4, LDS_BYTES=LDS_OST+NW*4096;
constexpr float C2=0.125f*1.4426950408889634f;
__device__ __forceinline__ void glds16(const void*gsrc,unsigned lds_dst){unsigned keep;
  asm volatile("s_mov_b32 %0, m0\n\ts_mov_b32 m0, %2\n\ts_nop 0\n\tglobal_load_lds_dwordx4 %1, off\n\ts_mov_b32 m0, %0":"=&s"(keep):"v"(gsrc),"s"(lds_dst):"memory");}
__device__ __forceinline__ float max3f(float a,float b,float c){float r;asm("v_max3_f32 %0, %1, %2, %3":"=v"(r):"v"(a),"v"(b),"v"(c));return r;}
__device__ __forceinline__ float max2f(float a,float b){float r;asm("v_max_f32_e32 %0, %1, %2":"=v"(r):"v"(a),"v"(b));return r;}
__device__ __forceinline__ float fadd_s(float a,float b){float r;asm("v_add_f32_e32 %0, %1, %2":"=v"(r):"v"(a),"v"(b));return r;}
__device__ __forceinline__ float fsub_s(float a,float b){float r;asm("v_sub_f32_e32 %0, %1, %2":"=v"(r):"v"(a),"v"(b));return r;}
typedef float f32x2_t __attribute__((ext_vector_type(2))); typedef __bf16 bf16x2_t __attribute__((ext_vector_type(2)));
__device__ __forceinline__ unsigned cvtpk_s(float lo,float hi){f32x2_t v={lo,hi};bf16x2_t b=__builtin_convertvector(v,bf16x2_t);return __builtin_bit_cast(unsigned,b);}
#define WAIT_BAR(N) asm volatile("s_waitcnt vmcnt(" #N ") lgkmcnt(0)\n\ts_barrier":::"memory")

__device__ __forceinline__ void qkt(f32x16&p0,f32x16&p1,const char*Kslot,const bf16x8*qr,const f32x16&negm,int r32,int hi){
  const char*kb=Kslot+hi*1024+r32*16;
  #pragma unroll
  for(int d0=0;d0<4;++d0){
    const bf16x8 b0=*reinterpret_cast<const bf16x8*>(kb+d0*2048);
    const bf16x8 b1=*reinterpret_cast<const bf16x8*>(kb+d0*2048+512);
    if(d0==0){p0=__builtin_amdgcn_mfma_f32_32x32x16_bf16(b0,qr[0],negm,0,0,0);p1=__builtin_amdgcn_mfma_f32_32x32x16_bf16(b1,qr[0],negm,0,0,0);}
    else{p0=__builtin_amdgcn_mfma_f32_32x32x16_bf16(b0,qr[d0],p0,0,0,0);p1=__builtin_amdgcn_mfma_f32_32x32x16_bf16(b1,qr[d0],p1,0,0,0);}}
}
typedef __attribute__((address_space(3))) const char* lds_cptr;
typedef short v4i16_t __attribute__((ext_vector_type(4)));
__device__ __forceinline__ void kload8(bf16x8*kf,lds_cptr kp){
  kf[0]=*(const __attribute__((address_space(3))) bf16x8*)(kp);      kf[1]=*(const __attribute__((address_space(3))) bf16x8*)(kp+512);
  kf[2]=*(const __attribute__((address_space(3))) bf16x8*)(kp+2048); kf[3]=*(const __attribute__((address_space(3))) bf16x8*)(kp+2560);
  kf[4]=*(const __attribute__((address_space(3))) bf16x8*)(kp+4096); kf[5]=*(const __attribute__((address_space(3))) bf16x8*)(kp+4608);
  kf[6]=*(const __attribute__((address_space(3))) bf16x8*)(kp+6144); kf[7]=*(const __attribute__((address_space(3))) bf16x8*)(kp+6656);
}
__device__ __forceinline__ void kload2(bf16x8*kf,lds_cptr kp,int j){ kf[2*j]=*(const __attribute__((address_space(3))) bf16x8*)(kp+j*2048); kf[2*j+1]=*(const __attribute__((address_space(3))) bf16x8*)(kp+j*2048+512); }
__device__ __forceinline__ s16x4 vtr(lds_cptr p){ return __builtin_bit_cast(s16x4,__builtin_amdgcn_ds_read_tr16_b64_v4i16((__attribute__((address_space(3))) v4i16_t*)p)); }
__device__ __forceinline__ float rowmax(const f32x16&p0,const f32x16&p1){
  float a=max3f(p0[0],p0[1],p1[0]),b=max3f(p0[2],p0[3],p1[1]);a=max3f(a,p1[2],p1[3]);
  #pragma unroll
  for(int r=4;r<16;r+=4){a=max3f(a,p0[r],p0[r+1]);b=max3f(b,p0[r+2],p0[r+3]);a=max3f(a,p1[r],p1[r+1]);b=max3f(b,p1[r+2],p1[r+3]);}
  const float m=max2f(a,b);
  auto rr=__builtin_amdgcn_permlane32_swap(__float_as_uint(m),__float_as_uint(m),false,false);
  return max2f(__uint_as_float(rr[0]),__uint_as_float(rr[1]));
}
__device__ __forceinline__ void pv(f32x16*o,int vb,bf16x8 pa0,bf16x8 pa1,bf16x8 pa2,bf16x8 pa3){
  #pragma unroll
  for(int d0=0;d0<2;++d0){s16x4 lo[4],hi[4];
    #pragma unroll
    for(int ks=0;ks<4;++ks){
      asm volatile("ds_read_b64_tr_b16 %0,%1 offset:%c2":"=&v"(lo[ks]):"v"(vb),"i"(d0*4096+ks*1024):"memory");
      asm volatile("ds_read_b64_tr_b16 %0,%1 offset:%c2":"=&v"(hi[ks]):"v"(vb),"i"(d0*4096+ks*1024+512):"memory");}
    asm volatile("s_waitcnt lgkmcnt(0)":::"memory");SBAR();
    #define PK(k) (bf16x8){lo[k][0],lo[k][1],lo[k][2],lo[k][3],hi[k][0],hi[k][1],hi[k][2],hi[k][3]}
    o[d0]=__builtin_amdgcn_mfma_f32_32x32x16_bf16(pa0,PK(0),o[d0],0,0,0);
    o[d0]=__builtin_amdgcn_mfma_f32_32x32x16_bf16(pa1,PK(1),o[d0],0,0,0);
    o[d0]=__builtin_amdgcn_mfma_f32_32x32x16_bf16(pa2,PK(2),o[d0],0,0,0);
    o[d0]=__builtin_amdgcn_mfma_f32_32x32x16_bf16(pa3,PK(3),o[d0],0,0,0);
    #undef PK
  }
}

#ifndef ATTN_STORE16
#define ATTN_STORE16(p,v) (*(u32x4*)(p)=(v))
#endif
template<int THRL> __device__ __forceinline__ void attn_unit(int b,int vh,int qb,const bf16*Q,const bf16*__restrict__ K,const bf16*__restrict__ V,bf16*O,char*shm){
  const int hh=vh>>2, qkh=vh>>1, vhh=2*hh+(vh&1);
  const float sig=__builtin_ldexpf(1.4426950408889634f,-(hh+1));
  int tid=threadIdx.x; asm volatile("":"+v"(tid)); const int lane=tid&63,r32=lane&31,hi=lane>>5; const int wid=__builtin_amdgcn_readfirstlane(tid>>6);
  const long rowbase=(long)b*SEQ; const int q0=qb*QB;
  const bf16*Qw=Q+(rowbase+q0+wid*QBLK)*PQ+qkh*D;
  const bf16*Kh=K+rowbase*PQ+qkh*D,*Vh=V+rowbase*PQ+vhh*D;
  const unsigned lds0=(unsigned)(uintptr_t)shm;
  float*wsf=(float*)(shm+LDS_WS)+wid*64;
  const bf16*ksrc=Kh+(long)lane*PQ+wid*8;
  const bf16*vsrc=Vh+(long)(16*(wid&3)+(lane>>2))*PQ+(wid>>2)*32+(lane&3)*8;
  const unsigned kdst=lds0+LDS_K+wid*1024, vdst=lds0+LDS_V+wid*1024;
  #define DMA_K(t,slot) glds16(ksrc+(long)(t)*KVBLK*PQ,(unsigned)__builtin_amdgcn_readfirstlane(kdst+(slot)))
  #define DMA_V(t,slot) glds16(vsrc+(long)(t)*KVBLK*PQ,(unsigned)__builtin_amdgcn_readfirstlane(vdst+(slot)))
  const int vb0=(int)(lds0+LDS_V)+((lane>>4)&1)*32+(lane&3)*8+(4*hi+((lane&15)>>2))*64;
  const char*Kbase=shm+LDS_K; bf16x8 kf[8];
  const lds_cptr shm3=(lds_cptr)shm; const lds_cptr kp0=shm3+LDS_K+hi*1024+r32*16; const lds_cptr vp0=shm3+LDS_V+((lane>>4)&1)*32+(lane&3)*8+(4*hi+((lane&15)>>2))*64;
  const int NT=(q0+QB)/KVBLK;
  DMA_K(0,0);DMA_V(0,0);DMA_K(1,SLOTB);
  bf16x8 qr[4];
  #pragma unroll
  for(int d0=0;d0<4;++d0)qr[d0]=*reinterpret_cast<const bf16x8*>(&Qw[(long)r32*PQ+d0*16+hi*8]);
  float mhat=0.f,l_reg=0.f;f32x16 o[2];o[0]=f32x16{};o[1]=f32x16{};const f32x16 zero16=f32x16{};
  const int qrel=wid*QBLK+r32;
  const float sig64=sig*64.f, chi=sig*(float)(4*hi);
  float sa[16];
  #pragma unroll
  for(int r=0;r<16;++r) sa[r]=__uint_as_float(__builtin_amdgcn_readfirstlane(__float_as_uint(sig*(float)((r&3)+8*(r>>2)))));
  const float sig32=sig*32.f;
  #define ABIAS(P0,P1,t) do{ const float nb0_=fmaf(sig64,(float)((t)-NT),chi)-mhat, nb1_=nb0_+sig32; _Pragma("unroll") for(int r=0;r<16;++r){P0[r]=(P0[r]+sa[r])+nb0_;P1[r]=(P1[r]+sa[r])+nb1_;} }while(0)
  #define CMASK(P0,P1,t) do{int jb_=(t)-(NT-4); if(jb_>=0)cmask(P0,P1,jb_,qrel,hi);}while(0)
  bool resc=false;
  #define START(P0,P1) do{ const float rm=rowmax(P0,P1); resc=false; \
    { const float dl=rm; mhat=fadd_s(mhat,dl); \
      _Pragma("unroll") for(int r=0;r<16;++r){P0[r]=fsub_s(P0[r],dl);P1[r]=fsub_s(P1[r],dl);} } \
    _Pragma("unroll") for(int r=0;r<16;++r)P0[r]=__builtin_amdgcn_exp2f(P0[r]); }while(0)
  #define RESC() do{ if(resc){ asm volatile("s_waitcnt lgkmcnt(0)":::"memory"); \
      _Pragma("unroll") for(int d_=0;d_<2;++d_) _Pragma("unroll") for(int r=0;r<16;++r)o[d_][r]*=wsf[crow(r,hi)]; } }while(0)
  f32x16 pA0,pA1,pB0,pB1;
  int sl_prev=0,sl_cur=0,sl_next=SLOTB;
  #define ROT() do{sl_prev=sl_cur;sl_cur=sl_next;sl_next=(sl_next==(NSLOT-1)*SLOTB)?0:sl_next+SLOTB;}while(0)
  DMA_K(2,2*SLOTB);
  WAIT_BAR(3);
  qkt(pA0,pA1,Kbase,qr,zero16,r32,hi);asm volatile("s_nop 15\n\ts_nop 7":"+v"(pA0),"+v"(pA1));ABIAS(pA0,pA1,0);CMASK(pA0,pA1,0);
  START(pA0,pA1);
  _Pragma("unroll") for(int r=0;r<16;++r)pA1[r]=__builtin_amdgcn_exp2f(pA1[r]);
  WAIT_BAR(0);
  DMA_K(3,0);DMA_V(1,SLOTB);
  ROT();
  kload8(kf,kp0+sl_cur);
  WAIT_BAR(2);
  s16x4 vlo[8],vhi[8]; u32x4 pw0,pw1,pw2,pw3;
  #define PKW(P,B) cvtpk_s(P[B],P[B+1])
  #define PAF(k) __builtin_bit_cast(bf16x8,pw##k)
  #define VFR(i) (bf16x8){vlo[i][0],vlo[i][1],vlo[i][2],vlo[i][3],vhi[i][0],vhi[i][1],vhi[i][2],vhi[i][3]}
  #define PIN(x) asm volatile("":"+v"(x))
  #define MX3(a,b,c) __builtin_fmaxf(__builtin_fmaxf((a),(b)),(c))
  #define GAPA(MF,A0,A1,A2,A3,W0,W1,PW) do{ MF; sacc+=A0; sacc+=A1; sacc+=A2; sacc+=A3; PIN(sacc); W0; W1; PIN(PW); SBAR(); }while(0)
  #define EX(v) __builtin_amdgcn_exp2f(v)
  #define GAPB(MF,X,B) do{ MF; X[B]=EX(X[B]); X[B+1]=EX(X[B+1]); X[B+2]=EX(X[B+2]); X[B+3]=EX(X[B+3]); PIN(X); SBAR(); }while(0)
  #define VRD(i) do{ vlo[i]=vtr(vp_+(((i)>>2)*4096+((i)&3)*1024)); vhi[i]=vtr(vp_+(((i)>>2)*4096+((i)&3)*1024+512)); }while(0)
  #define KRD(G,j) do{ if(G){ kload2(kf,kp0+sl_next,j); SBAR(); } }while(0)
  #define STEP(C0,C1,P0,P1,t,GK,GV,GL) do{ SBAR(); \
    const lds_cptr vp_=vp0+sl_prev; \
    VRD(0); SBAR(); float sacc=(P0[0]+P0[1]); \
    GAPA(C0=__builtin_amdgcn_mfma_f32_32x32x16_bf16(kf[0],qr[0],zero16,0,0,0), P0[2],P0[3],P0[4],P0[5],     pw0[0]=PKW(P0,0), pw0[1]=PKW(P0,2), pw0); \
    VRD(4); SBAR(); GAPA(C1=__builtin_amdgcn_mfma_f32_32x32x16_bf16(kf[1],qr[0],zero16,0,0,0), P0[6],P0[7],P0[8],P0[9],     pw0[2]=PKW(P0,4), pw0[3]=PKW(P0,6), pw0); \
    VRD(1); SBAR(); GAPA(C0=__builtin_amdgcn_mfma_f32_32x32x16_bf16(kf[2],qr[1],C0,0,0,0),   P0[10],P0[11],P0[12],P0[13], pw1[0]=PKW(P0,8), pw1[1]=PKW(P0,10), pw1); \
    VRD(5); SBAR(); GAPA(C1=__builtin_amdgcn_mfma_f32_32x32x16_bf16(kf[3],qr[1],C1,0,0,0),   P0[14],P0[15],P1[0],P1[1],   pw1[2]=PKW(P0,12),pw1[3]=PKW(P0,14), pw1); \
    VRD(2); SBAR(); GAPA(C0=__builtin_amdgcn_mfma_f32_32x32x16_bf16(kf[4],qr[2],C0,0,0,0),   P1[2],P1[3],P1[4],P1[5],     pw2[0]=PKW(P1,0), pw2[1]=PKW(P1,2), pw2); \
    VRD(6); SBAR(); GAPA(C1=__builtin_amdgcn_mfma_f32_32x32x16_bf16(kf[5],qr[2],C1,0,0,0),   P1[6],P1[7],P1[8],P1[9],     pw2[2]=PKW(P1,4), pw2[3]=PKW(P1,6), pw2); \
    VRD(3); SBAR(); GAPA(C0=__builtin_amdgcn_mfma_f32_32x32x16_bf16(kf[6],qr[3],C0,0,0,0),   P1[10],P1[11],P1[12],P1[13], pw3[0]=PKW(P1,8), pw3[1]=PKW(P1,10), pw3); \
    VRD(7); SBAR(); GAPA(C1=__builtin_amdgcn_mfma_f32_32x32x16_bf16(kf[7],qr[3],C1,0,0,0),   P1[14],P1[15],0.f,0.f,       pw3[2]=PKW(P1,12),pw3[3]=PKW(P1,14), pw3); \
    l_reg+=sacc; \
    if(GK){DMA_K((t)+3,sl_cur);} if(GV){DMA_V((t)+1,sl_next);} \
    ABIAS(C0,C1,t); CMASK(C0,C1,t); \
    { float a=MX3(C0[0],C0[1],C1[0]),b=MX3(C0[2],C0[3],C1[1]); a=MX3(a,C1[2],C1[3]); \
      _Pragma("unroll") for(int r=4;r<16;r+=4){a=MX3(a,C0[r],C0[r+1]);b=MX3(b,C0[r+2],C0[r+3]);a=MX3(a,C1[r],C1[r+1]);b=MX3(b,C1[r+2],C1[r+3]);} \
      float rm=__builtin_fmaxf(a,b); { auto rr=__builtin_amdgcn_permlane32_swap(__float_as_uint(rm),__float_as_uint(rm),false,false); rm=__builtin_fmaxf(__uint_as_float(rr[0]),__uint_as_float(rr[1])); } \
      resc=false; \
      if(__builtin_expect(__any(rm>(float)THRL),0)){ const float dl=__builtin_fmaxf(rm,0.f); mhat+=dl; \
        _Pragma("unroll") for(int r=0;r<16;++r){C0[r]-=dl;C1[r]-=dl;} \
        const float f=__builtin_amdgcn_exp2f(-dl); l_reg*=f; if(hi==0)wsf[r32]=f; resc=true; } } \
    SBAR(); \
    GAPB(o[0]=__builtin_amdgcn_mfma_f32_32x32x16_bf16(PAF(0),VFR(0),o[0],0,0,0), C0,0); \
    GAPB(o[1]=__builtin_amdgcn_mfma_f32_32x32x16_bf16(PAF(0),VFR(4),o[1],0,0,0), C0,4); \
    KRD(GL,0); GAPB(o[0]=__builtin_amdgcn_mfma_f32_32x32x16_bf16(PAF(1),VFR(1),o[0],0,0,0), C0,8); \
    KRD(GL,1); GAPB(o[1]=__builtin_amdgcn_mfma_f32_32x32x16_bf16(PAF(1),VFR(5),o[1],0,0,0), C0,12); \
    KRD(GL,2); GAPB(o[0]=__builtin_amdgcn_mfma_f32_32x32x16_bf16(PAF(2),VFR(2),o[0],0,0,0), C1,0); \
    KRD(GL,3); GAPB(o[1]=__builtin_amdgcn_mfma_f32_32x32x16_bf16(PAF(2),VFR(6),o[1],0,0,0), C1,4); \
    GAPB(o[0]=__builtin_amdgcn_mfma_f32_32x32x16_bf16(PAF(3),VFR(3),o[0],0,0,0), C1,8); \
    GAPB(o[1]=__builtin_amdgcn_mfma_f32_32x32x16_bf16(PAF(3),VFR(7),o[1],0,0,0), C1,12); \
    }while(0)
  int t=1;
  #undef CMASK
  #define CMASK(P0,P1,t) do{}while(0)
  for(;t+5<NT;t+=2){
    STEP(pB0,pB1,pA0,pA1,t,true,true,true);     WAIT_BAR(2); RESC(); ROT();
    STEP(pA0,pA1,pB0,pB1,t+1,true,true,true);   WAIT_BAR(2); RESC(); ROT();
  }
  #undef CMASK
  #define CMASK(P0,P1,t) do{int jb_=(t)-(NT-4); if(jb_>=0)cmask(P0,P1,jb_,qrel,hi);}while(0)
  #define ENDW(tt) do{ if((tt)+3<NT){WAIT_BAR(2);} else if((tt)+2<NT){WAIT_BAR(1);} else {WAIT_BAR(0);} }while(0)
  for(;t+1<NT;t+=2){
    STEP(pB0,pB1,pA0,pA1,t,(t+3<NT),(t+1<NT),(t+1<NT));       ENDW(t);   RESC(); ROT();
    STEP(pA0,pA1,pB0,pB1,t+1,(t+4<NT),(t+2<NT),(t+2<NT));     ENDW(t+1); RESC(); ROT();
  }
  STEP(pB0,pB1,pA0,pA1,NT-1,false,false,false); RESC();
  { float sacc=pB0[0]+pB0[1]; _Pragma("unroll") for(int r=2;r<16;++r)sacc+=pB0[r]; _Pragma("unroll") for(int r=0;r<16;++r)sacc+=pB1[r]; l_reg+=sacc;
    pw0=(u32x4){PKW(pB0,0),PKW(pB0,2),PKW(pB0,4),PKW(pB0,6)};pw1=(u32x4){PKW(pB0,8),PKW(pB0,10),PKW(pB0,12),PKW(pB0,14)};pw2=(u32x4){PKW(pB1,0),PKW(pB1,2),PKW(pB1,4),PKW(pB1,6)};pw3=(u32x4){PKW(pB1,8),PKW(pB1,10),PKW(pB1,12),PKW(pB1,14)};
    SBAR(); pv(o,vb0+sl_cur,PAF(0),PAF(1),PAF(2),PAF(3)); }
  #undef PKW
  #undef PAF
  #undef VFR
  #undef PIN
  #undef MX3
  #undef GAPA
  #undef GAPB
  #undef EX
  #undef VRD
  #undef KRD
  #undef STEP
  #undef ENDW
  {auto rr=__builtin_amdgcn_permlane32_swap(__float_as_uint(l_reg),__float_as_uint(l_reg),false,false);l_reg=__uint_as_float(rr[0])+__uint_as_float(rr[1]);}
  if(hi==0)wsf[32+r32]=l_reg;asm volatile("s_waitcnt lgkmcnt(0)":::"memory");
  float rli[16];
  #pragma unroll
  for(int r=0;r<16;++r)rli[r]=__builtin_amdgcn_rcpf(wsf[32+crow(r,hi)]);
  bf16*Ow=O+(rowbase+q0+wid*QBLK)*PO+vh*D;
  { bf16*stg=(bf16*)(shm+LDS_OST)+wid*2048;
    #pragma unroll
    for(int r=0;r<16;++r){const int orow=crow(r,hi);
      #pragma unroll
      for(int d0=0;d0<2;++d0)stg[orow*64+d0*32+r32]=__float2bfloat16(o[d0][r]*rli[r]);}
    asm volatile("s_waitcnt lgkmcnt(0)":::"memory");
    #pragma unroll
    for(int i=0;i<4;++i){const int row=i*8+(lane>>3),ch=lane&7; const u32x4 v=*(const u32x4*)(stg+row*64+ch*8); ATTN_STORE16(Ow+(long)row*PO+ch*8,v);} }
  asm volatile("s_waitcnt lgkmcnt(0)\n\ts_barrier":::"memory");
  #undef DMA_K
  #undef DMA_V
  #undef CMASK
  #undef ABIAS
  #undef START
  #undef RESC
  #undef ROT
}
constexpr int ATTN_LDS_BYTES=LDS_BYTES;
struct AttnTensors { const bf16* Q; const bf16* K; const bf16* V; bf16* O; };
struct AttnUnit { int bh; int qb; };
struct StaticOrder {
  int vcu;
  __device__ __forceinline__ explicit StaticOrder(int grid,int block):vcu((block%8)*(grid/8)+block/8){}
  __device__ __forceinline__ bool next(int i,AttnUnit&u)const{ if(i>=4)return false; const int s=vcu&1; u.bh=vcu>>1; u.qb=(i==0)?s:(i==1)?3-s:(i==2)?4+s:7-s; return true; }
  __device__ __forceinline__ void a_ready(const AttnUnit&)const{}
  __device__ __forceinline__ void done(const AttnUnit&)const{}
};
template<class Sched,int THRL=8> __device__ __forceinline__ void attn_phase(char*lds,const AttnTensors&T,const Sched&S){
  AttnUnit u;
  for(int i=0;S.next(i,u);++i){ S.a_ready(u); attn_unit<THRL>(u.bh/NVH,u.bh%NVH,u.qb,T.Q,T.K,T.V,T.O,lds); S.done(u); }
}
#undef SBAR
#undef WAIT_BAR
}

constexpr int NWAVES = 8, NTHR = NWAVES * 64;
#ifndef MK_N_LAUNCHES
#define MK_N_LAUNCHES 1
#endif
constexpr int N_LAUNCHES = MK_N_LAUNCHES;

constexpr int BATCH = 4, SEQ = 2048, DM = 4096, DEPTH = 2, M = BATCH * SEQ;
constexpr int NCOL = 20480, FFN = 11008, NGU = 2 * FFN;
constexpr int C_HQ = 0, C_HF = 1024, C_HV = 2048, C_HG = 3072, C_PU = 4096, C_DQ = 5120, C_DK = 6144, C_DV = 7168, C_GATE = 8192;
constexpr float EPS = 1e-6f;
constexpr float QSCALE_HG = 0.08838834764831845f;
constexpr int PH_PER_LAYER = 10, NPHASES = 1 + PH_PER_LAYER * DEPTH;
static_assert(N_LAUNCHES == 1 || N_LAUNCHES == NPHASES, "MK_N_LAUNCHES must be 1 or 21");

constexpr size_t MiB = 1u << 20;
constexpr size_t WS_CTL = 0, CTL_ZERO_BYTES = 1 * MiB;
constexpr size_t WS_LB = 1 * MiB;
constexpr size_t WS_POOLW = 2 * MiB;
constexpr size_t WS_WUP = 4 * MiB;
constexpr size_t WS_WOUT = 52 * MiB;
constexpr size_t WS_WDN = 116 * MiB;
constexpr size_t WS_WIN = 288 * MiB;
constexpr size_t WS_WGU = 608 * MiB;
constexpr size_t WS_H = 952 * MiB;
constexpr size_t WS_PROJ = 1016 * MiB;
constexpr size_t WS_ATTO = 1336 * MiB;
constexpr size_t WS_Y = 1368 * MiB;
constexpr size_t WS_POOLED = 1416 * MiB;
constexpr size_t WS_MERGED = 1432 * MiB;
constexpr size_t WS_Z = 1496 * MiB;
constexpr size_t WS_HGL = 1624 * MiB;
constexpr size_t WS_HGS = 1688 * MiB;
constexpr size_t WS_HGD = 1752 * MiB;
constexpr size_t WS_XB = 1560 * MiB, WS_XC = 1753 * MiB;
constexpr size_t WS_END = 1817 * MiB;
static_assert(WS_WUP + (size_t)DEPTH * 3 * 4096 * 1024 * 2 <= WS_WOUT && WS_WOUT + (size_t)DEPTH * 4096 * 4096 * 2 <= WS_WDN && WS_WDN + (size_t)DEPTH * 4096 * FFN * 2 <= WS_WIN, "ws map 1");
static_assert(WS_WIN + (size_t)DEPTH * NCOL * 4096 * 2 <= WS_WGU && WS_WGU + (size_t)DEPTH * NGU * 4096 * 2 <= WS_H && WS_H + (size_t)M * DM * 2 <= WS_PROJ && WS_PROJ + (size_t)M * NCOL * 2 <= WS_ATTO, "ws map 2");
static_assert(WS_ATTO + (size_t)M * 2048 * 2 <= WS_Y && WS_Y + (size_t)3 * M * 1024 * 2 <= WS_POOLED && WS_POOLED + (size_t)M * 1024 * 2 <= WS_MERGED && WS_MERGED + (size_t)M * DM * 2 <= WS_Z && WS_Z + (size_t)M * DM * 2 <= WS_XB && WS_XB + (size_t)M * DM * 2 <= WS_HGL, "ws map 3");
static_assert(WS_HGL + (size_t)1024 * 16384 * 4 <= WS_HGS && WS_HGS + (size_t)1024 * 16384 * 4 <= WS_HGD && WS_HGD + (size_t)1024 * 128 * 4 <= WS_XC && WS_XC + (size_t)M * DM * 2 <= WS_END && (size_t)M * FFN * 2 <= (size_t)M * NCOL * 2, "ws map 4");
constexpr int CW_BAR = 4096;

constexpr int RING_OFF = 0, RING_BYTES = 131072;
constexpr int LDSCTL_OFF = RING_BYTES, MISC_OFF = LDSCTL_OFF + 320;
constexpr int LDS_BYTES = 147456;
static_assert(MISC_OFF + 128 <= LDS_BYTES, "LDS map");

#define GAS __attribute__((address_space(1)))
#define LAS __attribute__((address_space(3)))
typedef unsigned short bf16;
typedef unsigned v4u __attribute__((ext_vector_type(4)));
typedef unsigned v2u __attribute__((ext_vector_type(2)));
typedef float f32x4 __attribute__((ext_vector_type(4)));
typedef GAS unsigned gu32;
#define RLX_AGENT __ATOMIC_RELAXED, __HIP_MEMORY_SCOPE_AGENT
#define LDS_WAIT() asm volatile("s_waitcnt lgkmcnt(0)" ::: "memory")
#define VM_WAIT() asm volatile("s_waitcnt vmcnt(0)" ::: "memory")
__device__ __forceinline__ unsigned f2bf(float f) { unsigned u = __builtin_bit_cast(unsigned, f); return (u + 0x7fffu + ((u >> 16) & 1u)) >> 16; }
__device__ __forceinline__ unsigned pk2(float lo, float hi) { return f2bf(lo) | (f2bf(hi) << 16); }
__device__ __forceinline__ float bflo(unsigned w) { return __uint_as_float(w << 16); }
__device__ __forceinline__ float bfhi(unsigned w) { return __uint_as_float(w & 0xffff0000u); }
__device__ __forceinline__ void unpack8(const v4u w, float (&f)[8]) { f[0] = bflo(w.x); f[1] = bfhi(w.x); f[2] = bflo(w.y); f[3] = bfhi(w.y); f[4] = bflo(w.z); f[5] = bfhi(w.z); f[6] = bflo(w.w); f[7] = bfhi(w.w); }
__device__ __forceinline__ v4u pack8(const float (&f)[8]) { v4u w; w.x = pk2(f[0], f[1]); w.y = pk2(f[2], f[3]); w.z = pk2(f[4], f[5]); w.w = pk2(f[6], f[7]); return w; }
__device__ __forceinline__ float sigmoidf_(float z) { return 1.0f / (1.0f + __expf(-z)); }

#define XB_TMO      128
#define XB_XCNT(j)  (256  + 64 * (j))
#define XB_XSUB(j)  (1280 + 64 * (j))
#define XB_XGEN(j)  (2304 + 64 * (j))
#define XB_TOP      3328
#define XB_TOPGEN   3392
#define XCD_BAR_WORDS 3456
#define XB_SPIN_CAP (1u << 18)

__device__ __forceinline__ unsigned xb_ld(unsigned* p)              { return __hip_atomic_load(p, __ATOMIC_RELAXED, __HIP_MEMORY_SCOPE_AGENT); }
__device__ __forceinline__ unsigned xb_add(unsigned* p, unsigned v) { return __hip_atomic_fetch_add(p, v, __ATOMIC_RELAXED, __HIP_MEMORY_SCOPE_AGENT); }
__device__ __forceinline__ unsigned xb_xcc_id() { return (unsigned)__builtin_amdgcn_s_getreg((3 << 11) | 20) & 0xFu; }
#define XB_SPIN(cond, bar) do { unsigned _sp = 0; while (cond) { __builtin_amdgcn_s_sleep(1); \
    if ((++_sp & 255u) == 0u) { if (xb_ld(&(bar)[XB_TMO])) break; if (_sp > XB_SPIN_CAP) { atomicAdd(&(bar)[XB_TMO], 1u); break; } } } } while (0)

struct XcdBarrier {
    unsigned* bar; unsigned x;
    volatile LAS unsigned* st;
};

__device__ __forceinline__ XcdBarrier xcd_barrier_post(unsigned* bar, volatile LAS unsigned* st) {
    XcdBarrier b; b.bar = bar; b.x = xb_xcc_id(); b.st = st;
    if (threadIdx.x == 0) (void)xb_add(&bar[XB_XCNT(b.x)], 1u);
    return b;
}
__device__ __forceinline__ void xcd_barrier_complete(unsigned* bar, unsigned x, unsigned& nloc, unsigned& nx) {
    const unsigned G = gridDim.x * gridDim.y * gridDim.z;
    unsigned sum, cnt, mine, sp = 0u;
    for (;;) {
        sum = 0u; cnt = 0u; mine = 0u;
#pragma unroll
        for (unsigned j = 0; j < 16; ++j) { const unsigned c = xb_ld(&bar[XB_XCNT(j)]); sum += c; cnt += (c > 0u) ? 1u : 0u; mine = (j == x) ? c : mine; }
        if (sum == G) break;
        __builtin_amdgcn_s_sleep(1);
        if ((++sp & 255u) == 0u) { if (xb_ld(&bar[XB_TMO])) break; if (sp > XB_SPIN_CAP) { atomicAdd(&bar[XB_TMO], 1u); break; } }
    }
    nloc = mine > 0u ? mine : 1u; nx = cnt > 0u ? cnt : 1u;
}

__device__ __forceinline__ void xcd_barrier(const XcdBarrier& b) {
    asm volatile("s_waitcnt vmcnt(0)" ::: "memory");
    __syncthreads();
    if (threadIdx.x == 0) {
        unsigned* bar = b.bar;
        __builtin_amdgcn_s_waitcnt(0);
        unsigned nloc = b.st[0], nx = b.st[1];
        if (nloc == 0u) { xcd_barrier_complete(bar, b.x, nloc, nx); b.st[0] = nloc; b.st[1] = nx; }
        const unsigned old = xb_add(&bar[XB_XSUB(b.x)], 1u);
        const unsigned gen = old / nloc;
        if (old + 1u == (gen + 1u) * nloc) {
            __builtin_amdgcn_fence(__ATOMIC_RELEASE, "agent");
            asm volatile("s_waitcnt vmcnt(0)" ::: "memory");
            const unsigned og = xb_add(&bar[XB_TOP], 1u);
            const unsigned tg = og / nx;
            if (og + 1u == (tg + 1u) * nx) xb_add(&bar[XB_TOPGEN], 1u);
            else XB_SPIN(xb_ld(&bar[XB_TOPGEN]) == tg, bar);
            __builtin_amdgcn_fence(__ATOMIC_ACQUIRE, "agent");
            xb_add(&bar[XB_XGEN(b.x)], 1u);
            asm volatile("s_waitcnt vmcnt(0)" ::: "memory");
        } else {
            XB_SPIN(xb_ld(&bar[XB_XGEN(b.x)]) == gen, bar);
            __builtin_amdgcn_fence(__ATOMIC_ACQUIRE, "agent");
            asm volatile("s_waitcnt vmcnt(0)" ::: "memory");
        }
    }
    __syncthreads();
}


struct Frame {
    LAS unsigned char* lds;
    volatile LAS unsigned* MISC;
    unsigned char* ws; float* out;
    int tid, lane, wave;
    int vcu, G;
};
#define WSP(T, off) ((T*)(F.ws + (off)))
enum { I_X = 0, I_NMPRE, I_NMPOST, I_NFPRE, I_NFPOST, I_WIN, I_LBLOG, I_HGNORM, I_POOLW, I_POOLSC, I_LAMBDA, I_SUBLN, I_WUPA, I_WUPB, I_WUPC, I_WOUT, I_WGATE, I_WFUP, I_WDOWN };

struct Args { const float* in[19]; float* out; unsigned char* ws; int ph_lo, ph_hi; };

template <int X> __device__ __forceinline__ float xor_lane(float v) {
    if constexpr (X == 32) { const auto rr = __builtin_amdgcn_permlane32_swap(__float_as_uint(v), __float_as_uint(v), false, false); const unsigned a = rr[0], b = rr[1]; return __uint_as_float(a ^ b ^ __float_as_uint(v)); }
    else return __uint_as_float((unsigned)__builtin_amdgcn_ds_swizzle((int)__float_as_uint(v), (X << 10) | 0x1f));
}
__device__ __forceinline__ float wave_sum(float v) {
    v += xor_lane<1>(v); v += xor_lane<2>(v); v += xor_lane<4>(v); v += xor_lane<8>(v); v += xor_lane<16>(v); v += xor_lane<32>(v);
    return v;
}

__device__ __forceinline__ void p0_transpose_item(const float* W, int K, int N, bf16* WT, int drow0, LAS float* scr, int k0, int n0, int lane) {
#pragma unroll 8
    for (int i = 0; i < 32; ++i) { const int kk = 2 * i + (lane >> 5); scr[kk * 33 + (lane & 31)] = W[(size_t)(k0 + kk) * N + n0 + (lane & 31)]; }
    LDS_WAIT(); asm volatile("" ::: "memory");
    const int c = lane & 7;
#pragma unroll
    for (int j = 0; j < 4; ++j) { const int n = (lane >> 3) + 8 * j; const LAS float* s = scr + (8 * c) * 33 + n;
        v4u o; o.x = pk2(s[0 * 33], s[1 * 33]); o.y = pk2(s[2 * 33], s[3 * 33]); o.z = pk2(s[4 * 33], s[5 * 33]); o.w = pk2(s[6 * 33], s[7 * 33]);
        *(GAS v4u*)(WT + (size_t)(drow0 + n) * K + k0 + 8 * c) = o; }
    LDS_WAIT(); asm volatile("" ::: "memory");
}
__device__ __forceinline__ void rms_row_to_bf16(int lane, const float* xrow, const float* gain, bf16* orow) {
    const GAS f32x4* xr = (const GAS f32x4*)xrow + lane; const GAS f32x4* gr = (const GAS f32x4*)gain + lane;
    f32x4 v[16]; float s = 0.f;
#pragma unroll
    for (int j = 0; j < 16; ++j) { v[j] = xr[64 * j]; s += (v[j].x * v[j].x + v[j].y * v[j].y) + (v[j].z * v[j].z + v[j].w * v[j].w); }
    const float rstd = 1.0f / sqrtf(wave_sum(s) * (1.f / DM) + EPS);
    GAS v2u* o8 = (GAS v2u*)orow + lane;
#pragma unroll
    for (int j = 0; j < 16; ++j) { const f32x4 g = gr[64 * j]; v2u w; w.x = pk2(v[j].x * rstd * g.x, v[j].y * rstd * g.y); w.y = pk2(v[j].z * rstd * g.z, v[j].w * rstd * g.w); o8[64 * j] = w; }
}
#define AIN(A, i) ({ int i_ = (i); asm volatile("" : "+s"(i_)); (A).in[i_]; })
__device__ __forceinline__ void p0_prologue(Frame& F, const Args& A) {
    LAS float* scr = (LAS float*)(F.lds + RING_OFF + F.wave * 16384);
    const int gw = F.vcu * NWAVES + F.wave, NGW = F.G * NWAVES;
    constexpr int I_IN = (DM / 64) * (NCOL / 32), I_UP = (1024 / 64) * (DM / 32), I_OUT = (DM / 64) * (DM / 32), I_G = (DM / 64) * (FFN / 32), I_DN = (FFN / 64) * (DM / 32), I_PL = (256 / 64) * (256 / 32);
    constexpr int I_LAYER = I_IN + 3 * I_UP + I_OUT + 2 * I_G + I_DN + 4 * I_PL;
    for (int it = gw; it < DEPTH * I_LAYER; it += NGW) {
        const int l = (DEPTH - 1) - it / I_LAYER; int r = it % I_LAYER;
        const float* W; bf16* WT; int K, N, mode = 0;
        if (r < I_DN) { W = AIN(A, I_WDOWN) + (size_t)l * FFN * DM; K = FFN; N = DM; WT = WSP(bf16, WS_WDN) + (size_t)l * DM * FFN; }
        else if ((r -= I_DN) < 2 * I_G) { const int j = r / I_G; r -= j * I_G; W = (j == 0 ? AIN(A, I_WGATE) : AIN(A, I_WFUP)) + (size_t)l * DM * FFN; K = DM; N = FFN; WT = WSP(bf16, WS_WGU) + (size_t)l * NGU * DM; mode = 1 + j; }
        else if ((r -= 2 * I_G) < I_OUT) { W = AIN(A, I_WOUT) + (size_t)l * DM * DM; K = DM; N = DM; WT = WSP(bf16, WS_WOUT) + (size_t)l * DM * DM; }
        else if ((r -= I_OUT) < 3 * I_UP) { const int j = r / I_UP; r -= j * I_UP; W = (j == 0 ? AIN(A, I_WUPA) : (j == 1 ? AIN(A, I_WUPB) : AIN(A, I_WUPC))) + (size_t)l * 1024 * DM; K = 1024; N = DM; WT = WSP(bf16, WS_WUP) + ((size_t)l * 3 + j) * DM * 1024; }
        else if ((r -= 3 * I_UP) < 4 * I_PL) { const int g = r / I_PL; r -= g * I_PL; W = AIN(A, I_POOLW) + ((size_t)l * 4 + g) * 65536; K = 256; N = 256; WT = WSP(bf16, WS_POOLW) + ((size_t)l * 4 + g) * 65536; }
        else { r -= 4 * I_PL; W = AIN(A, I_WIN) + (size_t)l * DM * NCOL; K = DM; N = NCOL; WT = WSP(bf16, WS_WIN) + (size_t)l * NCOL * DM; }
        const int nblk = N / 32, kb = r / nblk, nb = r - kb * nblk, n0 = 32 * nb;
        const int drow0 = (mode == 0) ? n0 : ((n0 >> 7) * 256 + (n0 & 127) + (mode == 2 ? 128 : 0));
        p0_transpose_item(W, K, N, WT, drow0, scr, 64 * kb, n0, F.lane);
    }
    if (blockIdx.x == 0) {
        for (int c = F.tid; c < 1024; c += NTHR) {
            float lg[DEPTH], mx = -INFINITY, den = 0.f;
#pragma unroll
            for (int l = 0; l < DEPTH; ++l) { lg[l] = AIN(A, I_LBLOG)[l * 1024 + c]; mx = fmaxf(mx, lg[l]); }
#pragma unroll
            for (int l = 0; l < DEPTH; ++l) { lg[l] = expf(lg[l] - mx); den += lg[l]; }
            float cum = 0.f;
#pragma unroll
            for (int l = 0; l < DEPTH; ++l) { if (l > 0) cum += lg[l] / den; WSP(float, WS_LB)[l * 1024 + c] = cum; }
        }
    }
    for (int m = gw; m < M; m += NGW) rms_row_to_bf16(F.lane, AIN(A, I_X) + (size_t)m * DM, AIN(A, I_NMPRE), WSP(bf16, WS_H) + (size_t)m * DM);
}

template <bool XIN_F32, bool XOUT_F32>
__device__ __forceinline__ void resnorm_phase(Frame& F, const void* xold, void* xnew, const float* gpost, const float* gnext) {
    const int gw = F.vcu * NWAVES + F.wave, NGW = F.G * NWAVES;
    for (int m = gw; m < M; m += NGW) {
        const GAS v4u* zr = (const GAS v4u*)(WSP(bf16, WS_Z) + (size_t)m * DM) + F.lane;
        float v[8][8]; float s = 0.f;
#pragma unroll
        for (int j = 0; j < 8; ++j) { unpack8(zr[64 * j], v[j]);
#pragma unroll
            for (int k = 0; k < 8; ++k) s += v[j][k] * v[j][k]; }
        const float rz = 1.0f / sqrtf(wave_sum(s) * (1.f / DM) + EPS);
        float s2 = 0.f;
#pragma unroll
        for (int j = 0; j < 8; ++j) { float x[8];
            if constexpr (XIN_F32) { const GAS f32x4* xr = (const GAS f32x4*)((const float*)xold + (size_t)m * DM) + 2 * F.lane + 128 * j; const f32x4 a = xr[0], b = xr[1]; x[0] = a.x; x[1] = a.y; x[2] = a.z; x[3] = a.w; x[4] = b.x; x[5] = b.y; x[6] = b.z; x[7] = b.w; }
            else unpack8(*((const GAS v4u*)((const bf16*)xold + (size_t)m * DM) + F.lane + 64 * j), x);
            const GAS f32x4* gp = (const GAS f32x4*)gpost + 2 * F.lane + 128 * j; const f32x4 g0 = gp[0], g1 = gp[1];
            const float g[8] = {g0.x, g0.y, g0.z, g0.w, g1.x, g1.y, g1.z, g1.w};
#pragma unroll
            for (int k = 0; k < 8; ++k) { v[j][k] = x[k] + v[j][k] * rz * g[k]; s2 += v[j][k] * v[j][k]; }
            if constexpr (XOUT_F32) { GAS f32x4* orow = (GAS f32x4*)((float*)xnew + (size_t)m * DM) + 2 * F.lane + 128 * j; orow[0] = (f32x4){v[j][0], v[j][1], v[j][2], v[j][3]}; orow[1] = (f32x4){v[j][4], v[j][5], v[j][6], v[j][7]}; }
            else *((GAS v4u*)((bf16*)xnew + (size_t)m * DM) + F.lane + 64 * j) = pack8(v[j]); }
        if (gnext) {
            const float rx = 1.0f / sqrtf(wave_sum(s2) * (1.f / DM) + EPS);
            GAS v4u* ho = (GAS v4u*)(WSP(bf16, WS_H) + (size_t)m * DM) + F.lane;
#pragma unroll
            for (int j = 0; j < 8; ++j) { const GAS f32x4* gn = (const GAS f32x4*)gnext + 2 * F.lane + 128 * j; const f32x4 g0 = gn[0], g1 = gn[1]; float o[8];
                o[0] = v[j][0] * rx * g0.x; o[1] = v[j][1] * rx * g0.y; o[2] = v[j][2] * rx * g0.z; o[3] = v[j][3] * rx * g0.w; o[4] = v[j][4] * rx * g1.x; o[5] = v[j][5] * rx * g1.y; o[6] = v[j][6] * rx * g1.z; o[7] = v[j][7] * rx * g1.w;
                ho[64 * j] = pack8(o); }
        }
    }
}
__device__ __forceinline__ void pooled_phase(Frame& F) {
    const int gt = F.vcu * NTHR + F.tid, NGT = F.G * NTHR;
    for (int it = gt; it < M * 128; it += NGT) {
        const int row = it >> 7, c8 = (it & 127) * 8, g = c8 >> 8, w = 2 << g, t = row & (SEQ - 1), cnt = (t + 1 < w) ? t + 1 : w;
        const bf16* p = WSP(bf16, WS_PROJ) + (size_t)row * NCOL + C_PU + c8;
        float cur[8], sum[8];
        unpack8(*(const GAS v4u*)p, cur);
#pragma unroll
        for (int j = 0; j < 8; ++j) sum[j] = cur[j];
        for (int i = 1; i < cnt; ++i) { float x[8]; unpack8(*(const GAS v4u*)(p - (size_t)i * NCOL), x);
#pragma unroll
            for (int j = 0; j < 8; ++j) sum[j] += x[j]; }
        const float inv = 1.0f / (float)cnt; float o[8];
#pragma unroll
        for (int j = 0; j < 8; ++j) o[j] = sum[j] * inv - cur[j];
        *(GAS v4u*)(WSP(bf16, WS_POOLED) + (size_t)row * 1024 + c8) = pack8(o);
    }
}
__device__ __forceinline__ void attn_combine_phase(Frame& F, const float* lp, const float* sub, float lambda_init) {
    const float lam = expf(wave_sum(lp[F.lane] * lp[64 + F.lane])) - expf(wave_sum(lp[128 + F.lane] * lp[192 + F.lane])) + lambda_init;
    bf16* yc = WSP(bf16, WS_Y) + (size_t)2 * M * 1024;
    const int gt = F.vcu * NTHR + F.tid, NGT = F.G * NTHR;
    for (int it = gt; it < M * 8 * 16; it += NGT) {
        const int l16 = it & 15, rh = it >> 4, h = rh & 7, row = rh >> 3, j = l16 >> 3, wcol = (l16 & 7) * 8;
        const bf16* o1 = WSP(bf16, WS_ATTO) + (size_t)row * 2048 + (h * 4 + j) * 64 + wcol;
        float a[8], b[8], d[8]; unpack8(*(const GAS v4u*)o1, a); unpack8(*(const GAS v4u*)(o1 + 128), b);
        float ss = 0.f;
#pragma unroll
        for (int k = 0; k < 8; ++k) { d[k] = a[k] - lam * b[k]; ss += d[k] * d[k]; }
        ss += xor_lane<1>(ss); ss += xor_lane<2>(ss); ss += xor_lane<4>(ss); ss += xor_lane<8>(ss);
        const float rstd = (1.0f / sqrtf(ss * (1.f / 128.f) + EPS)) * (1.0f - lambda_init);
#pragma unroll
        for (int k = 0; k < 8; ++k) d[k] = d[k] * rstd * sub[l16 * 8 + k];
        *(GAS v4u*)(yc + (size_t)row * 1024 + h * 128 + l16 * 8) = pack8(d);
    }
}

__device__ __forceinline__ void hg_gate(float z, float lb, float& logf_, float& k_) {
    z = fminf(fmaxf(z, -30.f), 30.f);
    const float e = expf(-z), sg = 1.0f / (1.0f + e), om = e * sg;
    logf_ = logf(lb + (1.0f - lb) * sg); k_ = (1.0f - lb) * om;
}
typedef short hbf16x8 __attribute__((ext_vector_type(8)));
__device__ __forceinline__ unsigned short ldg_u16(const bf16* p) { return *(const GAS unsigned short*)p; }
constexpr int HP = 72, QP = 136;
__device__ __forceinline__ void h1_unit(Frame& F, int layer, int u) {
    const int bh = u >> 5, c = u & 31, b = bh >> 3, h = bh & 7; const size_t r0 = (size_t)b * SEQ + c * 64;
    LAS bf16* KDT = (LAS bf16*)(F.lds + RING_OFF); LAS bf16* VT = KDT + 128 * HP; LAS float* TOT = (LAS float*)(F.lds + RING_OFF + 2 * 128 * HP * 2);
    const int ch = F.tid & 127, sc = F.tid >> 7, g = F.lane >> 4, c16 = F.lane & 15;
    const bf16* pf = WSP(bf16, WS_PROJ) + (r0 + 16 * sc) * NCOL + C_HF + h * 128 + ch; const bf16* pv = pf + (C_HV - C_HF);
    const float lb = WSP(float, WS_LB)[layer * 1024 + h * 128 + ch];
    float bl[16], kq[16]; float run = 0.f;
#pragma unroll
    for (int i = 0; i < 16; ++i) { float lf; hg_gate(__uint_as_float((unsigned)ldg_u16(pf + (size_t)i * NCOL) << 16), lb, lf, kq[i]); run += lf; bl[i] = run; }
    TOT[sc * 128 + ch] = run;
    { v4u w0, w1; unsigned w[8];
#pragma unroll
      for (int i = 0; i < 8; ++i) w[i] = (unsigned)ldg_u16(pv + (size_t)(2 * i) * NCOL) | ((unsigned)ldg_u16(pv + (size_t)(2 * i + 1) * NCOL) << 16);
      w0.x = w[0]; w0.y = w[1]; w0.z = w[2]; w0.w = w[3]; w1.x = w[4]; w1.y = w[5]; w1.z = w[6]; w1.w = w[7];
      *(LAS v4u*)(VT + ch * HP + 16 * sc) = w0; *(LAS v4u*)(VT + ch * HP + 16 * sc + 8) = w1; }
    __syncthreads();
    { const float t0 = TOT[ch], t1 = TOT[128 + ch], t2 = TOT[256 + ch], t3 = TOT[384 + ch];
      const float r1 = t0, r2 = t0 + t1, r3 = r2 + t2, tot = r3 + t3, off = (sc == 0) ? 0.f : ((sc == 1) ? r1 : ((sc == 2) ? r2 : r3));
      float kd[16];
#pragma unroll
      for (int i = 0; i < 16; ++i) kd[i] = kq[i] * expf(tot - (off + bl[i]));
      v4u w0, w1; w0.x = pk2(kd[0], kd[1]); w0.y = pk2(kd[2], kd[3]); w0.z = pk2(kd[4], kd[5]); w0.w = pk2(kd[6], kd[7]); w1.x = pk2(kd[8], kd[9]); w1.y = pk2(kd[10], kd[11]); w1.z = pk2(kd[12], kd[13]); w1.w = pk2(kd[14], kd[15]);
      *(LAS v4u*)(KDT + ch * HP + 16 * sc) = w0; *(LAS v4u*)(KDT + ch * HP + 16 * sc + 8) = w1;
      if (sc == 0) WSP(float, WS_HGD)[(size_t)u * 128 + ch] = expf(tot); }
    __syncthreads();
    { const int w = F.wave;
      const hbf16x8 a0 = *(const LAS hbf16x8*)(KDT + (16 * w + c16) * HP + 8 * g), a1 = *(const LAS hbf16x8*)(KDT + (16 * w + c16) * HP + 32 + 8 * g);
      bf16* lt = WSP(bf16, WS_HGL) + (size_t)u * 16384 + 16 * w + 4 * g;
#pragma unroll
      for (int n = 0; n < 8; ++n) {
          const hbf16x8 b0 = *(const LAS hbf16x8*)(VT + (16 * n + c16) * HP + 8 * g), b1 = *(const LAS hbf16x8*)(VT + (16 * n + c16) * HP + 32 + 8 * g);
          f32x4 acc = (f32x4){0.f, 0.f, 0.f, 0.f};
          acc = __builtin_amdgcn_mfma_f32_16x16x32_bf16(a0, b0, acc, 0, 0, 0); acc = __builtin_amdgcn_mfma_f32_16x16x32_bf16(a1, b1, acc, 0, 0, 0);
          v2u o; o.x = pk2(acc[0], acc[1]); o.y = pk2(acc[2], acc[3]);
          *(GAS v2u*)(lt + (size_t)(16 * n + c16) * 128) = o; } }
    __syncthreads();
}
__device__ __forceinline__ void h2_phase(Frame& F) {
    const int gt = F.vcu * NTHR + F.tid, NGT = F.G * NTHR;
    for (int it = gt; it < 32 * 4096; it += NGT) {
        const int bh = it >> 12, e4 = it & 4095, k4 = e4 & 31;
        f32x4 st = (f32x4){0.f, 0.f, 0.f, 0.f};
        for (int c = 0; c < 32; ++c) { const size_t u = (size_t)bh * 32 + c;
            v2u so; so.x = pk2(st[0], st[1]); so.y = pk2(st[2], st[3]);
            *((GAS v2u*)(WSP(bf16, WS_HGS) + u * 16384) + e4) = so;
            const f32x4 d = *((const GAS f32x4*)(WSP(float, WS_HGD) + u * 128) + k4); const v2u lw = *((const GAS v2u*)(WSP(bf16, WS_HGL) + u * 16384) + e4);
            st[0] = d[0] * st[0] + bflo(lw.x); st[1] = d[1] * st[1] + bfhi(lw.x); st[2] = d[2] * st[2] + bflo(lw.y); st[3] = d[3] * st[3] + bfhi(lw.y); }
    }
}
__device__ __forceinline__ void h3_unit(Frame& F, int layer, int u, const float* hgnorm) {
    const int bh = u >> 5, c = u & 31, b = bh >> 3, h = bh & 7; const size_t r0 = (size_t)b * SEQ + c * 64;
    LAS bf16* QE = (LAS bf16*)(F.lds + RING_OFF); LAS bf16* QI = QE + 64 * QP; LAS bf16* KT = QI + 64 * QP; LAS bf16* VT = KT + 160 * QP; LAS bf16* PM = VT + 128 * HP;
    LAS float* TOT = (LAS float*)(PM + 64 * HP); LAS float* SS = TOT + 512;
    static_assert((2 * 64 * QP + 160 * QP + 128 * HP + 64 * HP) * 2 + 512 * 4 + 128 * 4 <= RING_BYTES, "H3 LDS");
    const int ch = F.tid & 127, sc = F.tid >> 7, g = F.lane >> 4, c16 = F.lane & 15;
    const bf16* pf = WSP(bf16, WS_PROJ) + (r0 + 16 * sc) * NCOL + C_HF + h * 128 + ch; const bf16* pq = pf + (C_HQ - C_HF); const bf16* pv = pf + (C_HV - C_HF);
    const float lb = WSP(float, WS_LB)[layer * 1024 + h * 128 + ch];
    float bl[16], kq[16], q[16]; float run = 0.f;
#pragma unroll
    for (int i = 0; i < 16; ++i) { float lf; hg_gate(__uint_as_float((unsigned)ldg_u16(pf + (size_t)i * NCOL) << 16), lb, lf, kq[i]); run += lf; bl[i] = run; q[i] = __uint_as_float((unsigned)ldg_u16(pq + (size_t)i * NCOL) << 16); }
    TOT[sc * 128 + ch] = run;
    { v4u w0, w1; unsigned w[8];
#pragma unroll
      for (int i = 0; i < 8; ++i) w[i] = (unsigned)ldg_u16(pv + (size_t)(2 * i) * NCOL) | ((unsigned)ldg_u16(pv + (size_t)(2 * i + 1) * NCOL) << 16);
      w0.x = w[0]; w0.y = w[1]; w0.z = w[2]; w0.w = w[3]; w1.x = w[4]; w1.y = w[5]; w1.z = w[6]; w1.w = w[7];
      *(LAS v4u*)(VT + ch * HP + 16 * sc) = w0; *(LAS v4u*)(VT + ch * HP + 16 * sc + 8) = w1; }
    for (int i = F.tid; i < 64 * HP * 2 / 16; i += NTHR) ((LAS v4u*)PM)[i] = (v4u){0u, 0u, 0u, 0u};
    __syncthreads();
    { const float t0 = TOT[ch], t1 = TOT[128 + ch], t2 = TOT[256 + ch];
      float rr[4]; rr[0] = 0.f; rr[1] = t0; rr[2] = t0 + t1; rr[3] = rr[2] + t2;
      const float off = (sc == 0) ? rr[0] : ((sc == 1) ? rr[1] : ((sc == 2) ? rr[2] : rr[3]));
#pragma unroll
      for (int i = 0; i < 16; ++i) { const int t = 16 * sc + i; const float bt = off + bl[i];
          QE[t * QP + ch] = (bf16)f2bf(q[i] * expf(bt)); QI[t * QP + ch] = (bf16)f2bf(q[i] * expf(bl[i]));
#pragma unroll
          for (int ii = 0; ii < 4; ++ii) if (ii >= sc) KT[(8 * ii * (ii + 1) + t) * QP + ch] = (bf16)f2bf(kq[i] * expf(rr[ii] - bt)); } }
    __syncthreads();
#pragma unroll
    for (int rep = 0; rep < 2; ++rep) { const int blk = F.wave + 8 * rep;
        if (blk < 10) { const int i = (blk >= 6) ? 3 : ((blk >= 3) ? 2 : ((blk >= 1) ? 1 : 0)), j = blk - (i * (i + 1)) / 2;
            f32x4 acc = (f32x4){0.f, 0.f, 0.f, 0.f};
#pragma unroll
            for (int ks = 0; ks < 4; ++ks) { const hbf16x8 a = *(const LAS hbf16x8*)(QI + (16 * i + c16) * QP + 32 * ks + 8 * g), bb = *(const LAS hbf16x8*)(KT + (8 * i * (i + 1) + 16 * j + c16) * QP + 32 * ks + 8 * g);
                acc = __builtin_amdgcn_mfma_f32_16x16x32_bf16(a, bb, acc, 0, 0, 0); }
#pragma unroll
            for (int r = 0; r < 4; ++r) { const int tl = 4 * g + r; const float val = (i == j && c16 > tl) ? 0.f : acc[r]; PM[(16 * i + tl) * HP + 16 * j + c16] = (bf16)f2bf(val); } } }
    __syncthreads();
    { const int tb = F.wave & 3, vh = F.wave >> 2; f32x4 acc[4];
#pragma unroll
      for (int n = 0; n < 4; ++n) acc[n] = (f32x4){0.f, 0.f, 0.f, 0.f};
      const bf16* st = WSP(bf16, WS_HGS) + (size_t)u * 16384 + (size_t)(64 * vh + c16) * 128 + 8 * g;
#pragma unroll
      for (int ks = 0; ks < 4; ++ks) { const hbf16x8 a = *(const LAS hbf16x8*)(QE + (16 * tb + c16) * QP + 32 * ks + 8 * g);
#pragma unroll
          for (int n = 0; n < 4; ++n) { const hbf16x8 bb = *(const GAS hbf16x8*)(st + (size_t)(16 * n) * 128 + 32 * ks); acc[n] = __builtin_amdgcn_mfma_f32_16x16x32_bf16(a, bb, acc[n], 0, 0, 0); } }
      const int nss = (tb >= 2) ? 2 : 1;
      for (int ss = 0; ss < nss; ++ss) { const hbf16x8 a = *(const LAS hbf16x8*)(PM + (16 * tb + c16) * HP + 32 * ss + 8 * g);
#pragma unroll
          for (int n = 0; n < 4; ++n) { const hbf16x8 bb = *(const LAS hbf16x8*)(VT + (64 * vh + 16 * n + c16) * HP + 32 * ss + 8 * g); acc[n] = __builtin_amdgcn_mfma_f32_16x16x32_bf16(a, bb, acc[n], 0, 0, 0); } }
      float part[4];
#pragma unroll
      for (int r = 0; r < 4; ++r) { float s = 0.f;
#pragma unroll
          for (int n = 0; n < 4; ++n) s += acc[n][r] * acc[n][r];
          s += xor_lane<1>(s); s += xor_lane<2>(s); s += xor_lane<4>(s); s += xor_lane<8>(s); part[r] = s; }
      if (c16 == 0) {
#pragma unroll
          for (int r = 0; r < 4; ++r) SS[vh * 64 + 16 * tb + 4 * g + r] = part[r]; }
      __syncthreads();
#pragma unroll
      for (int r = 0; r < 4; ++r) { const int t = 16 * tb + 4 * g + r; const float rstd = 1.0f / sqrtf((SS[t] + SS[64 + t]) * (1.f / 128.f) + EPS);
          const bf16* gp = WSP(bf16, WS_PROJ) + (r0 + t) * NCOL + C_HG + h * 128 + 64 * vh + c16; bf16* yo = WSP(bf16, WS_Y) + (r0 + t) * 1024 + h * 128 + 64 * vh + c16;
#pragma unroll
          for (int n = 0; n < 4; ++n) { const float gz = __uint_as_float((unsigned)ldg_u16(gp + 16 * n) << 16); const float y = acc[n][r] * rstd * hgnorm[h * 128 + 64 * vh + 16 * n + c16] * (gz * sigmoidf_(gz));
              *(GAS unsigned short*)(yo + 16 * n) = (unsigned short)f2bf(y); } } }
    __syncthreads();
}

struct SchedPlain {
    pg8::TileOrder T; const char* A; const char* B; size_t ta, tb;
    __device__ __forceinline__ bool next(int i, pg8::Unit& u) const { int pm, pn; if (!T.tile(i, pm, pn)) return false; u.pm = pm; u.pn = pn; u.kind = 0; u.a = A + (size_t)pm * ta; u.b = B + (size_t)pn * tb; return true; }
};
struct SchedUp {
    pg8::TileOrder T; const char* Y; const char* W;
    __device__ __forceinline__ bool next(int i, pg8::Unit& u) const { const int ti = i / 3, br = i - 3 * ti; int pm, pn; if (!T.tile(ti, pm, pn)) return false; u.pm = pm; u.pn = pn; u.kind = br;
        u.a = Y + ((size_t)br * M * 1024 + (size_t)pm * 256 * 1024) * 2; u.b = W + ((size_t)br * DM + (size_t)pn * 256) * 1024 * 2; return true; }
};
struct SchedPool {
    int G, c; const char* A; const char* B;
    __device__ __forceinline__ bool next(int i, pg8::Unit& u) const { const int L = i * G + c; if (L >= 128) return false; u.pm = L >> 2; u.pn = L & 3; u.kind = 0;
        u.a = A + ((size_t)u.pm * 256 * 1024 + (size_t)u.pn * 256) * 2; u.b = B + (size_t)u.pn * 65536 * 2; return true; }
};
struct EpiProj {
    static constexpr bool PERM = true; bf16* O;
    __device__ __forceinline__ bool keep(const pg8::Unit&) const { return false; }
    __device__ __forceinline__ void operator()(pg8::f32x4 (&acc)[2][2][4][2], const pg8::Unit& u, int wr, int wc, int fr, int fq) const {
        const float sc = (u.pn < 4) ? QSCALE_HG : ((u.pn >= 20 && u.pn < 24) ? attn_body::C2 : 1.0f);
        const int row0 = u.pm * 256 + wr * 64 + fr, col0 = u.pn * 256 + wc * 32 + 8 * fq;
#pragma unroll
        for (int ai = 0; ai < 2; ++ai)
#pragma unroll
            for (int m = 0; m < 4; ++m) { bf16* rowp = O + (size_t)(row0 + ai * 128 + m * 16) * NCOL + col0;
#pragma unroll
                for (int bj = 0; bj < 2; ++bj) { const pg8::f32x4 v0 = acc[ai][bj][m][0] * sc, v1 = acc[ai][bj][m][1] * sc;
                    pg8::u32x4 w; w.x = pg8::cvt_pk_bf16(v0[0], v0[1]); w.y = pg8::cvt_pk_bf16(v0[2], v0[3]); w.z = pg8::cvt_pk_bf16(v1[0], v1[1]); w.w = pg8::cvt_pk_bf16(v1[2], v1[3]);
                    *(pg8::u32x4*)(rowp + bj * 128) = w; } }
    }
};
struct EpiPool {
    static constexpr bool PERM = true; bf16* O; const float* scale;
    __device__ __forceinline__ bool keep(const pg8::Unit&) const { return false; }
    __device__ __forceinline__ void operator()(pg8::f32x4 (&acc)[2][2][4][2], const pg8::Unit& u, int wr, int wc, int fr, int fq) const {
        const int row0 = u.pm * 256 + wr * 64 + fr, col0 = u.pn * 256 + wc * 32 + 8 * fq;
        pg8::f32x4 sv[2][2];
#pragma unroll
        for (int bj = 0; bj < 2; ++bj)
#pragma unroll
            for (int n = 0; n < 2; ++n) sv[bj][n] = *(const pg8::f32x4*)(scale + col0 + bj * 128 + 4 * n);
#pragma unroll
        for (int ai = 0; ai < 2; ++ai)
#pragma unroll
            for (int m = 0; m < 4; ++m) { bf16* rowp = O + (size_t)(row0 + ai * 128 + m * 16) * 1024 + col0;
#pragma unroll
                for (int bj = 0; bj < 2; ++bj) { const pg8::f32x4 v0 = acc[ai][bj][m][0] * sv[bj][0], v1 = acc[ai][bj][m][1] * sv[bj][1];
                    pg8::u32x4 w; w.x = pg8::cvt_pk_bf16(v0[0], v0[1]); w.y = pg8::cvt_pk_bf16(v0[2], v0[3]); w.z = pg8::cvt_pk_bf16(v1[0], v1[1]); w.w = pg8::cvt_pk_bf16(v1[2], v1[3]);
                    *(pg8::u32x4*)(rowp + bj * 128) = w; } }
    }
};
struct EpiUp {
    static constexpr bool PERM = true; const bf16* gates; bf16* O;
    __device__ __forceinline__ bool keep(const pg8::Unit& u) const { return u.kind < 2; }
    __device__ __forceinline__ void operator()(pg8::f32x4 (&acc)[2][2][4][2], const pg8::Unit& u, int wr, int wc, int fr, int fq) const {
        const int row0 = u.pm * 256 + wr * 64 + fr, col0 = u.pn * 256 + wc * 32 + 8 * fq;
        if (u.kind < 2) {
#pragma unroll
            for (int ai = 0; ai < 2; ++ai)
#pragma unroll
                for (int m = 0; m < 4; ++m) { const bf16* gp = gates + (size_t)(row0 + ai * 128 + m * 16) * NCOL + (size_t)u.kind * DM + col0;
#pragma unroll
                    for (int bj = 0; bj < 2; ++bj) { float za[8], zb[8]; unpack8(*(const v4u*)(gp + bj * 128), za); unpack8(*(const v4u*)(gp + DM + bj * 128), zb);
#pragma unroll
                        for (int j = 0; j < 8; ++j) { const float r = (1.0f + __expf(-zb[j])) * pg8::fast_rcp(1.0f + __expf(-za[j])); acc[ai][bj][m][j >> 2][j & 3] *= r; } } }
        } else {
#pragma unroll
            for (int ai = 0; ai < 2; ++ai)
#pragma unroll
                for (int m = 0; m < 4; ++m) { const size_t row = (size_t)(row0 + ai * 128 + m * 16); const bf16* gp = gates + row * NCOL + (size_t)2 * DM + col0; bf16* rowp = O + row * DM + col0;
#pragma unroll
                    for (int bj = 0; bj < 2; ++bj) { float zc[8], o[8]; unpack8(*(const v4u*)(gp + bj * 128), zc);
#pragma unroll
                        for (int j = 0; j < 8; ++j) o[j] = acc[ai][bj][m][j >> 2][j & 3] * pg8::fast_rcp(1.0f + __expf(-zc[j]));
                        pg8::u32x4 w; w.x = pg8::cvt_pk_bf16(o[0], o[1]); w.y = pg8::cvt_pk_bf16(o[2], o[3]); w.z = pg8::cvt_pk_bf16(o[4], o[5]); w.w = pg8::cvt_pk_bf16(o[6], o[7]);
                        *(pg8::u32x4*)(rowp + bj * 128) = w; } }
        }
    }
};
struct EpiZ {
    static constexpr bool PERM = true; bf16* C;
    __device__ __forceinline__ bool keep(const pg8::Unit&) const { return false; }
    __device__ __forceinline__ void operator()(pg8::f32x4 (&acc)[2][2][4][2], const pg8::Unit& u, int wr, int wc, int fr, int fq) const {
        const int row0 = u.pm * 256 + wr * 64 + fr, col0 = u.pn * 256 + wc * 32 + 8 * fq;
#pragma unroll
        for (int ai = 0; ai < 2; ++ai)
#pragma unroll
            for (int m = 0; m < 4; ++m) { bf16* rowp = C + (size_t)(row0 + ai * 128 + m * 16) * DM + col0;
#pragma unroll
                for (int bj = 0; bj < 2; ++bj) { const pg8::f32x4 v0 = acc[ai][bj][m][0], v1 = acc[ai][bj][m][1];
                    pg8::u32x4 w; w.x = pg8::cvt_pk_bf16(v0[0], v0[1]); w.y = pg8::cvt_pk_bf16(v0[2], v0[3]); w.z = pg8::cvt_pk_bf16(v1[0], v1[1]); w.w = pg8::cvt_pk_bf16(v1[2], v1[3]);
                    *(pg8::u32x4*)(rowp + bj * 128) = w; } }
    }
};
struct EpiSwiglu {
    static constexpr bool PERM = true; bf16* O;
    __device__ __forceinline__ bool keep(const pg8::Unit&) const { return false; }
    __device__ __forceinline__ void operator()(pg8::f32x4 (&acc)[2][2][4][2], const pg8::Unit& u, int wr, int wc, int fr, int fq) const {
        const int row0 = u.pm * 256 + wr * 64 + fr, col0 = u.pn * 128 + wc * 32 + 8 * fq;
#pragma unroll
        for (int ai = 0; ai < 2; ++ai)
#pragma unroll
            for (int m = 0; m < 4; ++m) { bf16* rowp = O + (size_t)(row0 + ai * 128 + m * 16) * FFN + col0; float o[8];
#pragma unroll
                for (int j = 0; j < 8; ++j) { const float g = acc[ai][0][m][j >> 2][j & 3], up = acc[ai][1][m][j >> 2][j & 3]; o[j] = g * pg8::fast_rcp(1.0f + __expf(-g)) * up; }
                pg8::u32x4 w; w.x = pg8::cvt_pk_bf16(o[0], o[1]); w.y = pg8::cvt_pk_bf16(o[2], o[3]); w.z = pg8::cvt_pk_bf16(o[4], o[5]); w.w = pg8::cvt_pk_bf16(o[6], o[7]);
                *(pg8::u32x4*)rowp = w; }
    }
};

#ifndef PH_ENABLE
#define PH_ENABLE 0xffff
#endif
#define PHE(b) ((PH_ENABLE >> (b)) & 1)
#ifndef PH_REPEAT
#define PH_REPEAT 0x0
#endif
#define PHR(b) ((PH_REPEAT >> (b)) & 1)
#define RUN(b, ...) do { if constexpr (PHE(b)) { __VA_ARGS__; } if constexpr (PHR(b)) { __syncthreads(); __VA_ARGS__; } } while (0)
#define IN(k) (lo <= (k) && (k) < hi)
#define PHASE_ENTER() do { int t_ = threadIdx.x, b_ = blockIdx.x, g_ = gridDim.x; unsigned char* w_ = args.ws; asm volatile("" : "+v"(t_), "+s"(w_), "+s"(b_), "+s"(g_)); F.tid = t_; F.lane = t_ & 63; F.wave = __builtin_amdgcn_readfirstlane(t_ >> 6); F.ws = w_; \
        bid = b_; F.G = g_; F.vcu = (g_ % 8 == 0) ? (b_ % 8) * (g_ / 8) + b_ / 8 : b_; } while (0)
#define INP(i) ({ int i_ = (i); asm volatile("" : "+s"(i_)); args.in[i_]; })
#define SEAM(k) do { if (N_LAUNCHES == 1 && IN(k) && IN((k) + 1)) { XcdBarrier b_ = bar; unsigned* p_ = bar.bar; asm volatile("" : "+s"(p_)); b_.bar = p_; xcd_barrier(b_); if constexpr (PHR(15)) xcd_barrier(b_); } } while (0)
template <int l> __device__ __forceinline__ void layer_program(Frame& F, const Args& args, const XcdBarrier& bar, const int lo, const int hi, unsigned char* lds) {
    int bid = (int)blockIdx.x;
        const int pb = 1 + PH_PER_LAYER * l;
        const float lambda_init = (l == 0) ? 0.2f : 0.35550906759f;
        if (IN(pb + 0)) { PHASE_ENTER();
            SchedPlain S; S.T.init(M / 256, NCOL / 256, F.G, bid); S.A = (const char*)WSP(bf16, WS_H); S.B = (const char*)(WSP(bf16, WS_WIN) + (size_t)l * NCOL * DM); S.ta = (size_t)256 * DM * 2; S.tb = (size_t)256 * DM * 2;
            EpiProj E{WSP(bf16, WS_PROJ)};
            RUN(1, pg8::gemm_phase<EpiProj, SchedPlain, true, true>(F.lds + RING_OFF, DM, DM, DM, S, E));
            SEAM(pb + 0);
        }
        if (IN(pb + 1)) { PHASE_ENTER();
            const attn_body::AttnTensors AT{(const attn_body::bf16*)(WSP(bf16, WS_PROJ) + C_DQ), (const attn_body::bf16*)(WSP(bf16, WS_PROJ) + C_DK), (const attn_body::bf16*)(WSP(bf16, WS_PROJ) + C_DV), (attn_body::bf16*)WSP(bf16, WS_ATTO)};
            const attn_body::StaticOrder S((int)F.G, bid);
            RUN(2, attn_body::attn_phase<attn_body::StaticOrder>((char*)lds + RING_OFF, AT, S));
            __syncthreads();
            RUN(3, for (int u = F.vcu; u < 1024; u += F.G) h1_unit(F, l, u); pooled_phase(F));
            SEAM(pb + 1);
        }
        if (IN(pb + 2)) { PHASE_ENTER();
            RUN(4, h2_phase(F); attn_combine_phase(F, INP(I_LAMBDA) + l * 256, INP(I_SUBLN) + l * 128, lambda_init));
            SchedPool S; S.G = F.G; S.c = bid; S.A = (const char*)WSP(bf16, WS_POOLED); S.B = (const char*)(WSP(bf16, WS_POOLW) + (size_t)l * 4 * 65536);
            EpiPool E{WSP(bf16, WS_Y) + (size_t)M * 1024, INP(I_POOLSC) + l * 1024};
            RUN(4, pg8::gemm_phase<EpiPool, SchedPool, true, true>(F.lds + RING_OFF, 256, 1024, 256, S, E));
            SEAM(pb + 2);
        }
        if (IN(pb + 3)) { PHASE_ENTER();
            RUN(5, for (int u = F.vcu; u < 1024; u += F.G) h3_unit(F, l, u, INP(I_HGNORM) + l * 1024));
            SEAM(pb + 3);
        }
        if (IN(pb + 4)) { PHASE_ENTER();
            SchedUp S; S.T.init(M / 256, DM / 256, F.G, bid); S.Y = (const char*)WSP(bf16, WS_Y); S.W = (const char*)(WSP(bf16, WS_WUP) + (size_t)l * 3 * DM * 1024);
            EpiUp E{WSP(bf16, WS_PROJ) + C_GATE, WSP(bf16, WS_MERGED)};
            RUN(6, pg8::gemm_phase<EpiUp, SchedUp, true, true>(F.lds + RING_OFF, 1024, 1024, 1024, S, E));
            SEAM(pb + 4);
        }
        if (IN(pb + 5)) { PHASE_ENTER();
            SchedPlain S; S.T.init(M / 256, DM / 256, F.G, bid); S.A = (const char*)WSP(bf16, WS_MERGED); S.B = (const char*)(WSP(bf16, WS_WOUT) + (size_t)l * DM * DM); S.ta = (size_t)256 * DM * 2; S.tb = (size_t)256 * DM * 2;
            EpiZ E{WSP(bf16, WS_Z)};
            RUN(7, pg8::gemm_phase<EpiZ, SchedPlain, true, true>(F.lds + RING_OFF, DM, DM, DM, S, E));
            SEAM(pb + 5);
        }
        if (IN(pb + 6)) { PHASE_ENTER();
            if constexpr (l == 0) RUN(8, resnorm_phase<true, false>(F, INP(I_X), WSP(bf16, WS_XB), INP(I_NMPOST) + l * DM, INP(I_NFPRE) + l * DM));
            else RUN(8, resnorm_phase<false, false>(F, WSP(bf16, WS_XC), WSP(bf16, WS_XB), INP(I_NMPOST) + l * DM, INP(I_NFPRE) + l * DM));
            SEAM(pb + 6);
        }
        if (IN(pb + 7)) { PHASE_ENTER();
            SchedPlain S; S.T.init(M / 256, NGU / 256, F.G, bid); S.A = (const char*)WSP(bf16, WS_H); S.B = (const char*)(WSP(bf16, WS_WGU) + (size_t)l * NGU * DM); S.ta = (size_t)256 * DM * 2; S.tb = (size_t)256 * DM * 2;
            EpiSwiglu E{WSP(bf16, WS_PROJ)};
            RUN(9, pg8::gemm_phase<EpiSwiglu, SchedPlain, true, true>(F.lds + RING_OFF, DM, DM, DM, S, E));
            SEAM(pb + 7);
        }
        if (IN(pb + 8)) { PHASE_ENTER();
            SchedPlain S; S.T.init(M / 256, DM / 256, F.G, bid); S.A = (const char*)WSP(bf16, WS_PROJ); S.B = (const char*)(WSP(bf16, WS_WDN) + (size_t)l * DM * FFN); S.ta = (size_t)256 * FFN * 2; S.tb = (size_t)256 * FFN * 2;
            EpiZ E{WSP(bf16, WS_Z)};
            RUN(10, pg8::gemm_phase<EpiZ, SchedPlain, true, true>(F.lds + RING_OFF, FFN, FFN, FFN, S, E));
            SEAM(pb + 8);
        }
        if (IN(pb + 9)) { PHASE_ENTER();
            if constexpr (l + 1 < DEPTH) RUN(8, resnorm_phase<false, false>(F, WSP(bf16, WS_XB), WSP(bf16, WS_XC), INP(I_NFPOST) + l * DM, INP(I_NMPRE) + (l + 1) * DM));
            else RUN(8, resnorm_phase<false, true>(F, WSP(bf16, WS_XB), args.out, INP(I_NFPOST) + l * DM, (const float*)nullptr));
            SEAM(pb + 9);
        }
    }
__global__ void __launch_bounds__(NTHR, 2) trunk_fwd(Args args) {
    extern __shared__ __attribute__((aligned(16))) unsigned char lds[];
    Frame F;
    F.lds = (LAS unsigned char*)lds;
    F.MISC = (volatile LAS unsigned*)(F.lds + MISC_OFF);
    F.tid = threadIdx.x; F.lane = F.tid & 63; F.wave = __builtin_amdgcn_readfirstlane(F.tid >> 6);
    F.G = gridDim.x; { const int bx = blockIdx.x; F.vcu = (F.G % 8 == 0) ? (bx % 8) * (F.G / 8) + bx / 8 : bx; }
    F.ws = args.ws; F.out = args.out;
    gu32* const ctl = (gu32*)(args.ws + WS_CTL);
    for (int u = F.tid; u < (LDS_BYTES - LDSCTL_OFF) / 4; u += NTHR) ((LAS unsigned*)(F.lds + LDSCTL_OFF))[u] = 0u;
    __syncthreads();
    XcdBarrier bar; bar.bar = (unsigned*)(ctl + CW_BAR); bar.x = 0; bar.st = nullptr;
    if (N_LAUNCHES == 1) bar = xcd_barrier_post((unsigned*)(ctl + CW_BAR), F.MISC + 8);
    const int lo = args.ph_lo, hi = args.ph_hi;
    int bid = (int)blockIdx.x;

    if (IN(0)) { PHASE_ENTER(); RUN(0, p0_prologue(F, args)); SEAM(0); }

    layer_program<0>(F, args, bar, lo, hi, lds);
    layer_program<1>(F, args, bar, lo, hi, lds);
#undef IN
#undef SEAM
#undef PHASE_ENTER
#undef INP
}

extern "C" void kernel_launch(void* const* d_in, const int* in_sizes, int n_in, void* d_out, int out_size, void* d_ws, size_t ws_size, hipStream_t stream) {
    static int grid = 0;
    if (grid == 0) {
        if (n_in != 19 || in_sizes[0] != M * DM || out_size != M * DM || ws_size < WS_END) { fprintf(stderr, "kernel_launch: built for 19 inputs, x and out of %d floats, >= %zu bytes of workspace; got n_in %d, in0 %d, out %d, ws %zu; nothing launched\n", M * DM, (size_t)WS_END, n_in, n_in > 0 ? in_sizes[0] : -1, out_size, ws_size); grid = -1; return; }
        int dev = 0, cus = 0, per_cu = 0;
        if (hipGetDevice(&dev) != hipSuccess || hipDeviceGetAttribute(&cus, hipDeviceAttributeMultiprocessorCount, dev) != hipSuccess) { fprintf(stderr, "kernel_launch: hipGetDevice / hipDeviceGetAttribute failed; nothing launched\n"); grid = -1; return; }
        if (hipFuncSetAttribute((const void*)trunk_fwd, hipFuncAttributeMaxDynamicSharedMemorySize, LDS_BYTES) != hipSuccess) { fprintf(stderr, "kernel_launch: hipFuncSetAttribute failed; nothing launched\n"); grid = -1; return; }
        if (hipOccupancyMaxActiveBlocksPerMultiprocessor(&per_cu, (const void*)trunk_fwd, NTHR, LDS_BYTES) != hipSuccess || per_cu < 1)
            fprintf(stderr, "kernel_launch: note: the occupancy query reports %d workgroups per CU\n", per_cu);
        (void)hipGetLastError();
        grid = cus;
        if (grid != 256) fprintf(stderr, "kernel_launch: %d CUs; the attention unit order is built for 256\n", grid);
    }
    if (grid < 0) return;
    if (hipMemsetAsync((char*)d_ws + WS_CTL, 0, CTL_ZERO_BYTES, stream) != hipSuccess) { fprintf(stderr, "kernel_launch: hipMemsetAsync of the control words failed; nothing launched\n"); return; }
    Args a{};
    for (int i = 0; i < 19; ++i) a.in[i] = (const float*)d_in[i];
    a.out = (float*)d_out; a.ws = (unsigned char*)d_ws;
    for (int li = 0; li < N_LAUNCHES; ++li) {
        a.ph_lo = (N_LAUNCHES == 1) ? 0 : li; a.ph_hi = (N_LAUNCHES == 1) ? NPHASES : li + 1;
        hipLaunchKernelGGL(trunk_fwd, dim3(grid), dim3(NTHR), LDS_BYTES, stream, a);
        const hipError_t le = hipPeekAtLastError();
        if (le != hipSuccess) { fprintf(stderr, "kernel_launch: launch %d failed: %s\n", li, hipGetErrorName(le)); break; }
    }
}
```

```cpp
#include <hip/hip_runtime.h>
#include <hip/hip_bf16.h>
#include <cstdio>
#include <cstdint>
#include <cmath>

namespace pg8 {
#define PG8_LAS __attribute__((address_space(3)))
typedef unsigned short bf16_t;
typedef short bf16x8 __attribute__((ext_vector_type(8)));
typedef float f32x4 __attribute__((ext_vector_type(4)));
typedef float f32x2 __attribute__((ext_vector_type(2)));
typedef unsigned u32x4 __attribute__((ext_vector_type(4)));
typedef unsigned u32x2 __attribute__((ext_vector_type(2)));
constexpr int BM = 256, BK = 64, HALF = 128, HTB = HALF * BK * 2  , STAGE_BYTES = 8 * HTB, NXCD = 8, WGM = 8;

__host__ __device__ __forceinline__ int lds_byte(int r, int c) { const int st = (r >> 4) * 2 + (c >> 5), rr = r & 15, cc = c & 31, ob = rr * 64 + cc * 2; return st * 1024 + (ob ^ (((ob >> 9) & 1) << 5)); }
__host__ __device__ __forceinline__ void stage_rc(int b, int& R, int& C) { const int st = b / 1024, sb = b % 1024, swz = sb ^ (((sb >> 9) & 1) << 5); R = (st >> 1) * 16 + swz / 64; C = (st & 1) * 32 + (swz % 64) / 2; }
__host__ __device__ __forceinline__ int perm32(int rho) { const int n = rho >> 4, i = rho & 15; return 8 * (i >> 2) + 4 * n + (i & 3); }

struct Unit { int pm, pn, kind; const char* a; const char* b; };

struct TileOrder {
    int nM, nN, nwg, G, c;
    __device__ __forceinline__ void init(int nM_, int nN_, int G_, int c_) { nM = nM_; nN = nN_; nwg = nM * nN; G = G_; c = c_; }
    __device__ __forceinline__ bool tile(int i, int& pm, int& pn) const {
        const long L = (long)i * G + c; if (L >= nwg) return false;
        int wgid = (int)L; { const int q = nwg / NXCD, r = nwg % NXCD, xcd = wgid % NXCD, off = wgid / NXCD; wgid = (xcd < r ? xcd * (q + 1) : r * (q + 1) + (xcd - r) * q) + off; }
        const int nig = WGM * nN, gid = wgid / nig, fm = gid * WGM, gsz = (nM - fm) < WGM ? (nM - fm) : WGM;
        pm = fm + ((wgid % nig) % gsz); pn = (wgid % nig) / gsz; return true;
    }
};

__device__ __forceinline__ unsigned cvt_pk_bf16(float lo, float hi) { unsigned r; asm volatile("v_cvt_pk_bf16_f32 %0, %1, %2" : "=v"(r) : "v"(lo), "v"(hi)); return r; }
__device__ __forceinline__ float bf_lo(unsigned w) { return __uint_as_float(w << 16); }
__device__ __forceinline__ float bf_hi(unsigned w) { return __uint_as_float(w & 0xffff0000u); }
__device__ __forceinline__ float fast_exp(float x) { return __builtin_amdgcn_exp2f(x * 1.4426950408889634f); }
__device__ __forceinline__ float fast_rcp(float x) { return __builtin_amdgcn_rcpf(x); }


template <class Epi, class Sched, bool ALIGN_EPI = false, bool SP2 = false>
__device__ __forceinline__ void gemm_phase(PG8_LAS unsigned char* lds, const int K, const int lda, const int ldb, const Sched& S, const Epi& E) {
    int tid = threadIdx.x; asm volatile("" : "+v"(tid));
    const int wid = __builtin_amdgcn_readfirstlane(tid >> 6), lane = tid & 63, wr = wid >> 2, wc = wid & 3, fr = lane & 15, fq = lane >> 4;
    int nt = K / BK; asm volatile("" : "+s"(nt));
    unsigned voffA[2], voffB[2];
#pragma unroll
    for (int i = 0; i < 2; ++i) { int R, C; stage_rc(tid * 16 + i * 8192, R, C); const int Rb = Epi::PERM ? ((R & ~31) + perm32(R & 31)) : R;
        voffA[i] = (unsigned)(R * lda + C) * 2u; voffB[i] = (unsigned)(Rb * ldb + C) * 2u; }
    const size_t kstep = (size_t)(BK * 2);
    const size_t hsA = (size_t)HALF * lda * 2, hsB = (size_t)HALF * ldb * 2;
    const unsigned ldsw = (unsigned)wid * 1024u;
    const int aoff = lds_byte(wr * 64 + fr, fq * 8), boff = lds_byte(wc * 32 + fr, fq * 8);
#define PG8_SA(b, h) (((b) * 2 + (h)) * HTB)
#define PG8_SB(b, h) ((4 + (b) * 2 + (h)) * HTB)
#define PG8_STAGE(bufoff, gbase, voff) do { _Pragma("unroll") for (int _i = 0; _i < 2; ++_i) \
        __builtin_amdgcn_global_load_lds((const unsigned*)((const char*)(gbase) + (voff)[_i]), (PG8_LAS unsigned*)(lds + (bufoff) + ldsw + _i * 8192), 16, 0, 0); } while (0)
#define PG8_LDA(dst, b, h) do { _Pragma("unroll") for (int m = 0; m < 4; ++m) _Pragma("unroll") for (int k = 0; k < 2; ++k) dst[m][k] = *(const PG8_LAS bf16x8*)(lds + PG8_SA(b, h) + aoff + m * 2048 + k * 1024); } while (0)
#define PG8_LDB(dst, b, h) do { _Pragma("unroll") for (int n = 0; n < 2; ++n) _Pragma("unroll") for (int k = 0; k < 2; ++k) dst[n][k] = *(const PG8_LAS bf16x8*)(lds + PG8_SB(b, h) + boff + n * 2048 + k * 1024); } while (0)
#define PG8_MMA(ai, bj, At, Bt) do { __builtin_amdgcn_s_setprio(1); _Pragma("unroll") for (int m = 0; m < 4; ++m) _Pragma("unroll") for (int n = 0; n < 2; ++n) _Pragma("unroll") for (int k = 0; k < 2; ++k) \
        acc[ai][bj][m][n] = __builtin_amdgcn_mfma_f32_16x16x32_bf16(Bt[n][k], At[m][k], acc[ai][bj][m][n], 0, 0, 0); __builtin_amdgcn_s_setprio(0); } while (0)
#define PG8_WAIT_V(n) asm volatile("s_waitcnt vmcnt(" #n ")" ::: "memory")
#define PG8_WAIT_L(n) asm volatile("s_waitcnt lgkmcnt(" #n ")" ::: "memory")
#define PG8_WAIT_VN(n) asm volatile("s_waitcnt vmcnt(%0)" :: "n"(n) : "memory")
#define PG8_BAR __builtin_amdgcn_s_barrier()
#define PG8_SCHED __builtin_amdgcn_sched_barrier(0)
    Unit cur, nxt; int ui = 0;
    if (!S.next(0, cur)) return;
    f32x4 acc[2][2][4][2];
#pragma unroll
    for (int a = 0; a < 2; ++a)
#pragma unroll
        for (int b = 0; b < 2; ++b)
#pragma unroll
            for (int m = 0; m < 4; ++m)
#pragma unroll
                for (int n = 0; n < 2; ++n) acc[a][b][m][n] = (f32x4){0.f, 0.f, 0.f, 0.f};
    bf16x8 At[4][2], B0[2][2], B1[2][2];
    const char* cA = cur.a; const char* cB = cur.b;
    if constexpr (SP2) {
        PG8_STAGE(PG8_SB(0, 0), cB, voffB); PG8_STAGE(PG8_SB(0, 1), cB + hsB, voffB); PG8_STAGE(PG8_SA(0, 0), cA, voffA); PG8_STAGE(PG8_SA(0, 1), cA + hsA, voffA);
        if (wr == 1) PG8_BAR;
        PG8_WAIT_V(2); PG8_BAR;
        PG8_STAGE(PG8_SB(1, 0), cB + kstep, voffB); PG8_STAGE(PG8_SA(1, 0), cA + kstep, voffA); PG8_STAGE(PG8_SB(1, 1), cB + hsB + kstep, voffB);
        PG8_WAIT_V(6); PG8_BAR;
    } else {
        PG8_STAGE(PG8_SB(0, 0), cB, voffB); PG8_STAGE(PG8_SA(0, 0), cA, voffA); PG8_STAGE(PG8_SB(0, 1), cB + hsB, voffB); PG8_STAGE(PG8_SA(0, 1), cA + hsA, voffA);
        if (wr == 1) PG8_BAR;
        PG8_WAIT_V(4); PG8_BAR;
        PG8_STAGE(PG8_SB(1, 0), cB + kstep, voffB); PG8_STAGE(PG8_SA(1, 0), cA + kstep, voffA); PG8_STAGE(PG8_SB(1, 1), cB + hsB + kstep, voffB);
        PG8_WAIT_V(6); PG8_BAR;
    }
    for (;;) {
        const bool has_next = S.next(ui + 1, nxt);
        const char* nA = has_next ? nxt.a : cA; const char* nB = has_next ? nxt.b : cB;
        for (int t = 0; t < nt; t += 2) {
            const bool last = (t == nt - 2);
            const char* a1 = cA + (size_t)(t + 1) * kstep;
            const char* a2 = last ? nA : cA + (size_t)(t + 2) * kstep; const char* b2 = last ? nB : cB + (size_t)(t + 2) * kstep;
            const char* a3 = a2 + kstep; const char* b3 = b2 + kstep;
            if constexpr (SP2) {
            const int relax = __builtin_amdgcn_readfirstlane(((Epi::NST > 0) && (t == 0) && (ui > 0)) ? 1 : 0);
#define PG8_WAIT_VR() do { if constexpr (Epi::NST > 0) { asm volatile("s_cmp_lg_u32 %0, 0\n\ts_cbranch_scc1 .Lrx%=\n\ts_waitcnt vmcnt(8)\n.Lrx%=:\n\ts_waitcnt vmcnt(%1)" :: "s"(relax), "n"(8 + Epi::NST) : "memory", "scc"); } else { PG8_WAIT_V(8); } } while (0)
            PG8_LDB(B0, 0, 0); PG8_LDB(B1, 0, 1); PG8_SCHED; PG8_LDA(At, 0, 0); PG8_STAGE(PG8_SA(1, 1), a1 + hsA, voffA);
            PG8_WAIT_VR(); PG8_WAIT_L(0); PG8_BAR; PG8_MMA(0, 0, At, B0); PG8_MMA(0, 1, At, B1); PG8_BAR; PG8_SCHED;
            PG8_LDA(At, 0, 1); PG8_STAGE(PG8_SB(0, 0), b2, voffB); PG8_STAGE(PG8_SB(0, 1), b2 + hsB, voffB); PG8_STAGE(PG8_SA(0, 0), a2, voffA);
            PG8_WAIT_VR(); PG8_WAIT_L(0); PG8_BAR; PG8_MMA(1, 0, At, B0); PG8_MMA(1, 1, At, B1); PG8_BAR; PG8_SCHED;
            PG8_LDB(B0, 1, 0); PG8_LDB(B1, 1, 1); PG8_SCHED; PG8_LDA(At, 1, 0); PG8_STAGE(PG8_SA(0, 1), a2 + hsA, voffA);
            PG8_WAIT_V(8); PG8_WAIT_L(0); PG8_BAR; PG8_MMA(0, 0, At, B0); PG8_MMA(0, 1, At, B1); PG8_BAR; PG8_SCHED;
            PG8_LDA(At, 1, 1); PG8_STAGE(PG8_SB(1, 0), b3, voffB); PG8_STAGE(PG8_SB(1, 1), b3 + hsB, voffB); PG8_STAGE(PG8_SA(1, 0), a3, voffA);
            PG8_WAIT_V(8); PG8_WAIT_L(0); PG8_BAR; PG8_MMA(1, 0, At, B0); PG8_MMA(1, 1, At, B1); PG8_BAR; PG8_SCHED;
#undef PG8_WAIT_VR
            } else {
            PG8_LDB(B0, 0, 0); PG8_SCHED; PG8_LDA(At, 0, 0); PG8_STAGE(PG8_SA(1, 1), a1 + hsA, voffA);
            PG8_WAIT_L(8); PG8_BAR; PG8_WAIT_L(0); PG8_MMA(0, 0, At, B0); PG8_BAR; PG8_SCHED;
            PG8_LDB(B1, 0, 1); PG8_STAGE(PG8_SB(0, 0), b2, voffB);
            PG8_BAR; PG8_WAIT_L(0); PG8_MMA(0, 1, At, B1); PG8_BAR;
            PG8_LDA(At, 0, 1); PG8_STAGE(PG8_SA(0, 0), a2, voffA);
            PG8_BAR; PG8_WAIT_L(0); PG8_MMA(1, 0, At, B0); PG8_BAR; PG8_SCHED;
            PG8_STAGE(PG8_SB(0, 1), b2 + hsB, voffB);
            PG8_WAIT_V(6); PG8_BAR; PG8_MMA(1, 1, At, B1); PG8_BAR;
            PG8_LDB(B0, 1, 0); PG8_SCHED; PG8_LDA(At, 1, 0); PG8_STAGE(PG8_SA(0, 1), a2 + hsA, voffA);
            PG8_WAIT_L(8); PG8_BAR; PG8_WAIT_L(0); PG8_MMA(0, 0, At, B0); PG8_BAR; PG8_SCHED;
            PG8_LDB(B1, 1, 1); PG8_STAGE(PG8_SB(1, 0), b3, voffB);
            PG8_BAR; PG8_WAIT_L(0); PG8_MMA(0, 1, At, B1); PG8_BAR;
            PG8_LDA(At, 1, 1); PG8_STAGE(PG8_SA(1, 0), a3, voffA);
            PG8_BAR; PG8_WAIT_L(0); PG8_MMA(1, 0, At, B0); PG8_BAR; PG8_SCHED;
            PG8_STAGE(PG8_SB(1, 1), b3 + hsB, voffB);
            PG8_WAIT_V(6); PG8_BAR; PG8_MMA(1, 1, At, B1); PG8_BAR;
            }
        }
        if constexpr (ALIGN_EPI) { if (wr == 0) PG8_BAR; }
        E(acc, cur, wr, wc, fr, fq);
        if (!has_next) break;
        if (!E.keep(cur)) {
#pragma unroll
        for (int a = 0; a < 2; ++a)
#pragma unroll
            for (int b = 0; b < 2; ++b)
#pragma unroll
                for (int m = 0; m < 4; ++m)
#pragma unroll
                    for (int n = 0; n < 2; ++n) acc[a][b][m][n] = (f32x4){0.f, 0.f, 0.f, 0.f};
        }
        cur = nxt; cA = nA; cB = nB; ++ui;
        if constexpr (ALIGN_EPI) { if (wr == 1) PG8_BAR; }
    }
    PG8_WAIT_V(0);
    if constexpr (!ALIGN_EPI) { if (wr == 0) PG8_BAR; }
    PG8_BAR;
#undef PG8_SA
#undef PG8_SB
#undef PG8_STAGE
#undef PG8_LDA
#undef PG8_LDB
#undef PG8_MMA
#undef PG8_WAIT_V
#undef PG8_WAIT_VN
#undef PG8_WAIT_L
#undef PG8_BAR
#undef PG8_SCHED
}
}

namespace attn_body {
using bf16=__hip_bfloat16;
using bf16x8=__attribute__((ext_vector_type(8)))short;
using s16x4=__attribute__((ext_vector_type(4)))short;
using f32x16=__attribute__((ext_vector_type(16)))float;
using u32x4=__attribute__((ext_vector_type(4)))unsigned;
constexpr int SEQ=2048,D=64,DV=128,NHM=16,NVH=32;
constexpr int PQ=8192,PO=2048;
constexpr int NW=8,QBLK=32,QB=QBLK*NW,KVBLK=64,NQB=SEQ/QB;
constexpr int ATTN_UNIT_ROWS=QB;
__device__ __forceinline__ int crow(int r,int hi){return (r&3)+8*(r>>2)+4*hi;}
#define SBAR() __builtin_amdgcn_sched_barrier(0)
__device__ __forceinline__ void cmask(f32x16&p0,f32x16&p1,int jb,int qrel,int hi){
  const float NEG=-INFINITY; int d=qrel-64*jb-4*hi; asm volatile("":"+v"(d));
  #pragma unroll
  for(int r=0;r<16;++r){const int c=(r&3)+8*(r>>2); if(c>d)p0[r]=NEG; if(c+32>d)p1[r]=NEG;}
}

constexpr int NSLOT=3, SLOTB=8192, VSLOTB=2*SLOTB;
constexpr int LDS_K=0, LDS_V=NSLOT*SLOTB, LDS_WS=LDS_V+NSLOT*VSLOTB, LDS_OST=LDS_WS+NW*64*4, LDS_BYTES=LDS_OST+NW*4096;
constexpr float C2=0.125f*1.4426950408889634f;
__device__ __forceinline__ void glds16(const void*gsrc,unsigned lds_dst){unsigned keep;
  asm volatile("s_mov_b32 %0, m0\n\ts_mov_b32 m0, %2\n\ts_nop 0\n\tglobal_load_lds_dwordx4 %1, off\n\ts_mov_b32 m0, %0":"=&s"(keep):"v"(gsrc),"s"(lds_dst):"memory");}
__device__ __forceinline__ float max3f(float a,float b,float c){float r;asm("v_max3_f32 %0, %1, %2, %3":"=v"(r):"v"(a),"v"(b),"v"(c));return r;}
__device__ __forceinline__ float max2f(float a,float b){float r;asm("v_max_f32_e32 %0, %1, %2":"=v"(r):"v"(a),"v"(b));return r;}
__device__ __forceinline__ float fadd_s(float a,float b){float r;asm("v_add_f32_e32 %0, %1, %2":"=v"(r):"v"(a),"v"(b));return r;}
__device__ __forceinline__ float fsub_s(float a,float b){float r;asm("v_sub_f32_e32 %0, %1, %2":"=v"(r):"v"(a),"v"(b));return r;}
typedef float f32x2_t __attribute__((ext_vector_type(2))); typedef __bf16 bf16x2_t __attribute__((ext_vector_type(2)));
__device__ __forceinline__ unsigned cvtpk_s(float lo,float hi){f32x2_t v={lo,hi};bf16x2_t b=__builtin_convertvector(v,bf16x2_t);return __builtin_bit_cast(unsigned,b);}
#define WAIT_BAR(N) asm volatile("s_waitcnt vmcnt(" #N ") lgkmcnt(0)\n\ts_barrier":::"memory")

__device__ __forceinline__ void qkt(f32x16&p0,f32x16&p1,const char*Kslot,const bf16x8*qr,const f32x16&negm,int r32,int hi){
  const char*kb=Kslot+hi*1024+r32*16;
  #pragma unroll
  for(int d0=0;d0<4;++d0){
    const bf16x8 b0=*reinterpret_cast<const bf16x8*>(kb+d0*2048);
    const bf16x8 b1=*reinterpret_cast<const bf16x8*>(kb+d0*2048+512);
    if(d0==0){p0=__builtin_amdgcn_mfma_f32_32x32x16_bf16(b0,qr[0],negm,0,0,0);p1=__builtin_amdgcn_mfma_f32_32x32x16_bf16(b1,qr[0],negm,0,0,0);}
    else{p0=__builtin_amdgcn_mfma_f32_32x32x16_bf16(b0,qr[d0],p0,0,0,0);p1=__builtin_amdgcn_mfma_f32_32x32x16_bf16(b1,qr[d0],p1,0,0,0);}}
}
typedef __attribute__((address_space(3))) const char* lds_cptr;
typedef short v4i16_t __attribute__((ext_vector_type(4)));
__device__ __forceinline__ void kload8(bf16x8*kf,lds_cptr kp){
  kf[0]=*(const __attribute__((address_space(3))) bf16x8*)(kp);      kf[1]=*(const __attribute__((address_space(3))) bf16x8*)(kp+512);
  kf[2]=*(const __attribute__((address_space(3))) bf16x8*)(kp+2048); kf[3]=*(const __attribute__((address_space(3))) bf16x8*)(kp+2560);
  kf[4]=*(const __attribute__((address_space(3))) bf16x8*)(kp+4096); kf[5]=*(const __attribute__((address_space(3))) bf16x8*)(kp+4608);
  kf[6]=*(const __attribute__((address_space(3))) bf16x8*)(kp+6144); kf[7]=*(const __attribute__((address_space(3))) bf16x8*)(kp+6656);
}
__device__ __forceinline__ void kload2(bf16x8*kf,lds_cptr kp,int j){ kf[2*j]=*(const __attribute__((address_space(3))) bf16x8*)(kp+j*2048); kf[2*j+1]=*(const __attribute__((address_space(3))) bf16x8*)(kp+j*2048+512); }
__device__ __forceinline__ s16x4 vtr(lds_cptr p){ return __builtin_bit_cast(s16x4,__builtin_amdgcn_ds_read_tr16_b64_v4i16((__attribute__((address_space(3))) v4i16_t*)p)); }
__device__ __forceinline__ float rowmax(const f32x16&p0,const f32x16&p1){
  float a=max3f(p0[0],p0[1],p1[0]),b=max3f(p0[2],p0[3],p1[1]);a=max3f(a,p1[2],p1[3]);
  #pragma unroll
  for(int r=4;r<16;r+=4){a=max3f(a,p0[r],p0[r+1]);b=max3f(b,p0[r+2],p0[r+3]);a=max3f(a,p1[r],p1[r+1]);b=max3f(b,p1[r+2],p1[r+3]);}
  const float m=max2f(a,b);
  auto rr=__builtin_amdgcn_permlane32_swap(__float_as_uint(m),__float_as_uint(m),false,false);
  return max2f(__uint_as_float(rr[0]),__uint_as_float(rr[1]));
}
__device__ __forceinline__ void pv(f32x16*o,int vb,bf16x8 pa0,bf16x8 pa1,bf16x8 pa2,bf16x8 pa3){
  #pragma unroll
  for(int d0=0;d0<4;++d0){s16x4 lo[4],hi[4];
    #pragma unroll
    for(int ks=0;ks<4;++ks){
      asm volatile("ds_read_b64_tr_b16 %0,%1 offset:%c2":"=&v"(lo[ks]):"v"(vb),"i"(d0*4096+ks*1024):"memory");
      asm volatile("ds_read_b64_tr_b16 %0,%1 offset:%c2":"=&v"(hi[ks]):"v"(vb),"i"(d0*4096+ks*1024+512):"memory");}
    asm volatile("s_waitcnt lgkmcnt(0)":::"memory");SBAR();
    #define PK(k) (bf16x8){lo[k][0],lo[k][1],lo[k][2],lo[k][3],hi[k][0],hi[k][1],hi[k][2],hi[k][3]}
    o[d0]=__builtin_amdgcn_mfma_f32_32x32x16_bf16(pa0,PK(0),o[d0],0,0,0);
    o[d0]=__builtin_amdgcn_mfma_f32_32x32x16_bf16(pa1,PK(1),o[d0],0,0,0);
    o[d0]=__builtin_amdgcn_mfma_f32_32x32x16_bf16(pa2,PK(2),o[d0],0,0,0);
    o[d0]=__builtin_amdgcn_mfma_f32_32x32x16_bf16(pa3,PK(3),o[d0],0,0,0);
    #undef PK
  }
}

#ifndef ATTN_STORE16
#define ATTN_STORE16(p,v) (*(__attribute__((address_space(1))) u32x4*)(p)=(v))
#endif
template<int THRL> __device__ __forceinline__ void attn_unit(int b,int hm,int qb,const bf16*Q,const bf16*__restrict__ K,const bf16*__restrict__ V,bf16*O,char*shm){
  const int hh=hm>>1, qkh=hm;
  const float sig=__builtin_ldexpf(1.4426950408889634f,-(hh+1));
  int tid=threadIdx.x; asm volatile("":"+v"(tid)); const int lane=tid&63,r32=lane&31,hi=lane>>5; const int wid=__builtin_amdgcn_readfirstlane(tid>>6);
  const long rowbase=(long)b*SEQ; const int q0=qb*QB;
  const bf16*Qw=Q+(rowbase+q0+wid*QBLK)*PQ+qkh*D;
  const bf16*Kh=K+rowbase*PQ+qkh*D,*Vh=V+rowbase*PQ+hh*DV;
  const unsigned lds0=(unsigned)(uintptr_t)shm;
  float*wsf=(float*)(shm+LDS_WS)+wid*64;
  const bf16*ksrc=Kh+(long)lane*PQ+wid*8;
  const bf16*vsrc=Vh+(long)(16*(wid&3)+(lane>>2))*PQ+(wid>>2)*32+(lane&3)*8;
  const unsigned kdst=lds0+LDS_K+wid*1024, vdst=lds0+LDS_V+wid*1024;
  #define DMA_K(t,slot) glds16(ksrc+(long)(t)*KVBLK*PQ,(unsigned)__builtin_amdgcn_readfirstlane(kdst+(slot)))
  #define DMA_V(t,slot) do{ glds16(vsrc+(long)(t)*KVBLK*PQ,(unsigned)__builtin_amdgcn_readfirstlane(vdst+2*(slot))); glds16(vsrc+(long)(t)*KVBLK*PQ+64,(unsigned)__builtin_amdgcn_readfirstlane(vdst+2*(slot)+8192)); }while(0)
  const int vb0=(int)(lds0+LDS_V)+((lane>>4)&1)*32+(lane&3)*8+(4*hi+((lane&15)>>2))*64;
  const char*Kbase=shm+LDS_K; bf16x8 kf[8];
  const lds_cptr shm3=(lds_cptr)shm; const lds_cptr kp0=shm3+LDS_K+hi*1024+r32*16; const lds_cptr vp0=shm3+LDS_V+((lane>>4)&1)*32+(lane&3)*8+(4*hi+((lane&15)>>2))*64;
  const int NT=(q0+QB)/KVBLK;
  DMA_K(0,0);DMA_V(0,0);DMA_K(1,SLOTB);
  bf16x8 qr[4];
  #pragma unroll
  for(int d0=0;d0<4;++d0)qr[d0]=*(const __attribute__((address_space(1))) bf16x8*)(&Qw[(long)r32*PQ+d0*16+hi*8]);
  float mhat=0.f,l_reg=0.f;f32x16 o[4];o[0]=f32x16{};o[1]=f32x16{};o[2]=f32x16{};o[3]=f32x16{};const f32x16 zero16=f32x16{};
  const int qrel=wid*QBLK+r32;
  const float sig64=sig*64.f, chi=sig*(float)(4*hi);
  const float sg1=sig, sg2=sig*2.f, sg3=sig*3.f, sg8=sig*8.f, sg32=sig*32.f;
  #define ABIAS(P0,P1,t) do{ float cb_[16]; cb_[0]=fmaf(sig64,(float)((t)-NT),chi)-mhat; cb_[4]=cb_[0]+sg8; cb_[8]=cb_[4]+sg8; cb_[12]=cb_[8]+sg8; \
      _Pragma("unroll") for(int g_=0;g_<4;++g_){ cb_[4*g_+1]=cb_[4*g_]+sg1; cb_[4*g_+2]=cb_[4*g_]+sg2; cb_[4*g_+3]=cb_[4*g_]+sg3; } \
      _Pragma("unroll") for(int r=0;r<16;++r){ P0[r]+=cb_[r]; P1[r]=(P1[r]+cb_[r])+sg32; } }while(0)
  #define CMASK(P0,P1,t) do{int jb_=(t)-(NT-4); if(jb_>=0)cmask(P0,P1,jb_,qrel,hi);}while(0)
  bool resc=false;
  #define START(P0,P1) do{ const float rm=rowmax(P0,P1); resc=false; \
    { const float dl=rm; mhat=fadd_s(mhat,dl); \
      _Pragma("unroll") for(int r=0;r<16;++r){P0[r]=fsub_s(P0[r],dl);P1[r]=fsub_s(P1[r],dl);} } \
    _Pragma("unroll") for(int r=0;r<16;++r)P0[r]=__builtin_amdgcn_exp2f(P0[r]); }while(0)
  #define RESC() do{ if(resc){ asm volatile("s_waitcnt lgkmcnt(0)":::"memory"); \
      _Pragma("unroll") for(int d_=0;d_<4;++d_) _Pragma("unroll") for(int r=0;r<16;++r)o[d_][r]*=wsf[crow(r,hi)]; } }while(0)
  f32x16 pA0,pA1,pB0,pB1;
  typedef unsigned u32x2_t __attribute__((ext_vector_type(2)));
  u32x2_t a0,a1,bq;
  { const unsigned shb=cvtpk_s(sig,0.f)&0xffffu; const unsigned S_=shb|(cvtpk_s(sig-__uint_as_float(shb<<16),0.f)<<16);
    const unsigned i0=__float_as_uint((float)r32)>>16, i1=__float_as_uint((float)(r32+32))>>16;
    a0[0]=hi?0x3F803F80u:(i0|(i0<<16)); a1[0]=hi?0x3F803F80u:(i1|(i1<<16)); a0[1]=0u; a1[1]=0u; bq[0]=hi?0u:S_; bq[1]=hi?0u:S_; }
  #define MSPLIT() do{ const float n_=-mhat; const unsigned hb_=cvtpk_s(n_,0.f)&0xffffu; const float r1_=n_-__uint_as_float(hb_<<16); const unsigned lb_=cvtpk_s(r1_,0.f)&0xffffu; \
      const float r2_=r1_-__uint_as_float(lb_<<16); const unsigned l2_=cvtpk_s(r2_,0.f)&0xffffu; if(hi){ bq[0]=hb_|(lb_<<16); bq[1]=l2_; } }while(0)
  int sl_prev=0,sl_cur=0,sl_next=SLOTB;
  #define ROT() do{sl_prev=sl_cur;sl_cur=sl_next;sl_next=(sl_next==(NSLOT-1)*SLOTB)?0:sl_next+SLOTB;}while(0)
  DMA_K(2,2*SLOTB);
  WAIT_BAR(4);
  qkt(pA0,pA1,Kbase,qr,zero16,r32,hi);asm volatile("s_nop 15\n\ts_nop 7":"+v"(pA0),"+v"(pA1));ABIAS(pA0,pA1,0);CMASK(pA0,pA1,0);
  START(pA0,pA1);
  _Pragma("unroll") for(int r=0;r<16;++r)pA1[r]=__builtin_amdgcn_exp2f(pA1[r]);
  MSPLIT();
  WAIT_BAR(0);
  DMA_K(3,0);DMA_V(1,SLOTB);
  ROT();
  kload8(kf,kp0+sl_cur);
  WAIT_BAR(3);
  s16x4 vlo[4],vhi[4]; u32x4 pw0,pw1,pw2,pw3;
  #define PKW(P,B) cvtpk_s(P[B],P[B+1])
  #define PAF(k) __builtin_bit_cast(bf16x8,pw##k)
  #define VFS(j) (bf16x8){vlo[(j)&3][0],vlo[(j)&3][1],vlo[(j)&3][2],vlo[(j)&3][3],vhi[(j)&3][0],vhi[(j)&3][1],vhi[(j)&3][2],vhi[(j)&3][3]}
  #define PIN(x) asm volatile("":"+v"(x))
  #define MX3(a,b,c) __builtin_fmaxf(__builtin_fmaxf((a),(b)),(c))
  #define GAPA(MF,CX,A0,A1,A2,A3,W0,W1,PW) do{ MF; PIN(CX); sacc+=A0; sacc+=A1; sacc+=A2; sacc+=A3; PIN(sacc); W0; W1; PIN(PW); SBAR(); }while(0)
  #define GAPN(MF,CX) do{ MF; PIN(CX); SBAR(); }while(0)
  #define EX(v) __builtin_amdgcn_exp2f(v)
  #define VRDJ(j) do{ vlo[(j)&3]=vtr(vp_+(((j)&3)*4096+((j)>>2)*1024)); vhi[(j)&3]=vtr(vp_+(((j)&3)*4096+((j)>>2)*1024+512)); SBAR(); }while(0)
  #define KRD(G,j) do{ if(G){ kload2(kf,kp0+sl_next,j); SBAR(); } }while(0)
  #define PVM(j) o[(j)&3]=__builtin_amdgcn_mfma_f32_32x32x16_bf16(__builtin_bit_cast(bf16x8,(((j)>>2)==0)?pw0:(((j)>>2)==1)?pw1:(((j)>>2)==2)?pw2:pw3),VFS(j),o[(j)&3],0,0,0)
  #define PVG(j) do{ if((j)+3<16){ VRDJ((j)+3); } PVM(j); PIN(o[(j)&3]); }while(0)
  #define EXE(C0,C1,e) do{ if((e)<16) C0[(e)&15]=EX(C0[(e)&15]); else C1[(e)&15]=EX(C1[(e)&15]); }while(0)
  #define GAPB(j,C0,C1,E0,E1) do{ PVG(j); _Pragma("unroll") for(int e_=(E0);e_<(E1);++e_) EXE(C0,C1,e_); PIN(C0); PIN(C1); SBAR(); }while(0)
  #define BIASM(AX) __builtin_amdgcn_mfma_f32_32x32x8bf16_1k(__builtin_bit_cast(s16x4,AX),__builtin_bit_cast(s16x4,bq),zero16,0,0,0)
  #define STEP(C0,C1,P0,P1,t,GK,GV,GL) do{ SBAR(); \
    const lds_cptr vp_=vp0+2*sl_prev; \
    { const unsigned nb_=__float_as_uint((float)(64*((t)-NT)))>>16; const unsigned ny_=hi?0x3F80u:(nb_|(nb_<<16)); a0[1]=ny_; a1[1]=ny_; } \
    float sacc=(P0[0]+P0[1]); \
    GAPA(C0=BIASM(a0),C0, P0[2],P0[3],P0[4],P0[5],     pw0[0]=PKW(P0,0), pw0[1]=PKW(P0,2), pw0); \
    GAPA(C1=BIASM(a1),C1, P0[6],P0[7],P0[8],P0[9],     pw0[2]=PKW(P0,4), pw0[3]=PKW(P0,6), pw0); \
    GAPA(C0=__builtin_amdgcn_mfma_f32_32x32x16_bf16(kf[0],qr[0],C0,0,0,0),C0,   P0[10],P0[11],P0[12],P0[13], pw1[0]=PKW(P0,8), pw1[1]=PKW(P0,10), pw1); \
    GAPA(C1=__builtin_amdgcn_mfma_f32_32x32x16_bf16(kf[1],qr[0],C1,0,0,0),C1,   P0[14],P0[15],P1[0],P1[1],   pw1[2]=PKW(P0,12),pw1[3]=PKW(P0,14), pw1); \
    GAPA(C0=__builtin_amdgcn_mfma_f32_32x32x16_bf16(kf[2],qr[1],C0,0,0,0),C0,   P1[2],P1[3],P1[4],P1[5],     pw2[0]=PKW(P1,0), pw2[1]=PKW(P1,2), pw2); \
    GAPA(C1=__builtin_amdgcn_mfma_f32_32x32x16_bf16(kf[3],qr[1],C1,0,0,0),C1,   P1[6],P1[7],P1[8],P1[9],     pw2[2]=PKW(P1,4), pw2[3]=PKW(P1,6), pw2); \
    GAPA(C0=__builtin_amdgcn_mfma_f32_32x32x16_bf16(kf[4],qr[2],C0,0,0,0),C0,   P1[10],P1[11],P1[12],P1[13], pw3[0]=PKW(P1,8), pw3[1]=PKW(P1,10), pw3); \
    VRDJ(0); GAPA(C1=__builtin_amdgcn_mfma_f32_32x32x16_bf16(kf[5],qr[2],C1,0,0,0),C1,   P1[14],P1[15],0.f,0.f,       pw3[2]=PKW(P1,12),pw3[3]=PKW(P1,14), pw3); \
    l_reg+=sacc; \
    VRDJ(1); GAPN(C0=__builtin_amdgcn_mfma_f32_32x32x16_bf16(kf[6],qr[3],C0,0,0,0),C0); \
    VRDJ(2); GAPN(C1=__builtin_amdgcn_mfma_f32_32x32x16_bf16(kf[7],qr[3],C1,0,0,0),C1); \
    if(GK){DMA_K((t)+3,sl_cur);} if(GV){DMA_V((t)+1,sl_next);} \
    SBAR(); \
    PVG(0); SBAR(); \
    CMASK(C0,C1,t); \
    float mxa_,mxb_; \
    PVG(1); mxa_=MX3(C0[0],C0[1],C1[0]); mxb_=MX3(C0[2],C0[3],C1[1]); mxa_=MX3(mxa_,C1[2],C1[3]); \
      mxa_=MX3(mxa_,C0[4],C0[5]); mxb_=MX3(mxb_,C0[6],C0[7]); mxa_=MX3(mxa_,C1[4],C1[5]); mxb_=MX3(mxb_,C1[6],C1[7]); PIN(mxa_); PIN(mxb_); SBAR(); \
    PVG(2); _Pragma("unroll") for(int r=8;r<16;r+=4){mxa_=MX3(mxa_,C0[r],C0[r+1]);mxb_=MX3(mxb_,C0[r+2],C0[r+3]);mxa_=MX3(mxa_,C1[r],C1[r+1]);mxb_=MX3(mxb_,C1[r+2],C1[r+3]);} PIN(mxa_); PIN(mxb_); SBAR(); \
    PVG(3); \
    { float rm=__builtin_fmaxf(mxa_,mxb_); { auto rr=__builtin_amdgcn_permlane32_swap(__float_as_uint(rm),__float_as_uint(rm),false,false); rm=__builtin_fmaxf(__uint_as_float(rr[0]),__uint_as_float(rr[1])); } \
      resc=false; \
      if(__builtin_expect(__any(rm>(float)THRL),0)){ const float dl=__builtin_fmaxf(rm,0.f); mhat+=dl; \
        _Pragma("unroll") for(int r=0;r<16;++r){C0[r]-=dl;C1[r]-=dl;} \
        const float f=__builtin_amdgcn_exp2f(-dl); l_reg*=f; if(hi==0)wsf[r32]=f; resc=true; MSPLIT(); } } \
    SBAR(); \
    GAPB(4, C0,C1,0,3); \
    KRD(GL,0); GAPB(5, C0,C1,3,6); \
    GAPB(6, C0,C1,6,9); \
    KRD(GL,1); GAPB(7, C0,C1,9,12); \
    GAPB(8, C0,C1,12,15); \
    KRD(GL,2); GAPB(9, C0,C1,15,18); \
    GAPB(10,C0,C1,18,21); \
    KRD(GL,3); GAPB(11,C0,C1,21,24); \
    GAPB(12,C0,C1,24,26); \
    GAPB(13,C0,C1,26,28); \
    GAPB(14,C0,C1,28,30); \
    GAPB(15,C0,C1,30,32); \
    }while(0)
  if(wid>=4)__builtin_amdgcn_s_setprio(1);
  int t=1;
  #undef CMASK
  #define CMASK(P0,P1,t) do{}while(0)
  for(;t+5<NT;t+=2){
    STEP(pB0,pB1,pA0,pA1,t,true,true,true);     WAIT_BAR(3); RESC(); ROT();
    STEP(pA0,pA1,pB0,pB1,t+1,true,true,true);   WAIT_BAR(3); RESC(); ROT();
  }
  #undef CMASK
  #define CMASK(P0,P1,t) do{int jb_=(t)-(NT-4); if(jb_>=0)cmask(P0,P1,jb_,qrel,hi);}while(0)
  #define ENDW(tt) do{ if((tt)+3<NT){WAIT_BAR(3);} else if((tt)+2<NT){WAIT_BAR(2);} else {WAIT_BAR(0);} }while(0)
  for(;t+1<NT;t+=2){
    STEP(pB0,pB1,pA0,pA1,t,(t+3<NT),(t+1<NT),(t+1<NT));       ENDW(t);   RESC(); ROT();
    STEP(pA0,pA1,pB0,pB1,t+1,(t+4<NT),(t+2<NT),(t+2<NT));     ENDW(t+1); RESC(); ROT();
  }
  STEP(pB0,pB1,pA0,pA1,NT-1,false,false,false); RESC();
  { float sacc=pB0[0]+pB0[1]; _Pragma("unroll") for(int r=2;r<16;++r)sacc+=pB0[r]; _Pragma("unroll") for(int r=0;r<16;++r)sacc+=pB1[r]; l_reg+=sacc;
    pw0=(u32x4){PKW(pB0,0),PKW(pB0,2),PKW(pB0,4),PKW(pB0,6)};pw1=(u32x4){PKW(pB0,8),PKW(pB0,10),PKW(pB0,12),PKW(pB0,14)};pw2=(u32x4){PKW(pB1,0),PKW(pB1,2),PKW(pB1,4),PKW(pB1,6)};pw3=(u32x4){PKW(pB1,8),PKW(pB1,10),PKW(pB1,12),PKW(pB1,14)};
    SBAR(); pv(o,vb0+2*sl_cur,PAF(0),PAF(1),PAF(2),PAF(3)); }
  #undef PKW
  #undef PAF
  #undef VFS
  #undef PVM
  #undef PVG
  #undef EXE
  #undef GAPN
  #undef BIASM
  #undef MSPLIT
  #undef PIN
  #undef MX3
  #undef GAPA
  #undef GAPB
  #undef EX
  #undef VRDJ
  #undef KRD
  #undef STEP
  #undef ENDW
  __builtin_amdgcn_s_setprio(0);
  {auto rr=__builtin_amdgcn_permlane32_swap(__float_as_uint(l_reg),__float_as_uint(l_reg),false,false);l_reg=__uint_as_float(rr[0])+__uint_as_float(rr[1]);}
  if(hi==0)wsf[32+r32]=l_reg;asm volatile("s_waitcnt lgkmcnt(0)":::"memory");
  float rli[16];
  #pragma unroll
  for(int r=0;r<16;++r)rli[r]=__builtin_amdgcn_rcpf(wsf[32+crow(r,hi)]);
  bf16*Ow=O+(rowbase+q0+wid*QBLK)*PO+hm*DV;
  { bf16*stg=(bf16*)(shm+LDS_OST)+wid*2048;
    #pragma unroll
    for(int ps=0;ps<2;++ps){
      #pragma unroll
      for(int r=0;r<16;++r){const int orow=crow(r,hi);
        #pragma unroll
        for(int d0=0;d0<2;++d0)stg[orow*64+d0*32+r32]=__float2bfloat16(o[2*ps+d0][r]*rli[r]);}
      asm volatile("s_waitcnt lgkmcnt(0)":::"memory");
      #pragma unroll
      for(int i=0;i<4;++i){const int row=i*8+(lane>>3),ch=lane&7; const u32x4 v=*(const u32x4*)(stg+row*64+ch*8); ATTN_STORE16(Ow+(long)row*PO+ps*64+ch*8,v);}
      asm volatile("s_waitcnt lgkmcnt(0)":::"memory"); } }
  asm volatile("s_waitcnt lgkmcnt(0)\n\ts_barrier":::"memory");
  #undef DMA_K
  #undef DMA_V
  #undef CMASK
  #undef ABIAS
  #undef START
  #undef RESC
  #undef ROT
}
constexpr int ATTN_LDS_BYTES=LDS_BYTES;
struct AttnTensors { const bf16* Q; const bf16* K; const bf16* V; bf16* O; };
struct AttnUnit { int bh; int qb; };
struct StaticOrder {
  int nw, r;
  __device__ __forceinline__ StaticOrder(int nw_,int r_):nw(nw_),r(r_){}
  __device__ __forceinline__ bool next(int i,AttnUnit&u)const{ const int p=i*nw+((i&1)?(nw-1-r):r); if(p>=64*NQB)return false; u.bh=p&63; u.qb=(NQB-1)-(p>>6); return true; }
  __device__ __forceinline__ void a_ready(const AttnUnit&)const{}
  __device__ __forceinline__ void done(const AttnUnit&)const{}
};
template<class Sched,int THRL=8> __device__ __forceinline__ void attn_phase(char*lds,const AttnTensors&T,const Sched&S){
  AttnUnit u;
  for(int i=0;S.next(i,u);++i){ S.a_ready(u); attn_unit<THRL>(u.bh/NHM,u.bh%NHM,u.qb,T.Q,T.K,T.V,T.O,lds); S.done(u); }
}
#undef SBAR
#undef WAIT_BAR
}

constexpr int NWAVES = 8, NTHR = NWAVES * 64;
#ifndef MK_N_LAUNCHES
#define MK_N_LAUNCHES 1
#endif
constexpr int N_LAUNCHES = MK_N_LAUNCHES;

constexpr int BATCH = 4, SEQ = 2048, DM = 4096, DEPTH = 2, M = BATCH * SEQ;
constexpr int NCOL = 20480, FFN = 11008, NGU = 2 * FFN, NPP = 8192;
constexpr int C_HQ = 0, C_HF = 1024, C_HV = 2048, C_HG = 3072, C_PU = 4096, C_DQ = 5120, C_DK = 6144, C_DV = 7168, C_GATE = 8192;
constexpr float EPS = 1e-6f;
constexpr float QSCALE_HG = 0.08838834764831845f;
constexpr int PH_PER_LAYER = 10, NPHASES = 1 + PH_PER_LAYER * DEPTH;
static_assert(N_LAUNCHES == 1 || N_LAUNCHES == NPHASES, "MK_N_LAUNCHES must be 1 or 21");

constexpr size_t MiB = 1u << 20;
constexpr size_t WS_CTL = 0, CTL_ZERO_BYTES = 1 * MiB;
constexpr size_t WS_LB = 1 * MiB;
constexpr size_t WS_POOLW = 2 * MiB;
constexpr size_t WS_WUP = 4 * MiB;
constexpr size_t WS_WOUT = 52 * MiB;
constexpr size_t WS_WDN = 116 * MiB;
constexpr size_t WS_WIN = 288 * MiB;
constexpr size_t WS_WGU = 608 * MiB;
constexpr size_t WS_H = 952 * MiB;
constexpr size_t WS_PROJ = 1016 * MiB;
constexpr size_t WS_ATTO = 1336 * MiB;
constexpr size_t WS_Y = 1368 * MiB;
constexpr size_t WS_POOLED = 1416 * MiB;
constexpr size_t WS_MERGED = 1432 * MiB;
constexpr size_t WS_Z = 1496 * MiB;
constexpr size_t WS_HGL = 1624 * MiB;
constexpr size_t WS_HGS = 1688 * MiB;
constexpr size_t WS_HGD = 1752 * MiB;
constexpr size_t WS_XB = 1560 * MiB, WS_XC = 1753 * MiB;
constexpr size_t WS_GATE = 1817 * MiB;
constexpr size_t WS_END = 2009 * MiB;
static_assert(WS_WUP + (size_t)DEPTH * 3 * 4096 * 1024 * 2 <= WS_WOUT && WS_WOUT + (size_t)DEPTH * 4096 * 4096 * 2 <= WS_WDN && WS_WDN + (size_t)DEPTH * 4096 * FFN * 2 <= WS_WIN, "ws map 1");
static_assert(WS_WIN + (size_t)DEPTH * NCOL * 4096 * 2 <= WS_WGU && WS_WGU + (size_t)DEPTH * NGU * 4096 * 2 <= WS_H && WS_H + (size_t)M * DM * 2 <= WS_PROJ && WS_PROJ + (size_t)M * NCOL * 2 <= WS_ATTO, "ws map 2");
static_assert(WS_ATTO + (size_t)M * 2048 * 2 <= WS_Y && WS_Y + (size_t)3 * M * 1024 * 2 <= WS_POOLED && WS_POOLED + (size_t)M * 1024 * 2 <= WS_MERGED && WS_MERGED + (size_t)M * DM * 2 <= WS_Z && WS_Z + (size_t)M * DM * 2 <= WS_XB && WS_XB + (size_t)M * DM * 2 <= WS_HGL, "ws map 3");
static_assert(WS_HGL + (size_t)1024 * 16384 * 4 <= WS_HGS && WS_HGS + (size_t)1024 * 16384 * 4 <= WS_HGD && WS_HGD + (size_t)1024 * 128 * 4 <= WS_XC && WS_XC + (size_t)M * DM * 2 <= WS_END && (size_t)M * FFN * 2 <= (size_t)M * NCOL * 2, "ws map 4");
constexpr int CW_BAR = 4096;

constexpr int RING_OFF = 0, RING_BYTES = 131072;
constexpr int LDSCTL_OFF = RING_BYTES, MISC_OFF = LDSCTL_OFF + 320;
constexpr int LDS_BYTES = 147456;
static_assert(MISC_OFF + 128 <= LDS_BYTES, "LDS map");

#define GAS __attribute__((address_space(1)))
#define LAS __attribute__((address_space(3)))
typedef unsigned short bf16;
typedef unsigned v4u __attribute__((ext_vector_type(4)));
typedef unsigned v2u __attribute__((ext_vector_type(2)));
typedef float f32x4 __attribute__((ext_vector_type(4)));
typedef GAS unsigned gu32;
#define RLX_AGENT __ATOMIC_RELAXED, __HIP_MEMORY_SCOPE_AGENT
#define LDS_WAIT() asm volatile("s_waitcnt lgkmcnt(0)" ::: "memory")
#define VM_WAIT() asm volatile("s_waitcnt vmcnt(0)" ::: "memory")
__device__ __forceinline__ unsigned f2bf(float f) { unsigned u = __builtin_bit_cast(unsigned, f); return (u + 0x7fffu + ((u >> 16) & 1u)) >> 16; }
typedef float f32x2_t_ __attribute__((ext_vector_type(2))); typedef __bf16 bf16x2_t_ __attribute__((ext_vector_type(2)));
__device__ __forceinline__ unsigned pk2(float lo, float hi) { const f32x2_t_ v = {lo, hi}; const bf16x2_t_ b = __builtin_convertvector(v, bf16x2_t_); return __builtin_bit_cast(unsigned, b); }
__device__ __forceinline__ unsigned short f2bf_hw(float f) { return (unsigned short)(pk2(f, f) & 0xffffu); }
__device__ __forceinline__ float bflo(unsigned w) { return __uint_as_float(w << 16); }
__device__ __forceinline__ float bfhi(unsigned w) { return __uint_as_float(w & 0xffff0000u); }
__device__ __forceinline__ void unpack8(const v4u w, float (&f)[8]) { f[0] = bflo(w.x); f[1] = bfhi(w.x); f[2] = bflo(w.y); f[3] = bfhi(w.y); f[4] = bflo(w.z); f[5] = bfhi(w.z); f[6] = bflo(w.w); f[7] = bfhi(w.w); }
__device__ __forceinline__ v4u pack8(const float (&f)[8]) { v4u w; w.x = pk2(f[0], f[1]); w.y = pk2(f[2], f[3]); w.z = pk2(f[4], f[5]); w.w = pk2(f[6], f[7]); return w; }
__device__ __forceinline__ float sigmoidf_(float z) { return 1.0f / (1.0f + __expf(-z)); }

#define XB_TMO      128
#define XB_XCNT(j)  (256  + 64 * (j))
#define XB_XSUB(j)  (1280 + 64 * (j))
#define XB_XGEN(j)  (2304 + 64 * (j))
#define XB_TOP      3328
#define XB_TOPGEN   3392
#define XCD_BAR_WORDS 3456
#define XB_SPIN_CAP (1u << 18)

__device__ __forceinline__ unsigned xb_ld(unsigned* p)              { return __hip_atomic_load(p, __ATOMIC_RELAXED, __HIP_MEMORY_SCOPE_AGENT); }
__device__ __forceinline__ unsigned xb_add(unsigned* p, unsigned v) { return __hip_atomic_fetch_add(p, v, __ATOMIC_RELAXED, __HIP_MEMORY_SCOPE_AGENT); }
__device__ __forceinline__ unsigned xb_xcc_id() { return (unsigned)__builtin_amdgcn_s_getreg((3 << 11) | 20) & 0xFu; }
#define XB_SPIN(cond, bar) do { unsigned _sp = 0; while (cond) { __builtin_amdgcn_s_sleep(1); \
    if ((++_sp & 255u) == 0u) { if (xb_ld(&(bar)[XB_TMO])) break; if (_sp > XB_SPIN_CAP) { atomicAdd(&(bar)[XB_TMO], 1u); break; } } } } while (0)

struct XcdBarrier {
    unsigned* bar; unsigned x;
    volatile LAS unsigned* st;
};

__device__ __forceinline__ XcdBarrier xcd_barrier_post(unsigned* bar, volatile LAS unsigned* st) {
    XcdBarrier b; b.bar = bar; b.x = xb_xcc_id(); b.st = st;
    if (threadIdx.x == 0) (void)xb_add(&bar[XB_XCNT(b.x)], 1u);
    return b;
}
__device__ __forceinline__ void xcd_barrier_complete(unsigned* bar, unsigned x, unsigned& nloc, unsigned& nx) {
    const unsigned G = gridDim.x * gridDim.y * gridDim.z;
    unsigned sum, cnt, mine, sp = 0u;
    for (;;) {
        sum = 0u; cnt = 0u; mine = 0u;
#pragma unroll
        for (unsigned j = 0; j < 16; ++j) { const unsigned c = xb_ld(&bar[XB_XCNT(j)]); sum += c; cnt += (c > 0u) ? 1u : 0u; mine = (j == x) ? c : mine; }
        if (sum == G) break;
        __builtin_amdgcn_s_sleep(1);
        if ((++sp & 255u) == 0u) { if (xb_ld(&bar[XB_TMO])) break; if (sp > XB_SPIN_CAP) { atomicAdd(&bar[XB_TMO], 1u); break; } }
    }
    nloc = mine > 0u ? mine : 1u; nx = cnt > 0u ? cnt : 1u;
}

__device__ __forceinline__ void xcd_barrier(const XcdBarrier& b) {
    asm volatile("s_waitcnt vmcnt(0)" ::: "memory");
    __syncthreads();
    if (threadIdx.x == 0) {
        unsigned* bar = b.bar;
        __builtin_amdgcn_s_waitcnt(0);
        unsigned nloc = b.st[0], nx = b.st[1];
        if (nloc == 0u) { xcd_barrier_complete(bar, b.x, nloc, nx); b.st[0] = nloc; b.st[1] = nx; }
        const unsigned old = xb_add(&bar[XB_XSUB(b.x)], 1u);
        const unsigned gen = old / nloc;
        if (old + 1u == (gen + 1u) * nloc) {
            __builtin_amdgcn_fence(__ATOMIC_RELEASE, "agent");
            asm volatile("s_waitcnt vmcnt(0)" ::: "memory");
            const unsigned og = xb_add(&bar[XB_TOP], 1u);
            const unsigned tg = og / nx;
            if (og + 1u == (tg + 1u) * nx) xb_add(&bar[XB_TOPGEN], 1u);
            else XB_SPIN(xb_ld(&bar[XB_TOPGEN]) == tg, bar);
            __builtin_amdgcn_fence(__ATOMIC_ACQUIRE, "agent");
            xb_add(&bar[XB_XGEN(b.x)], 1u);
            asm volatile("s_waitcnt vmcnt(0)" ::: "memory");
        } else {
            XB_SPIN(xb_ld(&bar[XB_XGEN(b.x)]) == gen, bar);
            __builtin_amdgcn_fence(__ATOMIC_ACQUIRE, "agent");
            asm volatile("s_waitcnt vmcnt(0)" ::: "memory");
        }
    }
    __syncthreads();
}


struct Frame {
    LAS unsigned char* lds;
    volatile LAS unsigned* MISC;
    unsigned char* ws; float* out;
    int tid, lane, wave;
    int vcu, G;
    unsigned long long tsec_acc, tsec_prev;
};
#ifndef HSEC
#define HSEC 0
#endif
#define TSEC_BEGIN() do { if constexpr (HSEC != 0) F.tsec_prev = __builtin_amdgcn_s_memrealtime(); } while (0)
#define TSEC(n) do { if constexpr (HSEC != 0) { const unsigned long long n_ = __builtin_amdgcn_s_memrealtime(); if (HSEC == (n)) F.tsec_acc += n_ - F.tsec_prev; F.tsec_prev = n_; } } while (0)
#define WSP(T, off) ((T*)(F.ws + (off)))
enum { I_X = 0, I_NMPRE, I_NMPOST, I_NFPRE, I_NFPOST, I_WIN, I_LBLOG, I_HGNORM, I_POOLW, I_POOLSC, I_LAMBDA, I_SUBLN, I_WUPA, I_WUPB, I_WUPC, I_WOUT, I_WGATE, I_WFUP, I_WDOWN };

struct Args { const float* in[19]; float* out; unsigned char* ws; int ph_lo, ph_hi; };

template <int X> __device__ __forceinline__ float xor_lane(float v) {
    if constexpr (X == 32) { const auto rr = __builtin_amdgcn_permlane32_swap(__float_as_uint(v), __float_as_uint(v), false, false); const unsigned a = rr[0], b = rr[1]; return __uint_as_float(a ^ b ^ __float_as_uint(v)); }
    else return __uint_as_float((unsigned)__builtin_amdgcn_ds_swizzle((int)__float_as_uint(v), (X << 10) | 0x1f));
}
__device__ __forceinline__ float wave_sum(float v) {
    v += xor_lane<1>(v); v += xor_lane<2>(v); v += xor_lane<4>(v); v += xor_lane<8>(v); v += xor_lane<16>(v); v += xor_lane<32>(v);
    return v;
}

struct CvtItem { const float* W; bf16* WT; int K, N, drow0, k0, n0; };
__device__ __forceinline__ void cvt_load(const CvtItem& c, float (&t)[32], int lane) {
#pragma unroll
    for (int i = 0; i < 32; ++i) t[i] = __builtin_nontemporal_load(c.W + (size_t)(c.k0 + 2 * i + (lane >> 5)) * c.N + c.n0 + (lane & 31));
}
__device__ __forceinline__ void cvt_store(const CvtItem& c, const float (&t)[32], LAS float* scr, int lane) {
#pragma unroll
    for (int i = 0; i < 32; ++i) scr[(2 * i + (lane >> 5)) * 33 + (lane & 31)] = t[i];
    LDS_WAIT(); asm volatile("" ::: "memory");
    const int ch = lane & 7;
#pragma unroll
    for (int j = 0; j < 4; ++j) { const int n = (lane >> 3) + 8 * j; const LAS float* s = scr + (8 * ch) * 33 + n;
        v4u o; o.x = pk2(s[0 * 33], s[1 * 33]); o.y = pk2(s[2 * 33], s[3 * 33]); o.z = pk2(s[4 * 33], s[5 * 33]); o.w = pk2(s[6 * 33], s[7 * 33]);
        *(GAS v4u*)(c.WT + (size_t)(c.drow0 + n) * c.K + c.k0 + 8 * ch) = o; }
    LDS_WAIT(); asm volatile("" ::: "memory");
}
__device__ __forceinline__ void rms_row_to_bf16(int lane, const float* xrow, const float* gain, bf16* orow) {
    const GAS f32x4* xr = (const GAS f32x4*)xrow + lane; const GAS f32x4* gr = (const GAS f32x4*)gain + lane;
    f32x4 v[16], gg[16]; float s = 0.f;
#pragma unroll
    for (int j = 0; j < 16; ++j) v[j] = __builtin_nontemporal_load(xr + 64 * j);
#pragma unroll
    for (int j = 0; j < 16; ++j) gg[j] = gr[64 * j];
#pragma unroll
    for (int j = 0; j < 16; ++j) s += (v[j].x * v[j].x + v[j].y * v[j].y) + (v[j].z * v[j].z + v[j].w * v[j].w);
    const float rstd = 1.0f / sqrtf(wave_sum(s) * (1.f / DM) + EPS);
    GAS v2u* o8 = (GAS v2u*)orow + lane;
#pragma unroll
    for (int j = 0; j < 16; ++j) { const f32x4 g = gg[j]; v2u w; w.x = pk2(v[j].x * rstd * g.x, v[j].y * rstd * g.y); w.y = pk2(v[j].z * rstd * g.z, v[j].w * rstd * g.w); o8[64 * j] = w; }
}
#define AIN(A, i) ({ int i_ = (i); asm volatile("" : "+s"(i_)); (A).in[i_]; })
enum { GRP_IN = 0, GRP_MIX = 1, GRP_FFN = 2, GRP_DN = 3 };
template <int GRP> __device__ __forceinline__ bool cvt_item(Frame& F, const Args& A, const int l, int r, CvtItem& c) {
    constexpr int I_IN = (DM / 64) * (NCOL / 32), I_UP = (1024 / 64) * (DM / 32), I_OUT = (DM / 64) * (DM / 32), I_G = (DM / 64) * (FFN / 32), I_DN = (FFN / 64) * (DM / 32), I_PL = (256 / 64) * (256 / 32);
    constexpr int NIT = (GRP == GRP_IN) ? I_IN : ((GRP == GRP_MIX) ? (I_OUT + 3 * I_UP + 4 * I_PL) : ((GRP == GRP_FFN) ? 2 * I_G : I_DN));
    if (r >= NIT) return false;
    int mode = 0;
    if constexpr (GRP == GRP_IN) { c.W = AIN(A, I_WIN) + (size_t)l * DM * NCOL; c.K = DM; c.N = NCOL; c.WT = WSP(bf16, WS_WIN) + (size_t)l * NCOL * DM; }
    else if constexpr (GRP == GRP_MIX) {
        if (r < I_OUT) { c.W = AIN(A, I_WOUT) + (size_t)l * DM * DM; c.K = DM; c.N = DM; c.WT = WSP(bf16, WS_WOUT) + (size_t)l * DM * DM; }
        else if ((r -= I_OUT) < 3 * I_UP) { const int j = r / I_UP; r -= j * I_UP; c.W = (j == 0 ? AIN(A, I_WUPA) : (j == 1 ? AIN(A, I_WUPB) : AIN(A, I_WUPC))) + (size_t)l * 1024 * DM; c.K = 1024; c.N = DM; c.WT = WSP(bf16, WS_WUP) + ((size_t)l * 3 + j) * DM * 1024; }
        else { r -= 3 * I_UP; const int g = r / I_PL; r -= g * I_PL; c.W = AIN(A, I_POOLW) + ((size_t)l * 4 + g) * 65536; c.K = 256; c.N = 256; c.WT = WSP(bf16, WS_POOLW) + ((size_t)l * 4 + g) * 65536; }
    } else if constexpr (GRP == GRP_FFN) { const int j = r / I_G; r -= j * I_G; c.W = (j == 0 ? AIN(A, I_WGATE) : AIN(A, I_WFUP)) + (size_t)l * DM * FFN; c.K = DM; c.N = FFN; c.WT = WSP(bf16, WS_WGU) + (size_t)l * NGU * DM; mode = 1 + j; }
    else { c.W = AIN(A, I_WDOWN) + (size_t)l * FFN * DM; c.K = FFN; c.N = DM; c.WT = WSP(bf16, WS_WDN) + (size_t)l * DM * FFN; }
    const int nblk = c.N / 32, kb = r / nblk, nb = r - kb * nblk; c.n0 = 32 * nb; c.k0 = 64 * kb;
    c.drow0 = (mode == 0) ? c.n0 : ((c.n0 >> 7) * 256 + (c.n0 & 127) + (mode == 2 ? 128 : 0));
    return true;
}
template <int GRP> __device__ __forceinline__ void convert_group_deep(Frame& F, const Args& A, const int l, const int rank, const int nranks) {
    LAS float* scr = (LAS float*)(F.lds + RING_OFF + F.wave * 16384);
    const int gw = rank * NWAVES + F.wave, NGW = nranks * NWAVES;
    for (int it = gw; ; it += 4 * NGW) {
        CvtItem c0, c1, c2, c3; float t0[32], t1[32], t2[32], t3[32];
        const bool v0 = cvt_item<GRP>(F, A, l, it, c0), v1 = cvt_item<GRP>(F, A, l, it + NGW, c1), v2 = cvt_item<GRP>(F, A, l, it + 2 * NGW, c2), v3 = cvt_item<GRP>(F, A, l, it + 3 * NGW, c3);
        if (!v0) break;
        cvt_load(c0, t0, F.lane); if (v1) cvt_load(c1, t1, F.lane); if (v2) cvt_load(c2, t2, F.lane); if (v3) cvt_load(c3, t3, F.lane);
        cvt_store(c0, t0, scr, F.lane); if (v1) cvt_store(c1, t1, scr, F.lane); if (v2) cvt_store(c2, t2, scr, F.lane); if (v3) cvt_store(c3, t3, scr, F.lane);
    }
}
template <int GRP> __device__ __forceinline__ void convert_group(Frame& F, const Args& A, const int l, const int rank, const int nranks) {
    LAS float* scr = (LAS float*)(F.lds + RING_OFF + F.wave * 16384);
    const int gw = rank * NWAVES + F.wave, NGW = nranks * NWAVES;
    for (int it = gw; ; it += 2 * NGW) {
        CvtItem c0, c1; float t0[32], t1[32];
        const bool v0 = cvt_item<GRP>(F, A, l, it, c0), v1 = cvt_item<GRP>(F, A, l, it + NGW, c1);
        if (!v0) break;
        cvt_load(c0, t0, F.lane); if (v1) cvt_load(c1, t1, F.lane);
        cvt_store(c0, t0, scr, F.lane); if (v1) cvt_store(c1, t1, scr, F.lane);
    }
}
__device__ __forceinline__ void p0_prologue(Frame& F, const Args& A) {
    const int gw = F.vcu * NWAVES + F.wave, NGW = F.G * NWAVES;
    convert_group<GRP_MIX>(F, A, 0, F.vcu, F.G);
    convert_group<GRP_IN>(F, A, 0, F.vcu, F.G);
    if (blockIdx.x == 0) {
        for (int c = F.tid; c < 1024; c += NTHR) {
            float lg[DEPTH], mx = -INFINITY, den = 0.f;
#pragma unroll
            for (int l = 0; l < DEPTH; ++l) { lg[l] = AIN(A, I_LBLOG)[l * 1024 + c]; mx = fmaxf(mx, lg[l]); }
#pragma unroll
            for (int l = 0; l < DEPTH; ++l) { lg[l] = expf(lg[l] - mx); den += lg[l]; }
            float cum = 0.f;
#pragma unroll
            for (int l = 0; l < DEPTH; ++l) { if (l > 0) cum += lg[l] / den; WSP(float, WS_LB)[l * 1024 + c] = cum; }
        }
    }
    for (int m = gw; m < M; m += NGW) rms_row_to_bf16(F.lane, AIN(A, I_X) + (size_t)m * DM, AIN(A, I_NMPRE), WSP(bf16, WS_H) + (size_t)m * DM);
}

template <bool XIN_F32, bool XOUT_F32>
__device__ __forceinline__ void resnorm_phase(Frame& F, const void* xold, void* xnew, const float* gpost, const float* gnext) {
    const int gw = F.vcu * NWAVES + F.wave, NGW = F.G * NWAVES;
    for (int m = gw; m < M; m += NGW) {
        const GAS v4u* zr = (const GAS v4u*)(WSP(bf16, WS_Z) + (size_t)m * DM) + F.lane;
        float v[8][8]; float s = 0.f;
#pragma unroll
        for (int j = 0; j < 8; ++j) { unpack8(__builtin_nontemporal_load(zr + 64 * j), v[j]);
#pragma unroll
            for (int k = 0; k < 8; ++k) s += v[j][k] * v[j][k]; }
        const float rz = 1.0f / sqrtf(wave_sum(s) * (1.f / DM) + EPS);
        float s2 = 0.f;
#pragma unroll
        for (int j = 0; j < 8; ++j) { float x[8];
            if constexpr (XIN_F32) { const GAS f32x4* xr = (const GAS f32x4*)((const float*)xold + (size_t)m * DM) + 2 * F.lane + 128 * j; const f32x4 a = __builtin_nontemporal_load(xr), b = __builtin_nontemporal_load(xr + 1); x[0] = a.x; x[1] = a.y; x[2] = a.z; x[3] = a.w; x[4] = b.x; x[5] = b.y; x[6] = b.z; x[7] = b.w; }
            else unpack8(__builtin_nontemporal_load((const GAS v4u*)((const bf16*)xold + (size_t)m * DM) + F.lane + 64 * j), x);
            const GAS f32x4* gp = (const GAS f32x4*)gpost + 2 * F.lane + 128 * j; const f32x4 g0 = gp[0], g1 = gp[1];
            const float g[8] = {g0.x, g0.y, g0.z, g0.w, g1.x, g1.y, g1.z, g1.w};
#pragma unroll
            for (int k = 0; k < 8; ++k) { v[j][k] = x[k] + v[j][k] * rz * g[k]; s2 += v[j][k] * v[j][k]; }
            if constexpr (XOUT_F32) { GAS f32x4* orow = (GAS f32x4*)((float*)xnew + (size_t)m * DM) + 2 * F.lane + 128 * j; __builtin_nontemporal_store((f32x4){v[j][0], v[j][1], v[j][2], v[j][3]}, orow); __builtin_nontemporal_store((f32x4){v[j][4], v[j][5], v[j][6], v[j][7]}, orow + 1); }
            else *((GAS v4u*)((bf16*)xnew + (size_t)m * DM) + F.lane + 64 * j) = pack8(v[j]); }
        if (gnext) {
            const float rx = 1.0f / sqrtf(wave_sum(s2) * (1.f / DM) + EPS);
            GAS v4u* ho = (GAS v4u*)(WSP(bf16, WS_H) + (size_t)m * DM) + F.lane; f32x4 ga[4], gb[4];
#pragma unroll
            for (int j = 0; j < 8; ++j) { if ((j & 3) == 0) {
#pragma unroll
                    for (int q = 0; q < 4; ++q) { const GAS f32x4* gn = (const GAS f32x4*)gnext + 2 * F.lane + 128 * (j + q); ga[q] = gn[0]; gb[q] = gn[1]; } }
                const f32x4 g0 = ga[j & 3], g1 = gb[j & 3]; float o[8];
                o[0] = v[j][0] * rx * g0.x; o[1] = v[j][1] * rx * g0.y; o[2] = v[j][2] * rx * g0.z; o[3] = v[j][3] * rx * g0.w; o[4] = v[j][4] * rx * g1.x; o[5] = v[j][5] * rx * g1.y; o[6] = v[j][6] * rx * g1.z; o[7] = v[j][7] * rx * g1.w;
                ho[64 * j] = pack8(o); }
        }
    }
}
template <int W> __device__ __forceinline__ void pool_item(const bf16* p, bf16* o, const int t0) {
    v4u pre[W - 1], cur[16];
#pragma unroll
    for (int i = 1; i < W; ++i) { pre[i - 1] = (v4u){0u, 0u, 0u, 0u}; if (t0 - i >= 0) pre[i - 1] = *(const GAS v4u*)(p - (size_t)i * NPP); }
#pragma unroll
    for (int r = 0; r < 16; ++r) cur[r] = *(const GAS v4u*)(p + (size_t)r * NPP);
    float s[8];
#pragma unroll
    for (int j = 0; j < 8; ++j) s[j] = 0.f;
#pragma unroll
    for (int i = 1; i < W; ++i) { float x[8]; unpack8(pre[i - 1], x);
#pragma unroll
        for (int j = 0; j < 8; ++j) s[j] += x[j]; }
#pragma unroll
    for (int r = 0; r < 16; ++r) { const int t = t0 + r; float c[8], ov[8]; unpack8(cur[r], c);
        const int cnt = (t + 1 < W) ? t + 1 : W; const float inv = 1.0f / (float)cnt;
#pragma unroll
        for (int j = 0; j < 8; ++j) { s[j] += c[j]; ov[j] = s[j] * inv - c[j]; }
        *(GAS v4u*)(o + (size_t)r * 1024) = pack8(ov);
        { float x[8]; unpack8((r - W + 1 >= 0) ? cur[(r - W + 1 >= 0) ? r - W + 1 : 0] : pre[(r - W + 1 >= 0) ? 0 : W - 2 - r], x);
#pragma unroll
          for (int j = 0; j < 8; ++j) s[j] -= x[j]; } }
}
__device__ __forceinline__ void pooled_phase(Frame& F, const int rank, const int nranks) {
    const int gwv = rank * NWAVES + F.wave, NGW = nranks * NWAVES;
    for (int it = gwv; it < (M / 32) * 4; it += NGW) {
        const int g = it & 3, rb = (it >> 2) * 2 + (F.lane >> 5), c8 = g * 256 + (F.lane & 31) * 8;
        const int row0 = rb * 16, t0 = row0 & (SEQ - 1);
        const bf16* p = WSP(bf16, WS_PROJ) + (size_t)row0 * NPP + C_PU + c8; bf16* o = WSP(bf16, WS_POOLED) + (size_t)row0 * 1024 + c8;
        if (g == 0) pool_item<2>(p, o, t0); else if (g == 1) pool_item<4>(p, o, t0); else if (g == 2) pool_item<8>(p, o, t0); else pool_item<16>(p, o, t0);
    }
}
__device__ __forceinline__ void attn_combine_phase(Frame& F, const float* lp, const float* sub, float lambda_init) {
    const float lam = expf(wave_sum(lp[F.lane] * lp[64 + F.lane])) - expf(wave_sum(lp[128 + F.lane] * lp[192 + F.lane])) + lambda_init;
    bf16* yc = WSP(bf16, WS_Y) + (size_t)2 * M * 1024;
    const int gt = F.vcu * NTHR + F.tid, NGT = F.G * NTHR;
    for (int it0 = gt; it0 < M * 8 * 16; it0 += 4 * NGT) {
        v4u qa[4], qb[4];
#pragma unroll
        for (int q = 0; q < 4; ++q) { const int it = it0 + q * NGT; if (it < M * 8 * 16) {
            const int l16 = it & 15, rh = it >> 4, h = rh & 7, row = rh >> 3, j = l16 >> 3, wcol = (l16 & 7) * 8;
            const bf16* o1 = WSP(bf16, WS_ATTO) + (size_t)row * 2048 + (h * 4 + j) * 64 + wcol; qa[q] = *(const GAS v4u*)o1; qb[q] = *(const GAS v4u*)(o1 + 128); } }
#pragma unroll
        for (int q = 0; q < 4; ++q) { const int it = it0 + q * NGT; if (it < M * 8 * 16) {
            const int l16 = it & 15, rh = it >> 4, h = rh & 7, row = rh >> 3;
            float a[8], b[8], d[8]; unpack8(qa[q], a); unpack8(qb[q], b);
            float ss = 0.f;
#pragma unroll
            for (int k = 0; k < 8; ++k) { d[k] = a[k] - lam * b[k]; ss += d[k] * d[k]; }
            ss += xor_lane<1>(ss); ss += xor_lane<2>(ss); ss += xor_lane<4>(ss); ss += xor_lane<8>(ss);
            const float rstd = (1.0f / sqrtf(ss * (1.f / 128.f) + EPS)) * (1.0f - lambda_init);
#pragma unroll
            for (int k = 0; k < 8; ++k) d[k] = d[k] * rstd * sub[l16 * 8 + k];
            *(GAS v4u*)(yc + (size_t)row * 1024 + h * 128 + l16 * 8) = pack8(d); } }
    }
}

__device__ __forceinline__ void hg_gate(float z, float lb, float& logf_, float& k_) {
    z = fminf(fmaxf(z, -30.f), 30.f);
    const float e = __expf(-z), sg = __builtin_amdgcn_rcpf(1.0f + e), om = e * sg;
    logf_ = __logf(lb + (1.0f - lb) * sg); k_ = (1.0f - lb) * om;
}
typedef short hbf16x8 __attribute__((ext_vector_type(8)));
__device__ __forceinline__ unsigned short ldg_u16(const bf16* p) { return *(const GAS unsigned short*)p; }
constexpr int HP = 72, QP = 136;
template <int NT_> struct HgRaw { v4u w[NT_][2]; };
template <int NT_> __device__ __forceinline__ void hg_load(HgRaw<NT_>& R, const bf16* rowbase  , const int (&col)[NT_], int tid) {
#pragma unroll
    for (int i = 0; i < NT_; ++i)
#pragma unroll
        for (int j = 0; j < 2; ++j) { const int vec = tid + NTHR * j; R.w[i][j] = *(const GAS v4u*)(rowbase + (size_t)(vec >> 4) * NPP + col[i] + (vec & 15) * 8); }
}
template <int NT_> __device__ __forceinline__ void hg_put(const HgRaw<NT_>& R, LAS bf16* const (&raw)[NT_], int tid) {
#pragma unroll
    for (int i = 0; i < NT_; ++i)
#pragma unroll
        for (int j = 0; j < 2; ++j) { const int vec = tid + NTHR * j; *(LAS v4u*)(raw[i] + (vec >> 4) * QP + (vec & 15) * 8) = R.w[i][j]; }
}
__device__ __forceinline__ const bf16* hg_rowbase(Frame& F, int u) { const int bh = u >> 5, c = u & 31, b = bh >> 3, h = bh & 7; return WSP(bf16, WS_PROJ) + ((size_t)b * SEQ + c * 64) * NPP + h * 128; }
__device__ __forceinline__ float lds_bf(const LAS bf16* p) { return __uint_as_float((unsigned)(*p) << 16); }
__device__ __forceinline__ void h1_unit(Frame& F, int layer, int u, HgRaw<2>& R, int unext) {
    const int bh = u >> 5, c = u & 31, b = bh >> 3, h = bh & 7; const size_t r0 = (size_t)b * SEQ + c * 64;
    LAS bf16* KDT = (LAS bf16*)(F.lds + RING_OFF); LAS bf16* VT = KDT + 128 * HP; LAS float* TOT = (LAS float*)(F.lds + RING_OFF + 2 * 128 * HP * 2);
    LAS bf16* RF = (LAS bf16*)(F.lds + RING_OFF + 40960); LAS bf16* RV = RF + 64 * QP;
    const int ch = F.tid & 127, sc = F.tid >> 7, g = F.lane >> 4, c16 = F.lane & 15;
    { const int col[2] = {C_HF, C_HV}; LAS bf16* const raw[2] = {RF, RV}; hg_put<2>(R, raw, F.tid); if (unext < 1024) hg_load<2>(R, hg_rowbase(F, unext), col, F.tid); }
    const float lb = WSP(float, WS_LB)[layer * 1024 + h * 128 + ch];
    __syncthreads();
    float bl[16], kq[16]; float run = 0.f;
#pragma unroll
    for (int i = 0; i < 16; ++i) { float lf; hg_gate(lds_bf(RF + (16 * sc + i) * QP + ch), lb, lf, kq[i]); run += lf; bl[i] = run; }
    TOT[sc * 128 + ch] = run;
    { v4u w0, w1; unsigned w[8];
#pragma unroll
      for (int i = 0; i < 8; ++i) w[i] = (unsigned)RV[(16 * sc + 2 * i) * QP + ch] | ((unsigned)RV[(16 * sc + 2 * i + 1) * QP + ch] << 16);
      w0.x = w[0]; w0.y = w[1]; w0.z = w[2]; w0.w = w[3]; w1.x = w[4]; w1.y = w[5]; w1.z = w[6]; w1.w = w[7];
      *(LAS v4u*)(VT + ch * HP + 16 * sc) = w0; *(LAS v4u*)(VT + ch * HP + 16 * sc + 8) = w1; }
    __syncthreads();
    { const float t0 = TOT[ch], t1 = TOT[128 + ch], t2 = TOT[256 + ch], t3 = TOT[384 + ch];
      const float r1 = t0, r2 = t0 + t1, r3 = r2 + t2, tot = r3 + t3, off = (sc == 0) ? 0.f : ((sc == 1) ? r1 : ((sc == 2) ? r2 : r3));
      float kd[16];
#pragma unroll
      for (int i = 0; i < 16; ++i) kd[i] = kq[i] * __expf(tot - (off + bl[i]));
      v4u w0, w1; w0.x = pk2(kd[0], kd[1]); w0.y = pk2(kd[2], kd[3]); w0.z = pk2(kd[4], kd[5]); w0.w = pk2(kd[6], kd[7]); w1.x = pk2(kd[8], kd[9]); w1.y = pk2(kd[10], kd[11]); w1.z = pk2(kd[12], kd[13]); w1.w = pk2(kd[14], kd[15]);
      *(LAS v4u*)(KDT + ch * HP + 16 * sc) = w0; *(LAS v4u*)(KDT + ch * HP + 16 * sc + 8) = w1;
      if (sc == 0) WSP(float, WS_HGD)[(size_t)u * 128 + ch] = __expf(tot); }
    __syncthreads();
    { const int wp = F.wave >> 1, wv = F.wave & 1;
      const int krow = 32 * wp + 8 * (c16 >> 2) + (c16 & 3);
      hbf16x8 a0[2], a1[2];
#pragma unroll
      for (int kt = 0; kt < 2; ++kt) { a0[kt] = *(const LAS hbf16x8*)(KDT + (krow + 4 * kt) * HP + 8 * g); a1[kt] = *(const LAS hbf16x8*)(KDT + (krow + 4 * kt) * HP + 32 + 8 * g); }
      bf16* lt = WSP(bf16, WS_HGL) + (size_t)u * 16384 + 32 * wp + 8 * g;
#pragma unroll
      for (int nn = 0; nn < 4; ++nn) { const int n = 4 * wv + nn;
          const hbf16x8 b0 = *(const LAS hbf16x8*)(VT + (16 * n + c16) * HP + 8 * g), b1 = *(const LAS hbf16x8*)(VT + (16 * n + c16) * HP + 32 + 8 * g);
          f32x4 acc[2];
#pragma unroll
          for (int kt = 0; kt < 2; ++kt) { acc[kt] = (f32x4){0.f, 0.f, 0.f, 0.f};
              acc[kt] = __builtin_amdgcn_mfma_f32_16x16x32_bf16(a0[kt], b0, acc[kt], 0, 0, 0); acc[kt] = __builtin_amdgcn_mfma_f32_16x16x32_bf16(a1[kt], b1, acc[kt], 0, 0, 0); }
          v4u o; o.x = pk2(acc[0][0], acc[0][1]); o.y = pk2(acc[0][2], acc[0][3]); o.z = pk2(acc[1][0], acc[1][1]); o.w = pk2(acc[1][2], acc[1][3]);
          *(GAS v4u*)(lt + (size_t)(16 * n + c16) * 128) = o; } }
    __syncthreads();
}
__device__ __forceinline__ void h2_phase(Frame& F) {
    const int gt = F.vcu * NTHR + F.tid, NGT = F.G * NTHR;
    for (int it = gt; it < 32 * 4096; it += NGT) {
        const int bh = it >> 12, e4 = it & 4095, k4 = e4 & 31;
        f32x4 st = (f32x4){0.f, 0.f, 0.f, 0.f};
        for (int c0 = 0; c0 < 32; c0 += 8) {
            f32x4 d[8]; v2u lw[8];
#pragma unroll
            for (int j = 0; j < 8; ++j) { const size_t u = (size_t)bh * 32 + c0 + j; d[j] = *((const GAS f32x4*)(WSP(float, WS_HGD) + u * 128) + k4); lw[j] = *((const GAS v2u*)(WSP(bf16, WS_HGL) + u * 16384) + e4); }
#pragma unroll
            for (int j = 0; j < 8; ++j) { const size_t u = (size_t)bh * 32 + c0 + j;
                v2u so; so.x = pk2(st[0], st[1]); so.y = pk2(st[2], st[3]);
                *((GAS v2u*)(WSP(bf16, WS_HGS) + u * 16384) + e4) = so;
                st[0] = d[j][0] * st[0] + bflo(lw[j].x); st[1] = d[j][1] * st[1] + bfhi(lw[j].x); st[2] = d[j][2] * st[2] + bflo(lw[j].y); st[3] = d[j][3] * st[3] + bfhi(lw[j].y); } }
    }
}
__device__ __forceinline__ void h3_unit(Frame& F, int layer, int u, const float* hgnorm, HgRaw<3>& R, int unext) {
    const int bh = u >> 5, c = u & 31, b = bh >> 3, h = bh & 7; const size_t r0 = (size_t)b * SEQ + c * 64;
    LAS bf16* QE = (LAS bf16*)(F.lds + RING_OFF); LAS bf16* QI = QE + 64 * QP; LAS bf16* KT = QI + 64 * QP; LAS bf16* VT = KT + 160 * QP; LAS bf16* PM = VT + 128 * HP;
    LAS float* TOT = (LAS float*)(PM + 64 * HP); LAS float* SS = TOT + 512;
    static_assert((2 * 64 * QP + 160 * QP + 128 * HP + 64 * HP) * 2 + 512 * 4 + 128 * 4 <= RING_BYTES, "H3 LDS");
    const int ch = F.tid & 127, sc = F.tid >> 7, g = F.lane >> 4, c16 = F.lane & 15;
    TSEC_BEGIN();
    LAS bf16* RF = KT; LAS bf16* RQ = KT + 64 * QP; LAS bf16* RV = QI;
    { const int col[3] = {C_HF, C_HQ, C_HV}; LAS bf16* const raw[3] = {RF, RQ, RV}; hg_put<3>(R, raw, F.tid); if (unext < 1024) hg_load<3>(R, hg_rowbase(F, unext), col, F.tid); }
    const int tb = F.wave & 3, vh = F.wave >> 2;
    hbf16x8 sfr[4][4];
    const int vrow = 64 * vh + 8 * (c16 >> 2) + (c16 & 3);
    { const bf16* st = WSP(bf16, WS_HGS) + (size_t)u * 16384 + (size_t)vrow * 128 + 8 * g;
#pragma unroll
      for (int ks = 0; ks < 4; ++ks)
#pragma unroll
          for (int n = 0; n < 4; ++n) sfr[ks][n] = *(const GAS hbf16x8*)(st + (size_t)(32 * (n >> 1) + 4 * (n & 1)) * 128 + 32 * ks); }
    const float lb = WSP(float, WS_LB)[layer * 1024 + h * 128 + ch];
    __syncthreads();
    float bl[16], kq[16], q[16]; float run = 0.f;
#pragma unroll
    for (int i = 0; i < 16; ++i) { float lf; hg_gate(lds_bf(RF + (16 * sc + i) * QP + ch), lb, lf, kq[i]); run += lf; bl[i] = run; q[i] = lds_bf(RQ + (16 * sc + i) * QP + ch); }
    TOT[sc * 128 + ch] = run;
    { v4u w0, w1; unsigned w[8];
#pragma unroll
      for (int i = 0; i < 8; ++i) w[i] = (unsigned)RV[(16 * sc + 2 * i) * QP + ch] | ((unsigned)RV[(16 * sc + 2 * i + 1) * QP + ch] << 16);
      w0.x = w[0]; w0.y = w[1]; w0.z = w[2]; w0.w = w[3]; w1.x = w[4]; w1.y = w[5]; w1.z = w[6]; w1.w = w[7];
      *(LAS v4u*)(VT + ch * HP + 16 * sc) = w0; *(LAS v4u*)(VT + ch * HP + 16 * sc + 8) = w1; }
    for (int i = F.tid; i < 64 * HP * 2 / 16; i += NTHR) ((LAS v4u*)PM)[i] = (v4u){0u, 0u, 0u, 0u};
    __syncthreads(); TSEC(1);
    { const float t0 = TOT[ch], t1 = TOT[128 + ch], t2 = TOT[256 + ch];
      float rr[4]; rr[0] = 0.f; rr[1] = t0; rr[2] = t0 + t1; rr[3] = rr[2] + t2;
      const float off = (sc == 0) ? rr[0] : ((sc == 1) ? rr[1] : ((sc == 2) ? rr[2] : rr[3]));
#pragma unroll
      for (int i = 0; i < 16; ++i) { const int t = 16 * sc + i; const float bt = off + bl[i];
          QE[t * QP + ch] = f2bf_hw(q[i] * __expf(bt)); QI[t * QP + ch] = f2bf_hw(q[i] * __expf(bl[i]));
#pragma unroll
          for (int ii = 0; ii < 4; ++ii) if (ii >= sc) KT[(8 * ii * (ii + 1) + t) * QP + ch] = f2bf_hw(kq[i] * __expf(rr[ii] - bt)); } }
    __syncthreads(); TSEC(2);
#pragma unroll
    for (int rep = 0; rep < 2; ++rep) { const int blk = F.wave + 8 * rep;
        if (blk < 10) { const int i = (blk >= 6) ? 3 : ((blk >= 3) ? 2 : ((blk >= 1) ? 1 : 0)), j = blk - (i * (i + 1)) / 2;
            f32x4 acc = (f32x4){0.f, 0.f, 0.f, 0.f};
#pragma unroll
            for (int ks = 0; ks < 4; ++ks) { const hbf16x8 a = *(const LAS hbf16x8*)(QI + (16 * i + c16) * QP + 32 * ks + 8 * g), bb = *(const LAS hbf16x8*)(KT + (8 * i * (i + 1) + 16 * j + c16) * QP + 32 * ks + 8 * g);
                acc = __builtin_amdgcn_mfma_f32_16x16x32_bf16(a, bb, acc, 0, 0, 0); }
#pragma unroll
            for (int r = 0; r < 4; ++r) { const int tl = 4 * g + r; const float val = (i == j && c16 > tl) ? 0.f : acc[r]; PM[(16 * i + tl) * HP + 16 * j + c16] = f2bf_hw(val); } } }
    __syncthreads(); TSEC(3);
    { f32x4 acc[4];
#pragma unroll
      for (int n = 0; n < 4; ++n) acc[n] = (f32x4){0.f, 0.f, 0.f, 0.f};
#pragma unroll
      for (int ks = 0; ks < 4; ++ks) { const hbf16x8 qb_ = *(const LAS hbf16x8*)(QE + (16 * tb + c16) * QP + 32 * ks + 8 * g);
#pragma unroll
          for (int n = 0; n < 4; ++n) acc[n] = __builtin_amdgcn_mfma_f32_16x16x32_bf16(sfr[ks][n], qb_, acc[n], 0, 0, 0); }
      const int nss = (tb >= 2) ? 2 : 1;
      for (int ss = 0; ss < nss; ++ss) { const hbf16x8 pb_ = *(const LAS hbf16x8*)(PM + (16 * tb + c16) * HP + 32 * ss + 8 * g);
#pragma unroll
          for (int n = 0; n < 4; ++n) { const hbf16x8 va_ = *(const LAS hbf16x8*)(VT + (vrow + 32 * (n >> 1) + 4 * (n & 1)) * HP + 32 * ss + 8 * g); acc[n] = __builtin_amdgcn_mfma_f32_16x16x32_bf16(va_, pb_, acc[n], 0, 0, 0); } }
      float s = 0.f;
#pragma unroll
      for (int n = 0; n < 4; ++n) s += (acc[n][0] * acc[n][0] + acc[n][1] * acc[n][1]) + (acc[n][2] * acc[n][2] + acc[n][3] * acc[n][3]);
      s += xor_lane<16>(s); s += xor_lane<32>(s);
      if (g == 0) SS[vh * 64 + 16 * tb + c16] = s;
      __syncthreads(); TSEC(4);
      { const int t = 16 * tb + c16; const float rstd = 1.0f / sqrtf((SS[t] + SS[64 + t]) * (1.f / 128.f) + EPS);
        const bf16* gp = WSP(bf16, WS_PROJ) + (r0 + t) * NPP + C_HG + h * 128 + 64 * vh + 8 * g; bf16* yo = WSP(bf16, WS_Y) + (r0 + t) * 1024 + h * 128 + 64 * vh + 8 * g;
        const float* gn = hgnorm + h * 128 + 64 * vh + 8 * g; v4u gwq[2]; f32x4 gvq[2][2];
#pragma unroll
        for (int p = 0; p < 2; ++p) { gwq[p] = *(const GAS v4u*)(gp + 32 * p); gvq[p][0] = *(const GAS f32x4*)(gn + 32 * p); gvq[p][1] = *(const GAS f32x4*)(gn + 32 * p + 4); }
#pragma unroll
        for (int p = 0; p < 2; ++p) { float z[8], o[8]; unpack8(gwq[p], z);
            const float gq[8] = {gvq[p][0].x, gvq[p][0].y, gvq[p][0].z, gvq[p][0].w, gvq[p][1].x, gvq[p][1].y, gvq[p][1].z, gvq[p][1].w};
#pragma unroll
            for (int k = 0; k < 8; ++k) o[k] = acc[2 * p + (k >> 2)][k & 3] * rstd * gq[k] * (z[k] * sigmoidf_(z[k]));
            *(GAS v4u*)(yo + 32 * p) = pack8(o); } } }
    asm volatile("s_waitcnt vmcnt(0)" ::: "memory"); __syncthreads(); TSEC(5);
}

__device__ __forceinline__ void h1_phase(Frame& F, int layer, int rank, int nranks) {
    int u = rank; if (u >= 1024) return;
    HgRaw<2> R; { const int col[2] = {C_HF, C_HV}; hg_load<2>(R, hg_rowbase(F, u), col, F.tid); }
    for (; u < 1024; u += nranks) h1_unit(F, layer, u, R, u + nranks);
}
__device__ __forceinline__ void h3_phase(Frame& F, int layer, const float* hgnorm, int rank, int nranks) {
    int u = rank; if (u >= 1024) return;
    HgRaw<3> R; { const int col[3] = {C_HF, C_HQ, C_HV}; hg_load<3>(R, hg_rowbase(F, u), col, F.tid); }
    for (; u < 1024; u += nranks) h3_unit(F, layer, u, hgnorm, R, u + nranks);
}

struct SchedPlain {
    pg8::TileOrder T; const char* A; const char* B; size_t ta, tb;
    __device__ __forceinline__ bool next(int i, pg8::Unit& u) const { int pm, pn; if (!T.tile(i, pm, pn)) return false; u.pm = pm; u.pn = pn; u.kind = 0; u.a = A + (size_t)pm * ta; u.b = B + (size_t)pn * tb; return true; }
};
struct SchedUp {
    pg8::TileOrder T; const char* Y; const char* W;
    __device__ __forceinline__ bool next(int i, pg8::Unit& u) const { const int ti = i / 3, br = i - 3 * ti; int pm, pn; if (!T.tile(ti, pm, pn)) return false; u.pm = pm; u.pn = pn; u.kind = br;
        u.a = Y + ((size_t)br * M * 1024 + (size_t)pm * 256 * 1024) * 2; u.b = W + ((size_t)br * DM + (size_t)pn * 256) * 1024 * 2; return true; }
};
struct SchedPool {
    int G, c; const char* A; const char* B;
    __device__ __forceinline__ bool next(int i, pg8::Unit& u) const { const int L = i * G + c; if (L >= 128) return false; u.pm = L >> 2; u.pn = L & 3; u.kind = 0;
        u.a = A + ((size_t)u.pm * 256 * 1024 + (size_t)u.pn * 256) * 2; u.b = B + (size_t)u.pn * 65536 * 2; return true; }
};
struct EpiProj {
    static constexpr int NST = 16;
    static constexpr bool PERM = true; bf16* O; bf16* G;
    __device__ __forceinline__ bool keep(const pg8::Unit&) const { return false; }
    __device__ __forceinline__ void operator()(pg8::f32x4 (&acc)[2][2][4][2], const pg8::Unit& u, int wr, int wc, int fr, int fq) const {
        const float sc = (u.pn < 4) ? QSCALE_HG : ((u.pn >= 20 && u.pn < 24) ? attn_body::C2 : 1.0f);
        const bool gate = u.pn >= 32;
        const int row0 = u.pm * 256 + wr * 64 + fr, col0 = u.pn * 256 + wc * 32 + 8 * fq;
#pragma unroll
        for (int ai = 0; ai < 2; ++ai)
#pragma unroll
            for (int m = 0; m < 4; ++m) { bf16* rowp = O + (size_t)(row0 + ai * 128 + m * 16) * NPP + col0;
#pragma unroll
                for (int bj = 0; bj < 2; ++bj) { pg8::f32x4 v0 = acc[ai][bj][m][0] * sc, v1 = acc[ai][bj][m][1] * sc;
                    if (gate) {
#pragma unroll
                        for (int j = 0; j < 4; ++j) { v0[j] = __builtin_amdgcn_exp2f(fminf(fmaxf(v0[j], -40.f), 40.f) * -1.4426950408889634f); v1[j] = __builtin_amdgcn_exp2f(fminf(fmaxf(v1[j], -40.f), 40.f) * -1.4426950408889634f); } }
                    pg8::u32x4 w; w.x = pg8::cvt_pk_bf16(v0[0], v0[1]); w.y = pg8::cvt_pk_bf16(v0[2], v0[3]); w.z = pg8::cvt_pk_bf16(v1[0], v1[1]); w.w = pg8::cvt_pk_bf16(v1[2], v1[3]);
                    if (gate) { const int k_ = (u.pn - 32) >> 4, po_ = (u.pn - 32) & 15; bf16* gq = G + ((size_t)((k_ * 32 + u.pm) * 16 + po_)) * 65536 + (wr * 4 + wc) * 8192 + (fq * 16 + fr) * 8; __builtin_nontemporal_store(w, (GAS pg8::u32x4*)(gq + ((ai * 4 + m) * 2 + bj) * 512)); } else *(GAS pg8::u32x4*)(rowp + bj * 128) = w; } }
    }
};
struct EpiPool {
    static constexpr int NST = 16;
    static constexpr bool PERM = true; bf16* O; const float* scale;
    __device__ __forceinline__ bool keep(const pg8::Unit&) const { return false; }
    __device__ __forceinline__ void operator()(pg8::f32x4 (&acc)[2][2][4][2], const pg8::Unit& u, int wr, int wc, int fr, int fq) const {
        const int row0 = u.pm * 256 + wr * 64 + fr, col0 = u.pn * 256 + wc * 32 + 8 * fq;
        pg8::f32x4 sv[2][2];
#pragma unroll
        for (int bj = 0; bj < 2; ++bj)
#pragma unroll
            for (int n = 0; n < 2; ++n) sv[bj][n] = *(const GAS pg8::f32x4*)(scale + col0 + bj * 128 + 4 * n);
#pragma unroll
        for (int ai = 0; ai < 2; ++ai)
#pragma unroll
            for (int m = 0; m < 4; ++m) { bf16* rowp = O + (size_t)(row0 + ai * 128 + m * 16) * 1024 + col0;
#pragma unroll
                for (int bj = 0; bj < 2; ++bj) { const pg8::f32x4 v0 = acc[ai][bj][m][0] * sv[bj][0], v1 = acc[ai][bj][m][1] * sv[bj][1];
                    pg8::u32x4 w; w.x = pg8::cvt_pk_bf16(v0[0], v0[1]); w.y = pg8::cvt_pk_bf16(v0[2], v0[3]); w.z = pg8::cvt_pk_bf16(v1[0], v1[1]); w.w = pg8::cvt_pk_bf16(v1[2], v1[3]);
                    *(GAS pg8::u32x4*)(rowp + bj * 128) = w; } }
    }
};
struct EpiUp {
    static constexpr int NST = 0;
    static constexpr bool PERM = true; const bf16* G; bf16* O;
    __device__ __forceinline__ bool keep(const pg8::Unit& u) const { return u.kind < 2; }
    __device__ __forceinline__ void operator()(pg8::f32x4 (&acc)[2][2][4][2], const pg8::Unit& u, int wr, int wc, int fr, int fq) const {
        const int row0 = u.pm * 256 + wr * 64 + fr, col0 = u.pn * 256 + wc * 32 + 8 * fq;
        const bf16* gp = G + ((size_t)((u.kind * 32 + u.pm) * 16 + u.pn)) * 65536 + (wr * 4 + wc) * 8192 + (fq * 16 + fr) * 8;
        if (u.kind < 2) {
#pragma unroll
            for (int ai = 0; ai < 2; ++ai) { v4u qa[8], qb[8];
#pragma unroll
                for (int i = 0; i < 8; ++i) { const int f = (ai * 8 + i) * 512; qa[i] = *(const GAS v4u*)(gp + f); qb[i] = *(const GAS v4u*)(gp + (size_t)32 * 16 * 65536 + f); }
#pragma unroll
                for (int i = 0; i < 8; ++i) { const int m = i >> 1, bj = i & 1; float za[8], zb[8]; unpack8(qa[i], za); unpack8(qb[i], zb);
#pragma unroll
                    for (int j = 0; j < 8; ++j) { const float r = (1.0f + zb[j]) * pg8::fast_rcp(1.0f + za[j]); acc[ai][bj][m][j >> 2][j & 3] *= r; } } }
        } else {
            v4u qc[16];
#pragma unroll
            for (int i = 0; i < 16; ++i) qc[i] = *(const GAS v4u*)(gp + i * 512);
#pragma unroll
            for (int i = 0; i < 16; ++i) { const int ai = i >> 3, m = (i >> 1) & 3, bj = i & 1; bf16* rowp = O + (size_t)(row0 + ai * 128 + m * 16) * DM + col0;
                float zc[8], o[8]; unpack8(qc[i], zc);
#pragma unroll
                for (int j = 0; j < 8; ++j) o[j] = acc[ai][bj][m][j >> 2][j & 3] * pg8::fast_rcp(1.0f + zc[j]);
                pg8::u32x4 w; w.x = pg8::cvt_pk_bf16(o[0], o[1]); w.y = pg8::cvt_pk_bf16(o[2], o[3]); w.z = pg8::cvt_pk_bf16(o[4], o[5]); w.w = pg8::cvt_pk_bf16(o[6], o[7]);
                *(GAS pg8::u32x4*)(rowp + bj * 128) = w; }
        }
    }
};
struct EpiZ {
    static constexpr int NST = 16;
    static constexpr bool PERM = true; bf16* C;
    __device__ __forceinline__ bool keep(const pg8::Unit&) const { return false; }
    __device__ __forceinline__ void operator()(pg8::f32x4 (&acc)[2][2][4][2], const pg8::Unit& u, int wr, int wc, int fr, int fq) const {
        const int row0 = u.pm * 256 + wr * 64 + fr, col0 = u.pn * 256 + wc * 32 + 8 * fq;
#pragma unroll
        for (int ai = 0; ai < 2; ++ai)
#pragma unroll
            for (int m = 0; m < 4; ++m) { bf16* rowp = C + (size_t)(row0 + ai * 128 + m * 16) * DM + col0;
#pragma unroll
                for (int bj = 0; bj < 2; ++bj) { const pg8::f32x4 v0 = acc[ai][bj][m][0], v1 = acc[ai][bj][m][1];
                    pg8::u32x4 w; w.x = pg8::cvt_pk_bf16(v0[0], v0[1]); w.y = pg8::cvt_pk_bf16(v0[2], v0[3]); w.z = pg8::cvt_pk_bf16(v1[0], v1[1]); w.w = pg8::cvt_pk_bf16(v1[2], v1[3]);
                    *(GAS pg8::u32x4*)(rowp + bj * 128) = w; } }
    }
};
struct EpiSwiglu {
    static constexpr int NST = 8;
    static constexpr bool PERM = true; bf16* O;
    __device__ __forceinline__ bool keep(const pg8::Unit&) const { return false; }
    __device__ __forceinline__ void operator()(pg8::f32x4 (&acc)[2][2][4][2], const pg8::Unit& u, int wr, int wc, int fr, int fq) const {
        const int row0 = u.pm * 256 + wr * 64 + fr, col0 = u.pn * 128 + wc * 32 + 8 * fq;
#pragma unroll
        for (int ai = 0; ai < 2; ++ai)
#pragma unroll
            for (int m = 0; m < 4; ++m) { bf16* rowp = O + (size_t)(row0 + ai * 128 + m * 16) * FFN + col0; float o[8];
#pragma unroll
                for (int j = 0; j < 8; ++j) { const float g = acc[ai][0][m][j >> 2][j & 3], up = acc[ai][1][m][j >> 2][j & 3]; o[j] = g * pg8::fast_rcp(1.0f + __expf(-g)) * up; }
                pg8::u32x4 w; w.x = pg8::cvt_pk_bf16(o[0], o[1]); w.y = pg8::cvt_pk_bf16(o[2], o[3]); w.z = pg8::cvt_pk_bf16(o[4], o[5]); w.w = pg8::cvt_pk_bf16(o[6], o[7]);
                *(GAS pg8::u32x4*)rowp = w; }
    }
};

#ifndef PH_ENABLE
#define PH_ENABLE 0xffff
#endif
#define PHE(b) ((PH_ENABLE >> (b)) & 1)
#ifndef PH_REPEAT
#define PH_REPEAT 0x0
#endif
#define PHR(b) ((PH_REPEAT >> (b)) & 1)
#ifndef TPROBE
#define TPROBE 0x0
#endif
#define TPROBE_FACTOR 4
#ifndef TSPREAD
#define TSPREAD 0x0
#endif
#define RUN(b, ...) do { if constexpr (PHE(b)) { __VA_ARGS__; } if constexpr (PHR(b)) { __syncthreads(); __VA_ARGS__; } } while (0)
#define IN(k) (lo <= (k) && (k) < hi)
#define PHASE_ENTER() do { int t_ = threadIdx.x, b_ = blockIdx.x, g_ = gridDim.x; unsigned char* w_ = args.ws; asm volatile("" : "+v"(t_), "+s"(w_), "+s"(b_), "+s"(g_)); F.tid = t_; F.lane = t_ & 63; F.wave = __builtin_amdgcn_readfirstlane(t_ >> 6); F.ws = w_; \
        bid = b_; F.G = g_; F.vcu = (g_ % 8 == 0) ? (b_ % 8) * (g_ / 8) + b_ / 8 : b_; } while (0)
#define INP(i) ({ int i_ = (i); asm volatile("" : "+s"(i_)); args.in[i_]; })
#define SEAM(k) do { if (N_LAUNCHES == 1 && IN(k) && IN((k) + 1)) { \
        if constexpr (((TSPREAD >> (k)) & 1) != 0) { if (threadIdx.x == 0) { const unsigned n_ = (unsigned)__builtin_amdgcn_s_memrealtime(); unsigned* c_ = (unsigned*)(args.ws + WS_CTL) + 8192 + 128 * (k); atomicMax(c_, n_); atomicMax(c_ + 64, ~n_); } } \
        XcdBarrier b_ = bar; unsigned* p_ = bar.bar; asm volatile("" : "+s"(p_)); b_.bar = p_; xcd_barrier(b_); if constexpr (PHR(15)) xcd_barrier(b_); } \
        if constexpr (((TSPREAD >> (k)) & 1) != 0) { unsigned* c_ = (unsigned*)(args.ws + WS_CTL) + 8192 + 128 * (k); const unsigned mx_ = __hip_atomic_load(c_, __ATOMIC_RELAXED, __HIP_MEMORY_SCOPE_AGENT), mn_ = ~__hip_atomic_load(c_ + 64, __ATOMIC_RELAXED, __HIP_MEMORY_SCOPE_AGENT); tp_acc += (unsigned long long)(mx_ - mn_); } \
        if constexpr (TPROBE != 0) { const unsigned long long now_ = __builtin_amdgcn_s_memrealtime(); if ((TPROBE >> (k)) & 1) tp_acc += now_ - tp_prev; tp_prev = now_; } } while (0)
template <int l> __device__ __forceinline__ void layer_program(Frame& F, const Args& args, const XcdBarrier& bar, const int lo, const int hi, unsigned char* lds, unsigned long long& tp_prev, unsigned long long& tp_acc) {
    int bid = (int)blockIdx.x;
        const int pb = 1 + PH_PER_LAYER * l;
        const float lambda_init = (l == 0) ? 0.2f : 0.35550906759f;
        if (IN(pb + 0)) { PHASE_ENTER();
            SchedPlain S; S.T.init(M / 256, NCOL / 256, F.G, bid); S.A = (const char*)WSP(bf16, WS_H); S.B = (const char*)(WSP(bf16, WS_WIN) + (size_t)l * NCOL * DM); S.ta = (size_t)256 * DM * 2; S.tb = (size_t)256 * DM * 2;
            EpiProj E{WSP(bf16, WS_PROJ), WSP(bf16, WS_GATE)};
            RUN(1, pg8::gemm_phase<EpiProj, SchedPlain, true, true>(F.lds + RING_OFF, DM, DM, DM, S, E));
            SEAM(pb + 0);
        }
        if (IN(pb + 1)) { PHASE_ENTER();
            const attn_body::AttnTensors AT{(const attn_body::bf16*)(WSP(bf16, WS_PROJ) + C_DQ), (const attn_body::bf16*)(WSP(bf16, WS_PROJ) + C_DK), (const attn_body::bf16*)(WSP(bf16, WS_PROJ) + C_DV), (attn_body::bf16*)WSP(bf16, WS_ATTO)};
            const attn_body::StaticOrder S((int)F.G, F.vcu);
            TSEC_BEGIN();
            const bool conv_first = ((F.vcu & 1) == 0);
            if (conv_first) { RUN(11, convert_group_deep<GRP_FFN>(F, args, l, F.vcu, F.G)); __syncthreads(); }
            RUN(2, attn_body::attn_phase<attn_body::StaticOrder>((char*)lds + RING_OFF, AT, S));
            __syncthreads(); TSEC(11);
            RUN(3, h1_phase(F, l, F.vcu, F.G); TSEC(12); pooled_phase(F, F.vcu, F.G); asm volatile("s_waitcnt vmcnt(0)" ::: "memory"); TSEC(13));
            if (!conv_first) { __syncthreads(); RUN(11, convert_group_deep<GRP_FFN>(F, args, l, F.vcu, F.G)); }
            SEAM(pb + 1);
        }
        if (IN(pb + 2)) { PHASE_ENTER();
            RUN(4, h2_phase(F); attn_combine_phase(F, INP(I_LAMBDA) + l * 256, INP(I_SUBLN) + l * 128, lambda_init));
            SchedPool S; S.G = F.G; S.c = bid; S.A = (const char*)WSP(bf16, WS_POOLED); S.B = (const char*)(WSP(bf16, WS_POOLW) + (size_t)l * 4 * 65536);
            EpiPool E{WSP(bf16, WS_Y) + (size_t)M * 1024, INP(I_POOLSC) + l * 1024};
            RUN(4, pg8::gemm_phase<EpiPool, SchedPool, true, true>(F.lds + RING_OFF, 256, 1024, 256, S, E));
            SEAM(pb + 2);
        }
        if (IN(pb + 3)) { PHASE_ENTER();
            RUN(5, h3_phase(F, l, INP(I_HGNORM) + l * 1024, F.vcu, F.G));
            SEAM(pb + 3);
        }
        if (IN(pb + 4)) { PHASE_ENTER();
            SchedUp S; S.T.init(M / 256, DM / 256, F.G, bid); S.Y = (const char*)WSP(bf16, WS_Y); S.W = (const char*)(WSP(bf16, WS_WUP) + (size_t)l * 3 * DM * 1024);
            EpiUp E{WSP(bf16, WS_GATE), WSP(bf16, WS_MERGED)};
            RUN(6, pg8::gemm_phase<EpiUp, SchedUp, true, true>(F.lds + RING_OFF, 1024, 1024, 1024, S, E));
            SEAM(pb + 4);
        }
        if (IN(pb + 5)) { PHASE_ENTER();
            SchedPlain S; S.T.init(M / 256, DM / 256, F.G, bid); S.A = (const char*)WSP(bf16, WS_MERGED); S.B = (const char*)(WSP(bf16, WS_WOUT) + (size_t)l * DM * DM); S.ta = (size_t)256 * DM * 2; S.tb = (size_t)256 * DM * 2;
            EpiZ E{WSP(bf16, WS_Z)};
            RUN(7, pg8::gemm_phase<EpiZ, SchedPlain, true, true>(F.lds + RING_OFF, DM, DM, DM, S, E));
            SEAM(pb + 5);
        }
        if (IN(pb + 6)) { PHASE_ENTER();
            if constexpr (l == 0) RUN(8, resnorm_phase<true, false>(F, INP(I_X), WSP(bf16, WS_XB), INP(I_NMPOST) + l * DM, INP(I_NFPRE) + l * DM));
            else RUN(8, resnorm_phase<false, false>(F, WSP(bf16, WS_XC), WSP(bf16, WS_XB), INP(I_NMPOST) + l * DM, INP(I_NFPRE) + l * DM));
            SEAM(pb + 6);
        }
        if (IN(pb + 7)) { PHASE_ENTER();
            SchedPlain S; S.T.init(M / 256, NGU / 256, F.G, bid); S.A = (const char*)WSP(bf16, WS_H); S.B = (const char*)(WSP(bf16, WS_WGU) + (size_t)l * NGU * DM); S.ta = (size_t)256 * DM * 2; S.tb = (size_t)256 * DM * 2;
            EpiSwiglu E{WSP(bf16, WS_PROJ)};
            RUN(9, pg8::gemm_phase<EpiSwiglu, SchedPlain, true, true>(F.lds + RING_OFF, DM, DM, DM, S, E));
            {
              const int full = (M / 256) * (NGU / 256) / F.G, rem = (M / 256) * (NGU / 256) - full * F.G, nidle = F.G - rem;
              if (rem == 0 || nidle < 32) { RUN(11, convert_group<GRP_DN>(F, args, l, F.vcu, F.G)); }
              else if (bid >= rem) { __syncthreads(); RUN(11, convert_group_deep<GRP_DN>(F, args, l, bid - rem, nidle)); } }
            SEAM(pb + 7);
        }
        if (IN(pb + 8)) { PHASE_ENTER();
            SchedPlain S; S.T.init(M / 256, DM / 256, F.G, bid); S.A = (const char*)WSP(bf16, WS_PROJ); S.B = (const char*)(WSP(bf16, WS_WDN) + (size_t)l * DM * FFN); S.ta = (size_t)256 * FFN * 2; S.tb = (size_t)256 * FFN * 2;
            EpiZ E{WSP(bf16, WS_Z)};
            RUN(10, pg8::gemm_phase<EpiZ, SchedPlain, true, true>(F.lds + RING_OFF, FFN, FFN, FFN, S, E));
            SEAM(pb + 8);
        }
        if (IN(pb + 9)) { PHASE_ENTER();
            if constexpr (l + 1 < DEPTH) { RUN(11, convert_group<GRP_MIX>(F, args, l + 1, F.vcu, F.G)); RUN(11, convert_group<GRP_IN>(F, args, l + 1, F.vcu, F.G)); }
            if constexpr (l + 1 < DEPTH) RUN(8, resnorm_phase<false, false>(F, WSP(bf16, WS_XB), WSP(bf16, WS_XC), INP(I_NFPOST) + l * DM, INP(I_NMPRE) + (l + 1) * DM));
            else RUN(8, resnorm_phase<false, true>(F, WSP(bf16, WS_XB), args.out, INP(I_NFPOST) + l * DM, (const float*)nullptr));
            SEAM(pb + 9);
        }
    }
__global__ void __launch_bounds__(NTHR, 2) trunk_fwd(Args args) {
    extern __shared__ __attribute__((aligned(16))) unsigned char lds[];
    Frame F;
    F.lds = (LAS unsigned char*)lds;
    F.MISC = (volatile LAS unsigned*)(F.lds + MISC_OFF);
    F.tid = threadIdx.x; F.lane = F.tid & 63; F.wave = __builtin_amdgcn_readfirstlane(F.tid >> 6);
    F.G = gridDim.x; { const int bx = blockIdx.x; F.vcu = (F.G % 8 == 0) ? (bx % 8) * (F.G / 8) + bx / 8 : bx; }
    F.ws = args.ws; F.out = args.out;
    gu32* const ctl = (gu32*)(args.ws + WS_CTL);
    for (int u = F.tid; u < (LDS_BYTES - LDSCTL_OFF) / 4; u += NTHR) ((LAS unsigned*)(F.lds + LDSCTL_OFF))[u] = 0u;
    __syncthreads();
    XcdBarrier bar; bar.bar = (unsigned*)(ctl + CW_BAR); bar.x = 0; bar.st = nullptr;
    if (N_LAUNCHES == 1) bar = xcd_barrier_post((unsigned*)(ctl + CW_BAR), F.MISC + 8);
    const int lo = args.ph_lo, hi = args.ph_hi;
    int bid = (int)blockIdx.x;
    unsigned long long tp_prev = (TPROBE != 0) ? __builtin_amdgcn_s_memrealtime() : 0ull, tp_acc = 0ull;
    F.tsec_acc = 0ull; F.tsec_prev = 0ull;

    if (IN(0)) { PHASE_ENTER(); RUN(0, p0_prologue(F, args)); SEAM(0); }

    layer_program<0>(F, args, bar, lo, hi, lds, tp_prev, tp_acc);
    layer_program<1>(F, args, bar, lo, hi, lds, tp_prev, tp_acc);
    if constexpr (HSEC != 0) tp_acc += F.tsec_acc;
    if constexpr (TPROBE != 0 || TSPREAD != 0 || HSEC != 0) {
        const unsigned long long now_ = __builtin_amdgcn_s_memrealtime(); if ((TPROBE >> (NPHASES - 1)) & 1) tp_acc += now_ - tp_prev;
        if (blockIdx.x == 0) { const unsigned long long t0_ = __builtin_amdgcn_s_memrealtime(); while (__builtin_amdgcn_s_memrealtime() - t0_ < tp_acc * TPROBE_FACTOR) __builtin_amdgcn_s_sleep(8); } }
#undef IN
#undef SEAM
#undef PHASE_ENTER
#undef INP
}

extern "C" void kernel_launch(void* const* d_in, const int* in_sizes, int n_in, void* d_out, int out_size, void* d_ws, size_t ws_size, hipStream_t stream) {
    static int grid = 0;
    if (grid == 0) {
        if (n_in != 19 || in_sizes[0] != M * DM || out_size != M * DM || ws_size < WS_END) { fprintf(stderr, "kernel_launch: built for 19 inputs, x and out of %d floats, >= %zu bytes of workspace; got n_in %d, in0 %d, out %d, ws %zu; nothing launched\n", M * DM, (size_t)WS_END, n_in, n_in > 0 ? in_sizes[0] : -1, out_size, ws_size); grid = -1; return; }
        int dev = 0, cus = 0, per_cu = 0;
        if (hipGetDevice(&dev) != hipSuccess || hipDeviceGetAttribute(&cus, hipDeviceAttributeMultiprocessorCount, dev) != hipSuccess) { fprintf(stderr, "kernel_launch: hipGetDevice / hipDeviceGetAttribute failed; nothing launched\n"); grid = -1; return; }
        if (hipFuncSetAttribute((const void*)trunk_fwd, hipFuncAttributeMaxDynamicSharedMemorySize, LDS_BYTES) != hipSuccess) { fprintf(stderr, "kernel_launch: hipFuncSetAttribute failed; nothing launched\n"); grid = -1; return; }
        if (hipOccupancyMaxActiveBlocksPerMultiprocessor(&per_cu, (const void*)trunk_fwd, NTHR, LDS_BYTES) != hipSuccess || per_cu < 1)
            fprintf(stderr, "kernel_launch: note: the occupancy query reports %d workgroups per CU\n", per_cu);
        (void)hipGetLastError();
        grid = cus;
        if (grid != 256) fprintf(stderr, "kernel_launch: %d CUs; the attention unit order is built for 256\n", grid);
    }
    if (grid < 0) return;
    if (hipMemsetAsync((char*)d_ws + WS_CTL, 0, CTL_ZERO_BYTES, stream) != hipSuccess) { fprintf(stderr, "kernel_launch: hipMemsetAsync of the control words failed; nothing launched\n"); return; }
    Args a{};
    for (int i = 0; i < 19; ++i) a.in[i] = (const float*)d_in[i];
    a.out = (float*)d_out; a.ws = (unsigned char*)d_ws;
    for (int li = 0; li < N_LAUNCHES; ++li) {
        a.ph_lo = (N_LAUNCHES == 1) ? 0 : li; a.ph_hi = (N_LAUNCHES == 1) ? NPHASES : li + 1;
        hipLaunchKernelGGL(trunk_fwd, dim3(grid), dim3(NTHR), LDS_BYTES, stream, a);
        const hipError_t le = hipPeekAtLastError();
        if (le != hipSuccess) { fprintf(stderr, "kernel_launch: launch %d failed: %s\n", li, hipGetErrorName(le)); break; }
    }
}
```

```cpp
#include <hip/hip_runtime.h>
#include <hip/hip_bf16.h>
#include <cstdio>
#include <cstdint>
#include <cmath>

namespace pg8 {
#define PG8_LAS __attribute__((address_space(3)))
typedef unsigned short bf16_t;
typedef short bf16x8 __attribute__((ext_vector_type(8)));
typedef float f32x4 __attribute__((ext_vector_type(4)));
typedef float f32x2 __attribute__((ext_vector_type(2)));
typedef unsigned u32x4 __attribute__((ext_vector_type(4)));
typedef unsigned u32x2 __attribute__((ext_vector_type(2)));
constexpr int BM = 256, BK = 64, HALF = 128, HTB = HALF * BK * 2  , STAGE_BYTES = 8 * HTB, NXCD = 8, WGM = 8;

__host__ __device__ __forceinline__ int lds_byte(int r, int c) { const int st = (r >> 4) * 2 + (c >> 5), rr = r & 15, cc = c & 31, ob = rr * 64 + cc * 2; return st * 1024 + (ob ^ (((ob >> 9) & 1) << 5)); }
__host__ __device__ __forceinline__ void stage_rc(int b, int& R, int& C) { const int st = b / 1024, sb = b % 1024, swz = sb ^ (((sb >> 9) & 1) << 5); R = (st >> 1) * 16 + swz / 64; C = (st & 1) * 32 + (swz % 64) / 2; }
__host__ __device__ __forceinline__ int perm32(int rho) { const int n = rho >> 4, i = rho & 15; return 8 * (i >> 2) + 4 * n + (i & 3); }

struct Unit { int pm, pn, kind; const char* a; const char* b; };

struct TileOrder {
    int nM, nN, nwg, G, c;
    __device__ __forceinline__ void init(int nM_, int nN_, int G_, int c_) { nM = nM_; nN = nN_; nwg = nM * nN; G = G_; c = c_; }
    __device__ __forceinline__ bool tile(int i, int& pm, int& pn) const {
        const long L = (long)i * G + c; if (L >= nwg) return false;
        int wgid = (int)L; { const int q = nwg / NXCD, r = nwg % NXCD, xcd = wgid % NXCD, off = wgid / NXCD; wgid = (xcd < r ? xcd * (q + 1) : r * (q + 1) + (xcd - r) * q) + off; }
        const int nig = WGM * nN, gid = wgid / nig, fm = gid * WGM, gsz = (nM - fm) < WGM ? (nM - fm) : WGM;
        pm = fm + ((wgid % nig) % gsz); pn = (wgid % nig) / gsz; return true;
    }
};

__device__ __forceinline__ unsigned cvt_pk_bf16(float lo, float hi) { unsigned r; asm volatile("v_cvt_pk_bf16_f32 %0, %1, %2" : "=v"(r) : "v"(lo), "v"(hi)); return r; }
__device__ __forceinline__ float bf_lo(unsigned w) { return __uint_as_float(w << 16); }
__device__ __forceinline__ float bf_hi(unsigned w) { return __uint_as_float(w & 0xffff0000u); }
__device__ __forceinline__ float fast_exp(float x) { return __builtin_amdgcn_exp2f(x * 1.4426950408889634f); }
__device__ __forceinline__ float fast_rcp(float x) { return __builtin_amdgcn_rcpf(x); }


template <class Epi, class Sched, bool ALIGN_EPI = false, bool SP2 = false>
__device__ __forceinline__ void gemm_phase(PG8_LAS unsigned char* lds, const int K, const int lda, const int ldb, const Sched& S, const Epi& E) {
    int tid = threadIdx.x; asm volatile("" : "+v"(tid));
    const int wid = __builtin_amdgcn_readfirstlane(tid >> 6), lane = tid & 63, wr = wid >> 2, wc = wid & 3, fr = lane & 15, fq = lane >> 4;
    int nt = K / BK; asm volatile("" : "+s"(nt));
    unsigned voffA[2], voffB[2];
#pragma unroll
    for (int i = 0; i < 2; ++i) { int R, C; stage_rc(tid * 16 + i * 8192, R, C); const int Rb = Epi::PERM ? ((R & ~31) + perm32(R & 31)) : R;
        voffA[i] = (unsigned)(R * lda + C) * 2u; voffB[i] = (unsigned)(Rb * ldb + C) * 2u; }
    const size_t kstep = (size_t)(BK * 2);
    const size_t hsA = (size_t)HALF * lda * 2, hsB = (size_t)HALF * ldb * 2;
    const unsigned ldsw = (unsigned)wid * 1024u;
    const int aoff = lds_byte(wr * 64 + fr, fq * 8), boff = lds_byte(wc * 32 + fr, fq * 8);
#define PG8_SA(b, h) (((b) * 2 + (h)) * HTB)
#define PG8_SB(b, h) ((4 + (b) * 2 + (h)) * HTB)
#define PG8_STAGE(bufoff, gbase, voff) do { _Pragma("unroll") for (int _i = 0; _i < 2; ++_i) \
        __builtin_amdgcn_global_load_lds((const unsigned*)((const char*)(gbase) + (voff)[_i]), (PG8_LAS unsigned*)(lds + (bufoff) + ldsw + _i * 8192), 16, 0, 0); } while (0)
#define PG8_LDA(dst, b, h) do { _Pragma("unroll") for (int m = 0; m < 4; ++m) _Pragma("unroll") for (int k = 0; k < 2; ++k) dst[m][k] = *(const PG8_LAS bf16x8*)(lds + PG8_SA(b, h) + aoff + m * 2048 + k * 1024); } while (0)
#define PG8_LDB(dst, b, h) do { _Pragma("unroll") for (int n = 0; n < 2; ++n) _Pragma("unroll") for (int k = 0; k < 2; ++k) dst[n][k] = *(const PG8_LAS bf16x8*)(lds + PG8_SB(b, h) + boff + n * 2048 + k * 1024); } while (0)
#define PG8_MMA(ai, bj, At, Bt) do { __builtin_amdgcn_s_setprio(1); _Pragma("unroll") for (int m = 0; m < 4; ++m) _Pragma("unroll") for (int n = 0; n < 2; ++n) _Pragma("unroll") for (int k = 0; k < 2; ++k) \
        acc[ai][bj][m][n] = __builtin_amdgcn_mfma_f32_16x16x32_bf16(Bt[n][k], At[m][k], acc[ai][bj][m][n], 0, 0, 0); __builtin_amdgcn_s_setprio(0); } while (0)
#define PG8_WAIT_V(n) asm volatile("s_waitcnt vmcnt(" #n ")" ::: "memory")
#define PG8_WAIT_L(n) asm volatile("s_waitcnt lgkmcnt(" #n ")" ::: "memory")
#define PG8_WAIT_VN(n) asm volatile("s_waitcnt vmcnt(%0)" :: "n"(n) : "memory")
#define PG8_BAR __builtin_amdgcn_s_barrier()
#define PG8_SCHED __builtin_amdgcn_sched_barrier(0)
    Unit cur, nxt; int ui = 0;
    if (!S.next(0, cur)) return;
    f32x4 acc[2][2][4][2];
#pragma unroll
    for (int a = 0; a < 2; ++a)
#pragma unroll
        for (int b = 0; b < 2; ++b)
#pragma unroll
            for (int m = 0; m < 4; ++m)
#pragma unroll
                for (int n = 0; n < 2; ++n) acc[a][b][m][n] = (f32x4){0.f, 0.f, 0.f, 0.f};
    bf16x8 At[4][2], B0[2][2], B1[2][2];
    const char* cA = cur.a; const char* cB = cur.b;
    if constexpr (SP2) {
        PG8_STAGE(PG8_SB(0, 0), cB, voffB); PG8_STAGE(PG8_SB(0, 1), cB + hsB, voffB); PG8_STAGE(PG8_SA(0, 0), cA, voffA); PG8_STAGE(PG8_SA(0, 1), cA + hsA, voffA);
        if (wr == 1) PG8_BAR;
        PG8_WAIT_V(2); PG8_BAR;
        PG8_STAGE(PG8_SB(1, 0), cB + kstep, voffB); PG8_STAGE(PG8_SA(1, 0), cA + kstep, voffA); PG8_STAGE(PG8_SB(1, 1), cB + hsB + kstep, voffB);
        PG8_WAIT_V(6); PG8_BAR;
    } else {
        PG8_STAGE(PG8_SB(0, 0), cB, voffB); PG8_STAGE(PG8_SA(0, 0), cA, voffA); PG8_STAGE(PG8_SB(0, 1), cB + hsB, voffB); PG8_STAGE(PG8_SA(0, 1), cA + hsA, voffA);
        if (wr == 1) PG8_BAR;
        PG8_WAIT_V(4); PG8_BAR;
        PG8_STAGE(PG8_SB(1, 0), cB + kstep, voffB); PG8_STAGE(PG8_SA(1, 0), cA + kstep, voffA); PG8_STAGE(PG8_SB(1, 1), cB + hsB + kstep, voffB);
        PG8_WAIT_V(6); PG8_BAR;
    }
    for (;;) {
        const bool has_next = S.next(ui + 1, nxt);
        const char* nA = has_next ? nxt.a : cA; const char* nB = has_next ? nxt.b : cB;
        for (int t = 0; t < nt; t += 2) {
            const bool last = (t == nt - 2);
            const char* a1 = cA + (size_t)(t + 1) * kstep;
            const char* a2 = last ? nA : cA + (size_t)(t + 2) * kstep; const char* b2 = last ? nB : cB + (size_t)(t + 2) * kstep;
            const char* a3 = a2 + kstep; const char* b3 = b2 + kstep;
            if constexpr (SP2) {
            const int relax = __builtin_amdgcn_readfirstlane(((Epi::NST > 0) && (t == 0) && (ui > 0)) ? 1 : 0);
#define PG8_WAIT_VR() do { if constexpr (Epi::NST > 0) { asm volatile("s_cmp_lg_u32 %0, 0\n\ts_cbranch_scc1 .Lrx%=\n\ts_waitcnt vmcnt(8)\n.Lrx%=:\n\ts_waitcnt vmcnt(%1)" :: "s"(relax), "n"(8 + Epi::NST) : "memory", "scc"); } else { PG8_WAIT_V(8); } } while (0)
            PG8_LDB(B0, 0, 0); PG8_LDB(B1, 0, 1); PG8_SCHED; PG8_LDA(At, 0, 0); PG8_STAGE(PG8_SA(1, 1), a1 + hsA, voffA);
            PG8_WAIT_VR(); PG8_WAIT_L(0); PG8_BAR; PG8_MMA(0, 0, At, B0); PG8_MMA(0, 1, At, B1); PG8_BAR; PG8_SCHED;
            PG8_LDA(At, 0, 1); PG8_STAGE(PG8_SB(0, 0), b2, voffB); PG8_STAGE(PG8_SB(0, 1), b2 + hsB, voffB); PG8_STAGE(PG8_SA(0, 0), a2, voffA);
            PG8_WAIT_VR(); PG8_WAIT_L(0); PG8_BAR; PG8_MMA(1, 0, At, B0); PG8_MMA(1, 1, At, B1); PG8_BAR; PG8_SCHED;
            PG8_LDB(B0, 1, 0); PG8_LDB(B1, 1, 1); PG8_SCHED; PG8_LDA(At, 1, 0); PG8_STAGE(PG8_SA(0, 1), a2 + hsA, voffA);
            PG8_WAIT_V(8); PG8_WAIT_L(0); PG8_BAR; PG8_MMA(0, 0, At, B0); PG8_MMA(0, 1, At, B1); PG8_BAR; PG8_SCHED;
            PG8_LDA(At, 1, 1); PG8_STAGE(PG8_SB(1, 0), b3, voffB); PG8_STAGE(PG8_SB(1, 1), b3 + hsB, voffB); PG8_STAGE(PG8_SA(1, 0), a3, voffA);
            PG8_WAIT_V(8); PG8_WAIT_L(0); PG8_BAR; PG8_MMA(1, 0, At, B0); PG8_MMA(1, 1, At, B1); PG8_BAR; PG8_SCHED;
#undef PG8_WAIT_VR
            } else {
            PG8_LDB(B0, 0, 0); PG8_SCHED; PG8_LDA(At, 0, 0); PG8_STAGE(PG8_SA(1, 1), a1 + hsA, voffA);
            PG8_WAIT_L(8); PG8_BAR; PG8_WAIT_L(0); PG8_MMA(0, 0, At, B0); PG8_BAR; PG8_SCHED;
            PG8_LDB(B1, 0, 1); PG8_STAGE(PG8_SB(0, 0), b2, voffB);
            PG8_BAR; PG8_WAIT_L(0); PG8_MMA(0, 1, At, B1); PG8_BAR;
            PG8_LDA(At, 0, 1); PG8_STAGE(PG8_SA(0, 0), a2, voffA);
            PG8_BAR; PG8_WAIT_L(0); PG8_MMA(1, 0, At, B0); PG8_BAR; PG8_SCHED;
            PG8_STAGE(PG8_SB(0, 1), b2 + hsB, voffB);
            PG8_WAIT_V(6); PG8_BAR; PG8_MMA(1, 1, At, B1); PG8_BAR;
            PG8_LDB(B0, 1, 0); PG8_SCHED; PG8_LDA(At, 1, 0); PG8_STAGE(PG8_SA(0, 1), a2 + hsA, voffA);
            PG8_WAIT_L(8); PG8_BAR; PG8_WAIT_L(0); PG8_MMA(0, 0, At, B0); PG8_BAR; PG8_SCHED;
            PG8_LDB(B1, 1, 1); PG8_STAGE(PG8_SB(1, 0), b3, voffB);
            PG8_BAR; PG8_WAIT_L(0); PG8_MMA(0, 1, At, B1); PG8_BAR;
            PG8_LDA(At, 1, 1); PG8_STAGE(PG8_SA(1, 0), a3, voffA);
            PG8_BAR; PG8_WAIT_L(0); PG8_MMA(1, 0, At, B0); PG8_BAR; PG8_SCHED;
            PG8_STAGE(PG8_SB(1, 1), b3 + hsB, voffB);
            PG8_WAIT_V(6); PG8_BAR; PG8_MMA(1, 1, At, B1); PG8_BAR;
            }
        }
        if constexpr (ALIGN_EPI) { if (wr == 0) PG8_BAR; }
        E(acc, cur, wr, wc, fr, fq);
        if (!has_next) break;
        if (!E.keep(cur)) {
#pragma unroll
        for (int a = 0; a < 2; ++a)
#pragma unroll
            for (int b = 0; b < 2; ++b)
#pragma unroll
                for (int m = 0; m < 4; ++m)
#pragma unroll
                    for (int n = 0; n < 2; ++n) acc[a][b][m][n] = (f32x4){0.f, 0.f, 0.f, 0.f};
        }
        cur = nxt; cA = nA; cB = nB; ++ui;
        if constexpr (ALIGN_EPI) { if (wr == 1) PG8_BAR; }
    }
    PG8_WAIT_V(0);
    if constexpr (!ALIGN_EPI) { if (wr == 0) PG8_BAR; }
    PG8_BAR;
#undef PG8_SA
#undef PG8_SB
#undef PG8_STAGE
#undef PG8_LDA
#undef PG8_LDB
#undef PG8_MMA
#undef PG8_WAIT_V
#undef PG8_WAIT_VN
#undef PG8_WAIT_L
#undef PG8_BAR
#undef PG8_SCHED
}
}

namespace attn_body {
using bf16=__hip_bfloat16;
using bf16x8=__attribute__((ext_vector_type(8)))short;
using s16x4=__attribute__((ext_vector_type(4)))short;
using f32x16=__attribute__((ext_vector_type(16)))float;
using u32x4=__attribute__((ext_vector_type(4)))unsigned;
constexpr int SEQ=2048,D=64,DV=128,NHM=16,NVH=32;
constexpr int PQ=8192,PO=2048;
constexpr int NW=8,QBLK=32,QB=QBLK*NW,KVBLK=64,NQB=SEQ/QB;
constexpr int ATTN_UNIT_ROWS=QB;
__device__ __forceinline__ int crow(int r,int hi){return (r&3)+8*(r>>2)+4*hi;}
#define SBAR() __builtin_amdgcn_sched_barrier(0)
__device__ __forceinline__ void cmask(f32x16&p0,f32x16&p1,int jb,int qrel,int hi){
  const float NEG=-INFINITY; int d=qrel-64*jb-4*hi; asm volatile("":"+v"(d));
  #pragma unroll
  for(int r=0;r<16;++r){const int c=(r&3)+8*(r>>2); if(c>d)p0[r]=NEG; if(c+32>d)p1[r]=NEG;}
}

constexpr int NSLOT=3, SLOTB=8192, VSLOTB=2*SLOTB;
constexpr int LDS_K=0, LDS_V=NSLOT*SLOTB, LDS_WS=LDS_V+NSLOT*VSLOTB, LDS_OST=LDS_WS+NW*64*4, LDS_BYTES=LDS_OST+NW*4096;
constexpr float C2=0.125f*1.4426950408889634f;
__device__ __forceinline__ void glds16(const void*gsrc,unsigned lds_dst){unsigned keep;
  asm volatile("s_mov_b32 %0, m0\n\ts_mov_b32 m0, %2\n\ts_nop 0\n\tglobal_load_lds_dwordx4 %1, off\n\ts_mov_b32 m0, %0":"=&s"(keep):"v"(gsrc),"s"(lds_dst):"memory");}
__device__ __forceinline__ float max3f(float a,float b,float c){float r;asm("v_max3_f32 %0, %1, %2, %3":"=v"(r):"v"(a),"v"(b),"v"(c));return r;}
__device__ __forceinline__ float max2f(float a,float b){float r;asm("v_max_f32_e32 %0, %1, %2":"=v"(r):"v"(a),"v"(b));return r;}
__device__ __forceinline__ float fadd_s(float a,float b){float r;asm("v_add_f32_e32 %0, %1, %2":"=v"(r):"v"(a),"v"(b));return r;}
__device__ __forceinline__ float fsub_s(float a,float b){float r;asm("v_sub_f32_e32 %0, %1, %2":"=v"(r):"v"(a),"v"(b));return r;}
typedef float f32x2_t __attribute__((ext_vector_type(2))); typedef __bf16 bf16x2_t __attribute__((ext_vector_type(2)));
__device__ __forceinline__ unsigned cvtpk_s(float lo,float hi){f32x2_t v={lo,hi};bf16x2_t b=__builtin_convertvector(v,bf16x2_t);return __builtin_bit_cast(unsigned,b);}
#define WAIT_BAR(N) asm volatile("s_waitcnt vmcnt(" #N ") lgkmcnt(0)\n\ts_barrier":::"memory")

__device__ __forceinline__ void qkt(f32x16&p0,f32x16&p1,const char*Kslot,const bf16x8*qr,const f32x16&negm,int r32,int hi){
  const char*kb=Kslot+hi*1024+r32*16;
  #pragma unroll
  for(int d0=0;d0<4;++d0){
    const bf16x8 b0=*reinterpret_cast<const bf16x8*>(kb+d0*2048);
    const bf16x8 b1=*reinterpret_cast<const bf16x8*>(kb+d0*2048+512);
    if(d0==0){p0=__builtin_amdgcn_mfma_f32_32x32x16_bf16(b0,qr[0],negm,0,0,0);p1=__builtin_amdgcn_mfma_f32_32x32x16_bf16(b1,qr[0],negm,0,0,0);}
    else{p0=__builtin_amdgcn_mfma_f32_32x32x16_bf16(b0,qr[d0],p0,0,0,0);p1=__builtin_amdgcn_mfma_f32_32x32x16_bf16(b1,qr[d0],p1,0,0,0);}}
}
typedef __attribute__((address_space(3))) const char* lds_cptr;
typedef short v4i16_t __attribute__((ext_vector_type(4)));
__device__ __forceinline__ void kload8(bf16x8*kf,lds_cptr kp){
  kf[0]=*(const __attribute__((address_space(3))) bf16x8*)(kp);      kf[1]=*(const __attribute__((address_space(3))) bf16x8*)(kp+512);
  kf[2]=*(const __attribute__((address_space(3))) bf16x8*)(kp+2048); kf[3]=*(const __attribute__((address_space(3))) bf16x8*)(kp+2560);
  kf[4]=*(const __attribute__((address_space(3))) bf16x8*)(kp+4096); kf[5]=*(const __attribute__((address_space(3))) bf16x8*)(kp+4608);
  kf[6]=*(const __attribute__((address_space(3))) bf16x8*)(kp+6144); kf[7]=*(const __attribute__((address_space(3))) bf16x8*)(kp+6656);
}
__device__ __forceinline__ void kload2(bf16x8*kf,lds_cptr kp,int j){ kf[2*j]=*(const __attribute__((address_space(3))) bf16x8*)(kp+j*2048); kf[2*j+1]=*(const __attribute__((address_space(3))) bf16x8*)(kp+j*2048+512); }
__device__ __forceinline__ s16x4 vtr(lds_cptr p){ return __builtin_bit_cast(s16x4,__builtin_amdgcn_ds_read_tr16_b64_v4i16((__attribute__((address_space(3))) v4i16_t*)p)); }
__device__ __forceinline__ float rowmax(const f32x16&p0,const f32x16&p1){
  float a=max3f(p0[0],p0[1],p1[0]),b=max3f(p0[2],p0[3],p1[1]);a=max3f(a,p1[2],p1[3]);
  #pragma unroll
  for(int r=4;r<16;r+=4){a=max3f(a,p0[r],p0[r+1]);b=max3f(b,p0[r+2],p0[r+3]);a=max3f(a,p1[r],p1[r+1]);b=max3f(b,p1[r+2],p1[r+3]);}
  const float m=max2f(a,b);
  auto rr=__builtin_amdgcn_permlane32_swap(__float_as_uint(m),__float_as_uint(m),false,false);
  return max2f(__uint_as_float(rr[0]),__uint_as_float(rr[1]));
}
__device__ __forceinline__ void pv(f32x16*o,int vb,bf16x8 pa0,bf16x8 pa1,bf16x8 pa2,bf16x8 pa3){
  #pragma unroll
  for(int d0=0;d0<4;++d0){s16x4 lo[4],hi[4];
    #pragma unroll
    for(int ks=0;ks<4;++ks){
      asm volatile("ds_read_b64_tr_b16 %0,%1 offset:%c2":"=&v"(lo[ks]):"v"(vb),"i"(d0*4096+ks*1024):"memory");
      asm volatile("ds_read_b64_tr_b16 %0,%1 offset:%c2":"=&v"(hi[ks]):"v"(vb),"i"(d0*4096+ks*1024+512):"memory");}
    asm volatile("s_waitcnt lgkmcnt(0)":::"memory");SBAR();
    #define PK(k) (bf16x8){lo[k][0],lo[k][1],lo[k][2],lo[k][3],hi[k][0],hi[k][1],hi[k][2],hi[k][3]}
    o[d0]=__builtin_amdgcn_mfma_f32_32x32x16_bf16(pa0,PK(0),o[d0],0,0,0);
    o[d0]=__builtin_amdgcn_mfma_f32_32x32x16_bf16(pa1,PK(1),o[d0],0,0,0);
    o[d0]=__builtin_amdgcn_mfma_f32_32x32x16_bf16(pa2,PK(2),o[d0],0,0,0);
    o[d0]=__builtin_amdgcn_mfma_f32_32x32x16_bf16(pa3,PK(3),o[d0],0,0,0);
    #undef PK
  }
}

#ifndef ATTN_STORE16
#define ATTN_STORE16(p,v) (*(__attribute__((address_space(1))) u32x4*)(p)=(v))
#endif
template<int THRL> __device__ __forceinline__ void attn_unit(int b,int hm,int qb,const bf16*Q,const bf16*__restrict__ K,const bf16*__restrict__ V,bf16*O,char*shm){
  const int hh=hm>>1, qkh=hm;
  const float sig=__builtin_ldexpf(1.4426950408889634f,-(hh+1));
  int tid=threadIdx.x; asm volatile("":"+v"(tid)); const int lane=tid&63,r32=lane&31,hi=lane>>5; const int wid=__builtin_amdgcn_readfirstlane(tid>>6);
  const long rowbase=(long)b*SEQ; const int q0=qb*QB;
  const bf16*Qw=Q+(rowbase+q0+wid*QBLK)*PQ+qkh*D;
  const bf16*Kh=K+rowbase*PQ+qkh*D,*Vh=V+rowbase*PQ+hh*DV;
  const unsigned lds0=(unsigned)(uintptr_t)shm;
  float*wsf=(float*)(shm+LDS_WS)+wid*64;
  const bf16*ksrc=Kh+(long)lane*PQ+wid*8;
  const bf16*vsrc=Vh+(long)(16*(wid&3)+(lane>>2))*PQ+(wid>>2)*32+(lane&3)*8;
  const unsigned kdst=lds0+LDS_K+wid*1024, vdst=lds0+LDS_V+wid*1024;
  #define DMA_K(t,slot) glds16(ksrc+(long)(t)*KVBLK*PQ,(unsigned)__builtin_amdgcn_readfirstlane(kdst+(slot)))
  #define DMA_V(t,slot) do{ glds16(vsrc+(long)(t)*KVBLK*PQ,(unsigned)__builtin_amdgcn_readfirstlane(vdst+2*(slot))); glds16(vsrc+(long)(t)*KVBLK*PQ+64,(unsigned)__builtin_amdgcn_readfirstlane(vdst+2*(slot)+8192)); }while(0)
  const int vb0=(int)(lds0+LDS_V)+((lane>>4)&1)*32+(lane&3)*8+(4*hi+((lane&15)>>2))*64;
  const char*Kbase=shm+LDS_K; bf16x8 kf[8];
  const lds_cptr shm3=(lds_cptr)shm; const lds_cptr kp0=shm3+LDS_K+hi*1024+r32*16; const lds_cptr vp0=shm3+LDS_V+((lane>>4)&1)*32+(lane&3)*8+(4*hi+((lane&15)>>2))*64;
  const int NT=(q0+QB)/KVBLK;
  DMA_K(0,0);DMA_V(0,0);DMA_K(1,SLOTB);
  bf16x8 qr[4];
  #pragma unroll
  for(int d0=0;d0<4;++d0)qr[d0]=*(const __attribute__((address_space(1))) bf16x8*)(&Qw[(long)r32*PQ+d0*16+hi*8]);
  float mhat=0.f,l_reg=0.f;f32x16 o[4];o[0]=f32x16{};o[1]=f32x16{};o[2]=f32x16{};o[3]=f32x16{};const f32x16 zero16=f32x16{};
  const int qrel=wid*QBLK+r32;
  const float sig64=sig*64.f, chi=sig*(float)(4*hi);
  const float sg1=sig, sg2=sig*2.f, sg3=sig*3.f, sg8=sig*8.f, sg32=sig*32.f;
  #define ABIAS(P0,P1,t) do{ float cb_[16]; cb_[0]=fmaf(sig64,(float)((t)-NT),chi)-mhat; cb_[4]=cb_[0]+sg8; cb_[8]=cb_[4]+sg8; cb_[12]=cb_[8]+sg8; \
      _Pragma("unroll") for(int g_=0;g_<4;++g_){ cb_[4*g_+1]=cb_[4*g_]+sg1; cb_[4*g_+2]=cb_[4*g_]+sg2; cb_[4*g_+3]=cb_[4*g_]+sg3; } \
      _Pragma("unroll") for(int r=0;r<16;++r){ P0[r]+=cb_[r]; P1[r]=(P1[r]+cb_[r])+sg32; } }while(0)
  #define CMASK(P0,P1,t) do{int jb_=(t)-(NT-4); if(jb_>=0)cmask(P0,P1,jb_,qrel,hi);}while(0)
  bool resc=false;
  #define START(P0,P1) do{ const float rm=rowmax(P0,P1); resc=false; \
    { const float dl=rm; mhat=fadd_s(mhat,dl); \
      _Pragma("unroll") for(int r=0;r<16;++r){P0[r]=fsub_s(P0[r],dl);P1[r]=fsub_s(P1[r],dl);} } \
    _Pragma("unroll") for(int r=0;r<16;++r)P0[r]=__builtin_amdgcn_exp2f(P0[r]); }while(0)
  #define RESC() do{ if(resc){ asm volatile("s_waitcnt lgkmcnt(0)":::"memory"); \
      _Pragma("unroll") for(int d_=0;d_<4;++d_) _Pragma("unroll") for(int r=0;r<16;++r)o[d_][r]*=wsf[crow(r,hi)]; } }while(0)
  f32x16 pA0,pA1,pB0,pB1;
  typedef unsigned u32x2_t __attribute__((ext_vector_type(2)));
  u32x2_t a0,a1,bq;
  { const unsigned shb=cvtpk_s(sig,0.f)&0xffffu; const unsigned S_=shb|(cvtpk_s(sig-__uint_as_float(shb<<16),0.f)<<16);
    const unsigned i0=__float_as_uint((float)r32)>>16, i1=__float_as_uint((float)(r32+32))>>16;
    a0[0]=hi?0x3F803F80u:(i0|(i0<<16)); a1[0]=hi?0x3F803F80u:(i1|(i1<<16)); a0[1]=0u; a1[1]=0u; bq[0]=hi?0u:S_; bq[1]=hi?0u:S_; }
  #define MSPLIT() do{ const float n_=-mhat; const unsigned hb_=cvtpk_s(n_,0.f)&0xffffu; const float r1_=n_-__uint_as_float(hb_<<16); const unsigned lb_=cvtpk_s(r1_,0.f)&0xffffu; \
      const float r2_=r1_-__uint_as_float(lb_<<16); const unsigned l2_=cvtpk_s(r2_,0.f)&0xffffu; if(hi){ bq[0]=hb_|(lb_<<16); bq[1]=l2_; } }while(0)
  int sl_prev=0,sl_cur=0,sl_next=SLOTB;
  #define ROT() do{sl_prev=sl_cur;sl_cur=sl_next;sl_next=(sl_next==(NSLOT-1)*SLOTB)?0:sl_next+SLOTB;}while(0)
  DMA_K(2,2*SLOTB);
  WAIT_BAR(4);
  qkt(pA0,pA1,Kbase,qr,zero16,r32,hi);asm volatile("s_nop 15\n\ts_nop 7":"+v"(pA0),"+v"(pA1));ABIAS(pA0,pA1,0);CMASK(pA0,pA1,0);
  START(pA0,pA1);
  _Pragma("unroll") for(int r=0;r<16;++r)pA1[r]=__builtin_amdgcn_exp2f(pA1[r]);
  MSPLIT();
  WAIT_BAR(0);
  DMA_K(3,0);DMA_V(1,SLOTB);
  ROT();
  kload8(kf,kp0+sl_cur);
  WAIT_BAR(3);
  s16x4 vlo[4],vhi[4]; u32x4 pw0,pw1,pw2,pw3;
  #define PKW(P,B) cvtpk_s(P[B],P[B+1])
  #define PAF(k) __builtin_bit_cast(bf16x8,pw##k)
  #define VFS(j) (bf16x8){vlo[(j)&3][0],vlo[(j)&3][1],vlo[(j)&3][2],vlo[(j)&3][3],vhi[(j)&3][0],vhi[(j)&3][1],vhi[(j)&3][2],vhi[(j)&3][3]}
  #define PIN(x) asm volatile("":"+v"(x))
  #define MX3(a,b,c) __builtin_fmaxf(__builtin_fmaxf((a),(b)),(c))
  #define GAPA(MF,CX,A0,A1,A2,A3,W0,W1,PW) do{ MF; PIN(CX); sacc+=A0; sacc+=A1; sacc+=A2; sacc+=A3; PIN(sacc); W0; W1; PIN(PW); SBAR(); }while(0)
  #define GAPN(MF,CX) do{ MF; PIN(CX); SBAR(); }while(0)
  #define EX(v) __builtin_amdgcn_exp2f(v)
  #define VRDJ(j) do{ vlo[(j)&3]=vtr(vp_+(((j)&3)*4096+((j)>>2)*1024)); vhi[(j)&3]=vtr(vp_+(((j)&3)*4096+((j)>>2)*1024+512)); SBAR(); }while(0)
  #define KRD(G,j) do{ if(G){ kload2(kf,kp0+sl_next,j); SBAR(); } }while(0)
  #define PVM(j) o[(j)&3]=__builtin_amdgcn_mfma_f32_32x32x16_bf16(__builtin_bit_cast(bf16x8,(((j)>>2)==0)?pw0:(((j)>>2)==1)?pw1:(((j)>>2)==2)?pw2:pw3),VFS(j),o[(j)&3],0,0,0)
  #define PVG(j) do{ if((j)+3<16){ VRDJ((j)+3); } PVM(j); PIN(o[(j)&3]); }while(0)
  #define EXE(C0,C1,e) do{ if((e)<16) C0[(e)&15]=EX(C0[(e)&15]); else C1[(e)&15]=EX(C1[(e)&15]); }while(0)
  #define GAPB(j,C0,C1,E0,E1) do{ PVG(j); _Pragma("unroll") for(int e_=(E0);e_<(E1);++e_) EXE(C0,C1,e_); PIN(C0); PIN(C1); SBAR(); }while(0)
  #define BIASM(AX) __builtin_amdgcn_mfma_f32_32x32x8bf16_1k(__builtin_bit_cast(s16x4,AX),__builtin_bit_cast(s16x4,bq),zero16,0,0,0)
  #define STEP(C0,C1,P0,P1,t,GK,GV,GL) do{ SBAR(); \
    const lds_cptr vp_=vp0+2*sl_prev; \
    { const unsigned nb_=__float_as_uint((float)(64*((t)-NT)))>>16; const unsigned ny_=hi?0x3F80u:(nb_|(nb_<<16)); a0[1]=ny_; a1[1]=ny_; } \
    float sacc=(P0[0]+P0[1]); \
    GAPA(C0=BIASM(a0),C0, P0[2],P0[3],P0[4],P0[5],     pw0[0]=PKW(P0,0), pw0[1]=PKW(P0,2), pw0); \
    GAPA(C1=BIASM(a1),C1, P0[6],P0[7],P0[8],P0[9],     pw0[2]=PKW(P0,4), pw0[3]=PKW(P0,6), pw0); \
    GAPA(C0=__builtin_amdgcn_mfma_f32_32x32x16_bf16(kf[0],qr[0],C0,0,0,0),C0,   P0[10],P0[11],P0[12],P0[13], pw1[0]=PKW(P0,8), pw1[1]=PKW(P0,10), pw1); \
    GAPA(C1=__builtin_amdgcn_mfma_f32_32x32x16_bf16(kf[1],qr[0],C1,0,0,0),C1,   P0[14],P0[15],P1[0],P1[1],   pw1[2]=PKW(P0,12),pw1[3]=PKW(P0,14), pw1); \
    GAPA(C0=__builtin_amdgcn_mfma_f32_32x32x16_bf16(kf[2],qr[1],C0,0,0,0),C0,   P1[2],P1[3],P1[4],P1[5],     pw2[0]=PKW(P1,0), pw2[1]=PKW(P1,2), pw2); \
    GAPA(C1=__builtin_amdgcn_mfma_f32_32x32x16_bf16(kf[3],qr[1],C1,0,0,0),C1,   P1[6],P1[7],P1[8],P1[9],     pw2[2]=PKW(P1,4), pw2[3]=PKW(P1,6), pw2); \
    GAPA(C0=__builtin_amdgcn_mfma_f32_32x32x16_bf16(kf[4],qr[2],C0,0,0,0),C0,   P1[10],P1[11],P1[12],P1[13], pw3[0]=PKW(P1,8), pw3[1]=PKW(P1,10), pw3); \
    VRDJ(0); GAPA(C1=__builtin_amdgcn_mfma_f32_32x32x16_bf16(kf[5],qr[2],C1,0,0,0),C1,   P1[14],P1[15],0.f,0.f,       pw3[2]=PKW(P1,12),pw3[3]=PKW(P1,14), pw3); \
    l_reg+=sacc; \
    VRDJ(1); GAPN(C0=__builtin_amdgcn_mfma_f32_32x32x16_bf16(kf[6],qr[3],C0,0,0,0),C0); \
    VRDJ(2); GAPN(C1=__builtin_amdgcn_mfma_f32_32x32x16_bf16(kf[7],qr[3],C1,0,0,0),C1); \
    if(GK){DMA_K((t)+3,sl_cur);} if(GV){DMA_V((t)+1,sl_next);} \
    SBAR(); \
    PVG(0); SBAR(); \
    CMASK(C0,C1,t); \
    float mxa_,mxb_; \
    PVG(1); mxa_=MX3(C0[0],C0[1],C1[0]); mxb_=MX3(C0[2],C0[3],C1[1]); mxa_=MX3(mxa_,C1[2],C1[3]); \
      mxa_=MX3(mxa_,C0[4],C0[5]); mxb_=MX3(mxb_,C0[6],C0[7]); mxa_=MX3(mxa_,C1[4],C1[5]); mxb_=MX3(mxb_,C1[6],C1[7]); PIN(mxa_); PIN(mxb_); SBAR(); \
    PVG(2); _Pragma("unroll") for(int r=8;r<16;r+=4){mxa_=MX3(mxa_,C0[r],C0[r+1]);mxb_=MX3(mxb_,C0[r+2],C0[r+3]);mxa_=MX3(mxa_,C1[r],C1[r+1]);mxb_=MX3(mxb_,C1[r+2],C1[r+3]);} PIN(mxa_); PIN(mxb_); SBAR(); \
    PVG(3); \
    { float rm=__builtin_fmaxf(mxa_,mxb_); { auto rr=__builtin_amdgcn_permlane32_swap(__float_as_uint(rm),__float_as_uint(rm),false,false); rm=__builtin_fmaxf(__uint_as_float(rr[0]),__uint_as_float(rr[1])); } \
      resc=false; \
      if(__builtin_expect(__any(rm>(float)THRL),0)){ const float dl=__builtin_fmaxf(rm,0.f); mhat+=dl; \
        _Pragma("unroll") for(int r=0;r<16;++r){C0[r]-=dl;C1[r]-=dl;} \
        const float f=__builtin_amdgcn_exp2f(-dl); l_reg*=f; if(hi==0)wsf[r32]=f; resc=true; MSPLIT(); } } \
    SBAR(); \
    GAPB(4, C0,C1,0,3); \
    KRD(GL,0); GAPB(5, C0,C1,3,6); \
    GAPB(6, C0,C1,6,9); \
    KRD(GL,1); GAPB(7, C0,C1,9,12); \
    GAPB(8, C0,C1,12,15); \
    KRD(GL,2); GAPB(9, C0,C1,15,18); \
    GAPB(10,C0,C1,18,21); \
    KRD(GL,3); GAPB(11,C0,C1,21,24); \
    GAPB(12,C0,C1,24,26); \
    GAPB(13,C0,C1,26,28); \
    GAPB(14,C0,C1,28,30); \
    GAPB(15,C0,C1,30,32); \
    }while(0)
  if(wid>=4)__builtin_amdgcn_s_setprio(1);
  int t=1;
  #undef CMASK
  #define CMASK(P0,P1,t) do{}while(0)
  for(;t+5<NT;t+=2){
    STEP(pB0,pB1,pA0,pA1,t,true,true,true);     WAIT_BAR(3); RESC(); ROT();
    STEP(pA0,pA1,pB0,pB1,t+1,true,true,true);   WAIT_BAR(3); RESC(); ROT();
  }
  #undef CMASK
  #define CMASK(P0,P1,t) do{int jb_=(t)-(NT-4); if(jb_>=0)cmask(P0,P1,jb_,qrel,hi);}while(0)
  #define ENDW(tt) do{ if((tt)+3<NT){WAIT_BAR(3);} else if((tt)+2<NT){WAIT_BAR(2);} else {WAIT_BAR(0);} }while(0)
  for(;t+1<NT;t+=2){
    STEP(pB0,pB1,pA0,pA1,t,(t+3<NT),(t+1<NT),(t+1<NT));       ENDW(t);   RESC(); ROT();
    STEP(pA0,pA1,pB0,pB1,t+1,(t+4<NT),(t+2<NT),(t+2<NT));     ENDW(t+1); RESC(); ROT();
  }
  STEP(pB0,pB1,pA0,pA1,NT-1,false,false,false); RESC();
  { float sacc=pB0[0]+pB0[1]; _Pragma("unroll") for(int r=2;r<16;++r)sacc+=pB0[r]; _Pragma("unroll") for(int r=0;r<16;++r)sacc+=pB1[r]; l_reg+=sacc;
    pw0=(u32x4){PKW(pB0,0),PKW(pB0,2),PKW(pB0,4),PKW(pB0,6)};pw1=(u32x4){PKW(pB0,8),PKW(pB0,10),PKW(pB0,12),PKW(pB0,14)};pw2=(u32x4){PKW(pB1,0),PKW(pB1,2),PKW(pB1,4),PKW(pB1,6)};pw3=(u32x4){PKW(pB1,8),PKW(pB1,10),PKW(pB1,12),PKW(pB1,14)};
    SBAR(); pv(o,vb0+2*sl_cur,PAF(0),PAF(1),PAF(2),PAF(3)); }
  #undef PKW
  #undef PAF
  #undef VFS
  #undef PVM
  #undef PVG
  #undef EXE
  #undef GAPN
  #undef BIASM
  #undef MSPLIT
  #undef PIN
  #undef MX3
  #undef GAPA
  #undef GAPB
  #undef EX
  #undef VRDJ
  #undef KRD
  #undef STEP
  #undef ENDW
  __builtin_amdgcn_s_setprio(0);
  {auto rr=__builtin_amdgcn_permlane32_swap(__float_as_uint(l_reg),__float_as_uint(l_reg),false,false);l_reg=__uint_as_float(rr[0])+__uint_as_float(rr[1]);}
  if(hi==0)wsf[32+r32]=l_reg;asm volatile("s_waitcnt lgkmcnt(0)":::"memory");
  float rli[16];
  #pragma unroll
  for(int r=0;r<16;++r)rli[r]=__builtin_amdgcn_rcpf(wsf[32+crow(r,hi)]);
  bf16*Ow=O+(rowbase+q0+wid*QBLK)*PO+hm*DV;
  { bf16*stg=(bf16*)(shm+LDS_OST)+wid*2048;
    #pragma unroll
    for(int ps=0;ps<2;++ps){
      #pragma unroll
      for(int r=0;r<16;++r){const int orow=crow(r,hi);
        #pragma unroll
        for(int d0=0;d0<2;++d0)stg[orow*64+d0*32+r32]=__float2bfloat16(o[2*ps+d0][r]*rli[r]);}
      asm volatile("s_waitcnt lgkmcnt(0)":::"memory");
      #pragma unroll
      for(int i=0;i<4;++i){const int row=i*8+(lane>>3),ch=lane&7; const u32x4 v=*(const u32x4*)(stg+row*64+ch*8); ATTN_STORE16(Ow+(long)row*PO+ps*64+ch*8,v);}
      asm volatile("s_waitcnt lgkmcnt(0)":::"memory"); } }
  asm volatile("s_waitcnt lgkmcnt(0)\n\ts_barrier":::"memory");
  #undef DMA_K
  #undef DMA_V
  #undef CMASK
  #undef ABIAS
  #undef START
  #undef RESC
  #undef ROT
}
constexpr int ATTN_LDS_BYTES=LDS_BYTES;
struct AttnTensors { const bf16* Q; const bf16* K; const bf16* V; bf16* O; };
struct AttnUnit { int bh; int qb; };
struct StaticOrder {
  int nw, r;
  __device__ __forceinline__ StaticOrder(int nw_,int r_):nw(nw_),r(r_){}
  __device__ __forceinline__ bool next(int i,AttnUnit&u)const{ const int p=i*nw+((i&1)?(nw-1-r):r); if(p>=64*NQB)return false; u.bh=p&63; u.qb=(NQB-1)-(p>>6); return true; }
  __device__ __forceinline__ void a_ready(const AttnUnit&)const{}
  __device__ __forceinline__ void done(const AttnUnit&)const{}
};
template<class Sched,int THRL=8> __device__ __forceinline__ void attn_phase(char*lds,const AttnTensors&T,const Sched&S){
  AttnUnit u;
  for(int i=0;S.next(i,u);++i){ S.a_ready(u); attn_unit<THRL>(u.bh/NHM,u.bh%NHM,u.qb,T.Q,T.K,T.V,T.O,lds); S.done(u); }
}
#undef SBAR
#undef WAIT_BAR
}

constexpr int NWAVES = 8, NTHR = NWAVES * 64;
#ifndef MK_N_LAUNCHES
#define MK_N_LAUNCHES 1
#endif
constexpr int N_LAUNCHES = MK_N_LAUNCHES;

constexpr int BATCH = 4, SEQ = 2048, DM = 4096, DEPTH = 2, M = BATCH * SEQ;
constexpr int NCOL = 20480, FFN = 11008, NGU = 2 * FFN, NPP = 8192;
constexpr int C_HQ = 0, C_HF = 1024, C_HV = 2048, C_HG = 3072, C_PU = 4096, C_DQ = 5120, C_DK = 6144, C_DV = 7168, C_GATE = 8192;
constexpr float EPS = 1e-6f;
constexpr float QSCALE_HG = 0.08838834764831845f;
constexpr int PH_PER_LAYER = 10, NPHASES = 1 + PH_PER_LAYER * DEPTH;
static_assert(N_LAUNCHES == 1 || N_LAUNCHES == NPHASES, "MK_N_LAUNCHES must be 1 or 21");

constexpr size_t MiB = 1u << 20;
constexpr size_t WS_CTL = 0, CTL_ZERO_BYTES = 1 * MiB;
constexpr size_t WS_LB = 1 * MiB;
constexpr size_t WS_POOLW = 2 * MiB;
constexpr size_t WS_WUP = 4 * MiB;
constexpr size_t WS_WOUT = 52 * MiB;
constexpr size_t WS_WDN = 116 * MiB;
constexpr size_t WS_WIN = 288 * MiB;
constexpr size_t WS_WGU = 608 * MiB;
constexpr size_t WS_H = 952 * MiB;
constexpr size_t WS_PROJ = 1016 * MiB;
constexpr size_t WS_ATTO = 1336 * MiB;
constexpr size_t WS_Y = 1368 * MiB;
constexpr size_t WS_POOLED = 1416 * MiB;
constexpr size_t WS_MERGED = 1432 * MiB;
constexpr size_t WS_Z = 1496 * MiB;
constexpr size_t WS_HGL = 1624 * MiB;
constexpr size_t WS_HGS = 1688 * MiB;
constexpr size_t WS_HGD = 1752 * MiB;
constexpr size_t WS_XB = 1560 * MiB, WS_XC = 1753 * MiB;
constexpr size_t WS_GATE = 1817 * MiB;
constexpr size_t WS_END = 2009 * MiB;
static_assert(WS_WUP + (size_t)DEPTH * 3 * 4096 * 1024 * 2 <= WS_WOUT && WS_WOUT + (size_t)DEPTH * 4096 * 4096 * 2 <= WS_WDN && WS_WDN + (size_t)DEPTH * 4096 * FFN * 2 <= WS_WIN, "ws map 1");
static_assert(WS_WIN + (size_t)DEPTH * NCOL * 4096 * 2 <= WS_WGU && WS_WGU + (size_t)DEPTH * NGU * 4096 * 2 <= WS_H && WS_H + (size_t)M * DM * 2 <= WS_PROJ && WS_PROJ + (size_t)M * NCOL * 2 <= WS_ATTO, "ws map 2");
static_assert(WS_ATTO + (size_t)M * 2048 * 2 <= WS_Y && WS_Y + (size_t)3 * M * 1024 * 2 <= WS_POOLED && WS_POOLED + (size_t)M * 1024 * 2 <= WS_MERGED && WS_MERGED + (size_t)M * DM * 2 <= WS_Z && WS_Z + (size_t)M * DM * 2 <= WS_XB && WS_XB + (size_t)M * DM * 2 <= WS_HGL, "ws map 3");
static_assert(WS_HGL + (size_t)1024 * 16384 * 4 <= WS_HGS && WS_HGS + (size_t)1024 * 16384 * 4 <= WS_HGD && WS_HGD + (size_t)1024 * 128 * 4 <= WS_XC && WS_XC + (size_t)M * DM * 2 <= WS_END && (size_t)M * FFN * 2 <= (size_t)M * NCOL * 2, "ws map 4");
constexpr int CW_BAR = 4096;

constexpr int RING_OFF = 0, RING_BYTES = 131072;
constexpr int LDSCTL_OFF = RING_BYTES, MISC_OFF = LDSCTL_OFF + 320;
constexpr int LDS_BYTES = 147456;
static_assert(MISC_OFF + 128 <= LDS_BYTES, "LDS map");

#define GAS __attribute__((address_space(1)))
#define LAS __attribute__((address_space(3)))
typedef unsigned short bf16;
typedef unsigned v4u __attribute__((ext_vector_type(4)));
typedef unsigned v2u __attribute__((ext_vector_type(2)));
typedef float f32x4 __attribute__((ext_vector_type(4)));
typedef GAS unsigned gu32;
#define RLX_AGENT __ATOMIC_RELAXED, __HIP_MEMORY_SCOPE_AGENT
#define LDS_WAIT() asm volatile("s_waitcnt lgkmcnt(0)" ::: "memory")
#define VM_WAIT() asm volatile("s_waitcnt vmcnt(0)" ::: "memory")
__device__ __forceinline__ unsigned f2bf(float f) { unsigned u = __builtin_bit_cast(unsigned, f); return (u + 0x7fffu + ((u >> 16) & 1u)) >> 16; }
typedef float f32x2_t_ __attribute__((ext_vector_type(2))); typedef __bf16 bf16x2_t_ __attribute__((ext_vector_type(2)));
__device__ __forceinline__ unsigned pk2(float lo, float hi) { const f32x2_t_ v = {lo, hi}; const bf16x2_t_ b = __builtin_convertvector(v, bf16x2_t_); return __builtin_bit_cast(unsigned, b); }
__device__ __forceinline__ unsigned short f2bf_hw(float f) { return (unsigned short)(pk2(f, f) & 0xffffu); }
__device__ __forceinline__ float bflo(unsigned w) { return __uint_as_float(w << 16); }
__device__ __forceinline__ float bfhi(unsigned w) { return __uint_as_float(w & 0xffff0000u); }
__device__ __forceinline__ void unpack8(const v4u w, float (&f)[8]) { f[0] = bflo(w.x); f[1] = bfhi(w.x); f[2] = bflo(w.y); f[3] = bfhi(w.y); f[4] = bflo(w.z); f[5] = bfhi(w.z); f[6] = bflo(w.w); f[7] = bfhi(w.w); }
__device__ __forceinline__ v4u pack8(const float (&f)[8]) { v4u w; w.x = pk2(f[0], f[1]); w.y = pk2(f[2], f[3]); w.z = pk2(f[4], f[5]); w.w = pk2(f[6], f[7]); return w; }
__device__ __forceinline__ float sigmoidf_(float z) { return 1.0f / (1.0f + __expf(-z)); }

#define XB_TMO      128
#define XB_XCNT(j)  (256  + 64 * (j))
#define XB_XSUB(j)  (1280 + 64 * (j))
#define XB_XGEN(j)  (2304 + 64 * (j))
#define XB_TOP      3328
#define XB_TOPGEN   3392
#define XCD_BAR_WORDS 3456
#define XB_SPIN_CAP (1u << 18)

__device__ __forceinline__ unsigned xb_ld(unsigned* p)              { return __hip_atomic_load(p, __ATOMIC_RELAXED, __HIP_MEMORY_SCOPE_AGENT); }
__device__ __forceinline__ unsigned xb_add(unsigned* p, unsigned v) { return __hip_atomic_fetch_add(p, v, __ATOMIC_RELAXED, __HIP_MEMORY_SCOPE_AGENT); }
__device__ __forceinline__ unsigned xb_xcc_id() { return (unsigned)__builtin_amdgcn_s_getreg((3 << 11) | 20) & 0xFu; }
#define XB_SPIN(cond, bar) do { unsigned _sp = 0; while (cond) { __builtin_amdgcn_s_sleep(1); \
    if ((++_sp & 255u) == 0u) { if (xb_ld(&(bar)[XB_TMO])) break; if (_sp > XB_SPIN_CAP) { atomicAdd(&(bar)[XB_TMO], 1u); break; } } } } while (0)

struct XcdBarrier {
    unsigned* bar; unsigned x;
    volatile LAS unsigned* st;
};

__device__ __forceinline__ XcdBarrier xcd_barrier_post(unsigned* bar, volatile LAS unsigned* st) {
    XcdBarrier b; b.bar = bar; b.x = xb_xcc_id(); b.st = st;
    if (threadIdx.x == 0) (void)xb_add(&bar[XB_XCNT(b.x)], 1u);
    return b;
}
__device__ __forceinline__ void xcd_barrier_complete(unsigned* bar, unsigned x, unsigned& nloc, unsigned& nx) {
    const unsigned G = gridDim.x * gridDim.y * gridDim.z;
    unsigned sum, cnt, mine, sp = 0u;
    for (;;) {
        sum = 0u; cnt = 0u; mine = 0u;
#pragma unroll
        for (unsigned j = 0; j < 16; ++j) { const unsigned c = xb_ld(&bar[XB_XCNT(j)]); sum += c; cnt += (c > 0u) ? 1u : 0u; mine = (j == x) ? c : mine; }
        if (sum == G) break;
        __builtin_amdgcn_s_sleep(1);
        if ((++sp & 255u) == 0u) { if (xb_ld(&bar[XB_TMO])) break; if (sp > XB_SPIN_CAP) { atomicAdd(&bar[XB_TMO], 1u); break; } }
    }
    nloc = mine > 0u ? mine : 1u; nx = cnt > 0u ? cnt : 1u;
}

__device__ __forceinline__ void xcd_barrier(const XcdBarrier& b) {
    asm volatile("s_waitcnt vmcnt(0)" ::: "memory");
    __syncthreads();
    if (threadIdx.x == 0) {
        unsigned* bar = b.bar;
        __builtin_amdgcn_s_waitcnt(0);
        unsigned nloc = b.st[0], nx = b.st[1];
        if (nloc == 0u) { xcd_barrier_complete(bar, b.x, nloc, nx); b.st[0] = nloc; b.st[1] = nx; }
        const unsigned old = xb_add(&bar[XB_XSUB(b.x)], 1u);
        const unsigned gen = old / nloc;
        if (old + 1u == (gen + 1u) * nloc) {
            __builtin_amdgcn_fence(__ATOMIC_RELEASE, "agent");
            asm volatile("s_waitcnt vmcnt(0)" ::: "memory");
            const unsigned og = xb_add(&bar[XB_TOP], 1u);
            const unsigned tg = og / nx;
            if (og + 1u == (tg + 1u) * nx) xb_add(&bar[XB_TOPGEN], 1u);
            else XB_SPIN(xb_ld(&bar[XB_TOPGEN]) == tg, bar);
            __builtin_amdgcn_fence(__ATOMIC_ACQUIRE, "agent");
            xb_add(&bar[XB_XGEN(b.x)], 1u);
            asm volatile("s_waitcnt vmcnt(0)" ::: "memory");
        } else {
            XB_SPIN(xb_ld(&bar[XB_XGEN(b.x)]) == gen, bar);
            __builtin_amdgcn_fence(__ATOMIC_ACQUIRE, "agent");
            asm volatile("s_waitcnt vmcnt(0)" ::: "memory");
        }
    }
    __syncthreads();
}


struct Frame {
    LAS unsigned char* lds;
    volatile LAS unsigned* MISC;
    unsigned char* ws; float* out;
    int tid, lane, wave;
    int vcu, G;
    unsigned long long tsec_acc, tsec_prev;
};
#ifndef HSEC
#define HSEC 0
#endif
#define TSEC_BEGIN() do { if constexpr (HSEC != 0) F.tsec_prev = __builtin_amdgcn_s_memrealtime(); } while (0)
#define TSEC(n) do { if constexpr (HSEC != 0) { const unsigned long long n_ = __builtin_amdgcn_s_memrealtime(); if (HSEC == (n)) F.tsec_acc += n_ - F.tsec_prev; F.tsec_prev = n_; } } while (0)
#define WSP(T, off) ((T*)(F.ws + (off)))
enum { I_X = 0, I_NMPRE, I_NMPOST, I_NFPRE, I_NFPOST, I_WIN, I_LBLOG, I_HGNORM, I_POOLW, I_POOLSC, I_LAMBDA, I_SUBLN, I_WUPA, I_WUPB, I_WUPC, I_WOUT, I_WGATE, I_WFUP, I_WDOWN };

struct Args { const float* in[19]; float* out; unsigned char* ws; int ph_lo, ph_hi; };

template <int X> __device__ __forceinline__ float xor_lane(float v) {
    if constexpr (X == 32) { const auto rr = __builtin_amdgcn_permlane32_swap(__float_as_uint(v), __float_as_uint(v), false, false); const unsigned a = rr[0], b = rr[1]; return __uint_as_float(a ^ b ^ __float_as_uint(v)); }
    else return __uint_as_float((unsigned)__builtin_amdgcn_ds_swizzle((int)__float_as_uint(v), (X << 10) | 0x1f));
}
__device__ __forceinline__ float wave_sum(float v) {
    v += xor_lane<1>(v); v += xor_lane<2>(v); v += xor_lane<4>(v); v += xor_lane<8>(v); v += xor_lane<16>(v); v += xor_lane<32>(v);
    return v;
}

struct CvtItem { const float* W; bf16* WT; int K, N, drow0, k0, n0; };
__device__ __forceinline__ void cvt_load(const CvtItem& c, float (&t)[32], int lane) {
#pragma unroll
    for (int i = 0; i < 32; ++i) t[i] = __builtin_nontemporal_load(c.W + (size_t)(c.k0 + 2 * i + (lane >> 5)) * c.N + c.n0 + (lane & 31));
}
__device__ __forceinline__ void cvt_store(const CvtItem& c, const float (&t)[32], LAS float* scr, int lane) {
#pragma unroll
    for (int i = 0; i < 32; ++i) scr[(2 * i + (lane >> 5)) * 33 + (lane & 31)] = t[i];
    LDS_WAIT(); asm volatile("" ::: "memory");
    const int ch = lane & 7;
#pragma unroll
    for (int j = 0; j < 4; ++j) { const int n = (lane >> 3) + 8 * j; const LAS float* s = scr + (8 * ch) * 33 + n;
        v4u o; o.x = pk2(s[0 * 33], s[1 * 33]); o.y = pk2(s[2 * 33], s[3 * 33]); o.z = pk2(s[4 * 33], s[5 * 33]); o.w = pk2(s[6 * 33], s[7 * 33]);
        *(GAS v4u*)(c.WT + (size_t)(c.drow0 + n) * c.K + c.k0 + 8 * ch) = o; }
    LDS_WAIT(); asm volatile("" ::: "memory");
}
__device__ __forceinline__ void rms_row_to_bf16(int lane, const float* xrow, const float* gain, bf16* orow) {
    const GAS f32x4* xr = (const GAS f32x4*)xrow + lane; const GAS f32x4* gr = (const GAS f32x4*)gain + lane;
    f32x4 v[16], gg[16]; float s = 0.f;
#pragma unroll
    for (int j = 0; j < 16; ++j) v[j] = __builtin_nontemporal_load(xr + 64 * j);
#pragma unroll
    for (int j = 0; j < 16; ++j) gg[j] = gr[64 * j];
#pragma unroll
    for (int j = 0; j < 16; ++j) s += (v[j].x * v[j].x + v[j].y * v[j].y) + (v[j].z * v[j].z + v[j].w * v[j].w);
    const float rstd = 1.0f / sqrtf(wave_sum(s) * (1.f / DM) + EPS);
    GAS v2u* o8 = (GAS v2u*)orow + lane;
#pragma unroll
    for (int j = 0; j < 16; ++j) { const f32x4 g = gg[j]; v2u w; w.x = pk2(v[j].x * rstd * g.x, v[j].y * rstd * g.y); w.y = pk2(v[j].z * rstd * g.z, v[j].w * rstd * g.w); o8[64 * j] = w; }
}
#define AIN(A, i) ({ int i_ = (i); asm volatile("" : "+s"(i_)); (A).in[i_]; })
enum { GRP_IN = 0, GRP_MIX = 1, GRP_FFN = 2, GRP_DN = 3 };
template <int GRP> __device__ __forceinline__ bool cvt_item(Frame& F, const Args& A, const int l, int r, CvtItem& c) {
    constexpr int I_IN = (DM / 64) * (NCOL / 32), I_UP = (1024 / 64) * (DM / 32), I_OUT = (DM / 64) * (DM / 32), I_G = (DM / 64) * (FFN / 32), I_DN = (FFN / 64) * (DM / 32), I_PL = (256 / 64) * (256 / 32);
    constexpr int NIT = (GRP == GRP_IN) ? I_IN : ((GRP == GRP_MIX) ? (I_OUT + 3 * I_UP + 4 * I_PL) : ((GRP == GRP_FFN) ? 2 * I_G : I_DN));
    if (r >= NIT) return false;
    int mode = 0;
    if constexpr (GRP == GRP_IN) { c.W = AIN(A, I_WIN) + (size_t)l * DM * NCOL; c.K = DM; c.N = NCOL; c.WT = WSP(bf16, WS_WIN) + (size_t)l * NCOL * DM; }
    else if constexpr (GRP == GRP_MIX) {
        if (r < I_OUT) { c.W = AIN(A, I_WOUT) + (size_t)l * DM * DM; c.K = DM; c.N = DM; c.WT = WSP(bf16, WS_WOUT) + (size_t)l * DM * DM; }
        else if ((r -= I_OUT) < 3 * I_UP) { const int j = r / I_UP; r -= j * I_UP; c.W = (j == 0 ? AIN(A, I_WUPA) : (j == 1 ? AIN(A, I_WUPB) : AIN(A, I_WUPC))) + (size_t)l * 1024 * DM; c.K = 1024; c.N = DM; c.WT = WSP(bf16, WS_WUP) + ((size_t)l * 3 + j) * DM * 1024; }
        else { r -= 3 * I_UP; const int g = r / I_PL; r -= g * I_PL; c.W = AIN(A, I_POOLW) + ((size_t)l * 4 + g) * 65536; c.K = 256; c.N = 256; c.WT = WSP(bf16, WS_POOLW) + ((size_t)l * 4 + g) * 65536; }
    } else if constexpr (GRP == GRP_FFN) { const int j = r / I_G; r -= j * I_G; c.W = (j == 0 ? AIN(A, I_WGATE) : AIN(A, I_WFUP)) + (size_t)l * DM * FFN; c.K = DM; c.N = FFN; c.WT = WSP(bf16, WS_WGU) + (size_t)l * NGU * DM; mode = 1 + j; }
    else { c.W = AIN(A, I_WDOWN) + (size_t)l * FFN * DM; c.K = FFN; c.N = DM; c.WT = WSP(bf16, WS_WDN) + (size_t)l * DM * FFN; }
    const int nblk = c.N / 32, kb = r / nblk, nb = r - kb * nblk; c.n0 = 32 * nb; c.k0 = 64 * kb;
    c.drow0 = (mode == 0) ? c.n0 : ((c.n0 >> 7) * 256 + (c.n0 & 127) + (mode == 2 ? 128 : 0));
    return true;
}
template <int GRP> __device__ __forceinline__ void convert_group_deep(Frame& F, const Args& A, const int l, const int rank, const int nranks) {
    LAS float* scr = (LAS float*)(F.lds + RING_OFF + F.wave * 16384);
    const int gw = rank * NWAVES + F.wave, NGW = nranks * NWAVES;
    for (int it = gw; ; it += 4 * NGW) {
        CvtItem c0, c1, c2, c3; float t0[32], t1[32], t2[32], t3[32];
        const bool v0 = cvt_item<GRP>(F, A, l, it, c0), v1 = cvt_item<GRP>(F, A, l, it + NGW, c1), v2 = cvt_item<GRP>(F, A, l, it + 2 * NGW, c2), v3 = cvt_item<GRP>(F, A, l, it + 3 * NGW, c3);
        if (!v0) break;
        cvt_load(c0, t0, F.lane); if (v1) cvt_load(c1, t1, F.lane); if (v2) cvt_load(c2, t2, F.lane); if (v3) cvt_load(c3, t3, F.lane);
        cvt_store(c0, t0, scr, F.lane); if (v1) cvt_store(c1, t1, scr, F.lane); if (v2) cvt_store(c2, t2, scr, F.lane); if (v3) cvt_store(c3, t3, scr, F.lane);
    }
}
template <int GRP> __device__ __forceinline__ void convert_group(Frame& F, const Args& A, const int l, const int rank, const int nranks) {
    LAS float* scr = (LAS float*)(F.lds + RING_OFF + F.wave * 16384);
    const int gw = rank * NWAVES + F.wave, NGW = nranks * NWAVES;
    for (int it = gw; ; it += 2 * NGW) {
        CvtItem c0, c1; float t0[32], t1[32];
        const bool v0 = cvt_item<GRP>(F, A, l, it, c0), v1 = cvt_item<GRP>(F, A, l, it + NGW, c1);
        if (!v0) break;
        cvt_load(c0, t0, F.lane); if (v1) cvt_load(c1, t1, F.lane);
        cvt_store(c0, t0, scr, F.lane); if (v1) cvt_store(c1, t1, scr, F.lane);
    }
}
__device__ __forceinline__ void p0_prologue(Frame& F, const Args& A) {
    const int gw = F.vcu * NWAVES + F.wave, NGW = F.G * NWAVES;
    convert_group<GRP_IN>(F, A, 0, F.vcu, F.G);
    if (blockIdx.x == 0) {
        for (int c = F.tid; c < 1024; c += NTHR) {
            float lg[DEPTH], mx = -INFINITY, den = 0.f;
#pragma unroll
            for (int l = 0; l < DEPTH; ++l) { lg[l] = AIN(A, I_LBLOG)[l * 1024 + c]; mx = fmaxf(mx, lg[l]); }
#pragma unroll
            for (int l = 0; l < DEPTH; ++l) { lg[l] = expf(lg[l] - mx); den += lg[l]; }
            float cum = 0.f;
#pragma unroll
            for (int l = 0; l < DEPTH; ++l) { if (l > 0) cum += lg[l] / den; WSP(float, WS_LB)[l * 1024 + c] = cum; }
        }
    }
    for (int m = gw; m < M; m += NGW) rms_row_to_bf16(F.lane, AIN(A, I_X) + (size_t)m * DM, AIN(A, I_NMPRE), WSP(bf16, WS_H) + (size_t)m * DM);
}

template <bool XIN_F32, bool XOUT_F32>
__device__ __forceinline__ void resnorm_phase(Frame& F, const void* xold, void* xnew, const float* gpost, const float* gnext) {
    const int gw = F.vcu * NWAVES + F.wave, NGW = F.G * NWAVES;
    for (int m = gw; m < M; m += NGW) {
        const GAS v4u* zr = (const GAS v4u*)(WSP(bf16, WS_Z) + (size_t)m * DM) + F.lane;
        float v[8][8]; float s = 0.f;
#pragma unroll
        for (int j = 0; j < 8; ++j) { unpack8(__builtin_nontemporal_load(zr + 64 * j), v[j]);
#pragma unroll
            for (int k = 0; k < 8; ++k) s += v[j][k] * v[j][k]; }
        const float rz = 1.0f / sqrtf(wave_sum(s) * (1.f / DM) + EPS);
        float s2 = 0.f;
#pragma unroll
        for (int j = 0; j < 8; ++j) { float x[8];
            if constexpr (XIN_F32) { const GAS f32x4* xr = (const GAS f32x4*)((const float*)xold + (size_t)m * DM) + 2 * F.lane + 128 * j; const f32x4 a = __builtin_nontemporal_load(xr), b = __builtin_nontemporal_load(xr + 1); x[0] = a.x; x[1] = a.y; x[2] = a.z; x[3] = a.w; x[4] = b.x; x[5] = b.y; x[6] = b.z; x[7] = b.w; }
            else unpack8(__builtin_nontemporal_load((const GAS v4u*)((const bf16*)xold + (size_t)m * DM) + F.lane + 64 * j), x);
            const GAS f32x4* gp = (const GAS f32x4*)gpost + 2 * F.lane + 128 * j; const f32x4 g0 = gp[0], g1 = gp[1];
            const float g[8] = {g0.x, g0.y, g0.z, g0.w, g1.x, g1.y, g1.z, g1.w};
#pragma unroll
            for (int k = 0; k < 8; ++k) { v[j][k] = x[k] + v[j][k] * rz * g[k]; s2 += v[j][k] * v[j][k]; }
            if constexpr (XOUT_F32) { GAS f32x4* orow = (GAS f32x4*)((float*)xnew + (size_t)m * DM) + 2 * F.lane + 128 * j; __builtin_nontemporal_store((f32x4){v[j][0], v[j][1], v[j][2], v[j][3]}, orow); __builtin_nontemporal_store((f32x4){v[j][4], v[j][5], v[j][6], v[j][7]}, orow + 1); }
            else *((GAS v4u*)((bf16*)xnew + (size_t)m * DM) + F.lane + 64 * j) = pack8(v[j]); }
        if (gnext) {
            const float rx = 1.0f / sqrtf(wave_sum(s2) * (1.f / DM) + EPS);
            GAS v4u* ho = (GAS v4u*)(WSP(bf16, WS_H) + (size_t)m * DM) + F.lane; f32x4 ga[4], gb[4];
#pragma unroll
            for (int j = 0; j < 8; ++j) { if ((j & 3) == 0) {
#pragma unroll
                    for (int q = 0; q < 4; ++q) { const GAS f32x4* gn = (const GAS f32x4*)gnext + 2 * F.lane + 128 * (j + q); ga[q] = gn[0]; gb[q] = gn[1]; } }
                const f32x4 g0 = ga[j & 3], g1 = gb[j & 3]; float o[8];
                o[0] = v[j][0] * rx * g0.x; o[1] = v[j][1] * rx * g0.y; o[2] = v[j][2] * rx * g0.z; o[3] = v[j][3] * rx * g0.w; o[4] = v[j][4] * rx * g1.x; o[5] = v[j][5] * rx * g1.y; o[6] = v[j][6] * rx * g1.z; o[7] = v[j][7] * rx * g1.w;
                ho[64 * j] = pack8(o); }
        }
    }
}
template <int W> __device__ __forceinline__ void pool_item(const bf16* p, bf16* o, const int t0) {
    v4u pre[W - 1], cur[16];
#pragma unroll
    for (int i = 1; i < W; ++i) { pre[i - 1] = (v4u){0u, 0u, 0u, 0u}; if (t0 - i >= 0) pre[i - 1] = *(const GAS v4u*)(p - (size_t)i * NPP); }
#pragma unroll
    for (int r = 0; r < 16; ++r) cur[r] = *(const GAS v4u*)(p + (size_t)r * NPP);
    float s[8];
#pragma unroll
    for (int j = 0; j < 8; ++j) s[j] = 0.f;
#pragma unroll
    for (int i = 1; i < W; ++i) { float x[8]; unpack8(pre[i - 1], x);
#pragma unroll
        for (int j = 0; j < 8; ++j) s[j] += x[j]; }
#pragma unroll
    for (int r = 0; r < 16; ++r) { const int t = t0 + r; float c[8], ov[8]; unpack8(cur[r], c);
        const int cnt = (t + 1 < W) ? t + 1 : W; const float inv = 1.0f / (float)cnt;
#pragma unroll
        for (int j = 0; j < 8; ++j) { s[j] += c[j]; ov[j] = s[j] * inv - c[j]; }
        *(GAS v4u*)(o + (size_t)r * 1024) = pack8(ov);
        { float x[8]; unpack8((r - W + 1 >= 0) ? cur[(r - W + 1 >= 0) ? r - W + 1 : 0] : pre[(r - W + 1 >= 0) ? 0 : W - 2 - r], x);
#pragma unroll
          for (int j = 0; j < 8; ++j) s[j] -= x[j]; } }
}
__device__ __forceinline__ void pooled_phase(Frame& F, const int rank, const int nranks) {
    const int gwv = rank * NWAVES + F.wave, NGW = nranks * NWAVES;
    for (int it = gwv; it < (M / 32) * 4; it += NGW) {
        const int g = it & 3, rb = (it >> 2) * 2 + (F.lane >> 5), c8 = g * 256 + (F.lane & 31) * 8;
        const int row0 = rb * 16, t0 = row0 & (SEQ - 1);
        const bf16* p = WSP(bf16, WS_PROJ) + (size_t)row0 * NPP + C_PU + c8; bf16* o = WSP(bf16, WS_POOLED) + (size_t)row0 * 1024 + c8;
        if (g == 0) pool_item<2>(p, o, t0); else if (g == 1) pool_item<4>(p, o, t0); else if (g == 2) pool_item<8>(p, o, t0); else pool_item<16>(p, o, t0);
    }
}
__device__ __forceinline__ void attn_combine_phase(Frame& F, const float* lp, const float* sub, float lambda_init) {
    const float lam = expf(wave_sum(lp[F.lane] * lp[64 + F.lane])) - expf(wave_sum(lp[128 + F.lane] * lp[192 + F.lane])) + lambda_init;
    bf16* yc = WSP(bf16, WS_Y) + (size_t)2 * M * 1024;
    const int gt = F.vcu * NTHR + F.tid, NGT = F.G * NTHR;
    for (int it0 = gt; it0 < M * 8 * 16; it0 += 4 * NGT) {
        v4u qa[4], qb[4];
#pragma unroll
        for (int q = 0; q < 4; ++q) { const int it = it0 + q * NGT; if (it < M * 8 * 16) {
            const int l16 = it & 15, rh = it >> 4, h = rh & 7, row = rh >> 3, j = l16 >> 3, wcol = (l16 & 7) * 8;
            const bf16* o1 = WSP(bf16, WS_ATTO) + (size_t)row * 2048 + (h * 4 + j) * 64 + wcol; qa[q] = *(const GAS v4u*)o1; qb[q] = *(const GAS v4u*)(o1 + 128); } }
#pragma unroll
        for (int q = 0; q < 4; ++q) { const int it = it0 + q * NGT; if (it < M * 8 * 16) {
            const int l16 = it & 15, rh = it >> 4, h = rh & 7, row = rh >> 3;
            float a[8], b[8], d[8]; unpack8(qa[q], a); unpack8(qb[q], b);
            float ss = 0.f;
#pragma unroll
            for (int k = 0; k < 8; ++k) { d[k] = a[k] - lam * b[k]; ss += d[k] * d[k]; }
            ss += xor_lane<1>(ss); ss += xor_lane<2>(ss); ss += xor_lane<4>(ss); ss += xor_lane<8>(ss);
            const float rstd = (1.0f / sqrtf(ss * (1.f / 128.f) + EPS)) * (1.0f - lambda_init);
#pragma unroll
            for (int k = 0; k < 8; ++k) d[k] = d[k] * rstd * sub[l16 * 8 + k];
            *(GAS v4u*)(yc + (size_t)row * 1024 + h * 128 + l16 * 8) = pack8(d); } }
    }
}

__device__ __forceinline__ void hg_gate(float z, float lb, float& logf_, float& k_) {
    z = fminf(fmaxf(z, -30.f), 30.f);
    const float e = __expf(-z), sg = __builtin_amdgcn_rcpf(1.0f + e), om = e * sg;
    logf_ = __logf(lb + (1.0f - lb) * sg); k_ = (1.0f - lb) * om;
}
typedef short hbf16x8 __attribute__((ext_vector_type(8)));
__device__ __forceinline__ unsigned short ldg_u16(const bf16* p) { return *(const GAS unsigned short*)p; }
constexpr int HP = 72, QP = 136;
template <int NT_> struct HgRaw { v4u w[NT_][2]; };
template <int NT_> __device__ __forceinline__ void hg_load(HgRaw<NT_>& R, const bf16* rowbase  , const int (&col)[NT_], int tid) {
#pragma unroll
    for (int i = 0; i < NT_; ++i)
#pragma unroll
        for (int j = 0; j < 2; ++j) { const int vec = tid + NTHR * j; R.w[i][j] = *(const GAS v4u*)(rowbase + (size_t)(vec >> 4) * NPP + col[i] + (vec & 15) * 8); }
}
template <int NT_> __device__ __forceinline__ void hg_put(const HgRaw<NT_>& R, LAS bf16* const (&raw)[NT_], int tid) {
#pragma unroll
    for (int i = 0; i < NT_; ++i)
#pragma unroll
        for (int j = 0; j < 2; ++j) { const int vec = tid + NTHR * j; *(LAS v4u*)(raw[i] + (vec >> 4) * QP + (vec & 15) * 8) = R.w[i][j]; }
}
__device__ __forceinline__ const bf16* hg_rowbase(Frame& F, int u) { const int bh = u >> 5, c = u & 31, b = bh >> 3, h = bh & 7; return WSP(bf16, WS_PROJ) + ((size_t)b * SEQ + c * 64) * NPP + h * 128; }
__device__ __forceinline__ float lds_bf(const LAS bf16* p) { return __uint_as_float((unsigned)(*p) << 16); }
__device__ __forceinline__ void h1_unit(Frame& F, int layer, int u, HgRaw<2>& R, int unext) {
    const int bh = u >> 5, c = u & 31, b = bh >> 3, h = bh & 7; const size_t r0 = (size_t)b * SEQ + c * 64;
    LAS bf16* KDT = (LAS bf16*)(F.lds + RING_OFF); LAS bf16* VT = KDT + 128 * HP; LAS float* TOT = (LAS float*)(F.lds + RING_OFF + 2 * 128 * HP * 2);
    LAS bf16* RF = (LAS bf16*)(F.lds + RING_OFF + 40960); LAS bf16* RV = RF + 64 * QP;
    const int ch = F.tid & 127, sc = F.tid >> 7, g = F.lane >> 4, c16 = F.lane & 15;
    { const int col[2] = {C_HF, C_HV}; LAS bf16* const raw[2] = {RF, RV}; hg_put<2>(R, raw, F.tid); if (unext < 1024) hg_load<2>(R, hg_rowbase(F, unext), col, F.tid); }
    const float lb = WSP(float, WS_LB)[layer * 1024 + h * 128 + ch];
    __syncthreads();
    float bl[16], kq[16]; float run = 0.f;
#pragma unroll
    for (int i = 0; i < 16; ++i) { float lf; hg_gate(lds_bf(RF + (16 * sc + i) * QP + ch), lb, lf, kq[i]); run += lf; bl[i] = run; }
    TOT[sc * 128 + ch] = run;
    { v4u w0, w1; unsigned w[8];
#pragma unroll
      for (int i = 0; i < 8; ++i) w[i] = (unsigned)RV[(16 * sc + 2 * i) * QP + ch] | ((unsigned)RV[(16 * sc + 2 * i + 1) * QP + ch] << 16);
      w0.x = w[0]; w0.y = w[1]; w0.z = w[2]; w0.w = w[3]; w1.x = w[4]; w1.y = w[5]; w1.z = w[6]; w1.w = w[7];
      *(LAS v4u*)(VT + ch * HP + 16 * sc) = w0; *(LAS v4u*)(VT + ch * HP + 16 * sc + 8) = w1; }
    __syncthreads();
    { const float t0 = TOT[ch], t1 = TOT[128 + ch], t2 = TOT[256 + ch], t3 = TOT[384 + ch];
      const float r1 = t0, r2 = t0 + t1, r3 = r2 + t2, tot = r3 + t3, off = (sc == 0) ? 0.f : ((sc == 1) ? r1 : ((sc == 2) ? r2 : r3));
      float kd[16];
#pragma unroll
      for (int i = 0; i < 16; ++i) kd[i] = kq[i] * __expf(tot - (off + bl[i]));
      v4u w0, w1; w0.x = pk2(kd[0], kd[1]); w0.y = pk2(kd[2], kd[3]); w0.z = pk2(kd[4], kd[5]); w0.w = pk2(kd[6], kd[7]); w1.x = pk2(kd[8], kd[9]); w1.y = pk2(kd[10], kd[11]); w1.z = pk2(kd[12], kd[13]); w1.w = pk2(kd[14], kd[15]);
      *(LAS v4u*)(KDT + ch * HP + 16 * sc) = w0; *(LAS v4u*)(KDT + ch * HP + 16 * sc + 8) = w1;
      if (sc == 0) WSP(float, WS_HGD)[(size_t)u * 128 + ch] = __expf(tot); }
    __syncthreads();
    { const int wp = F.wave >> 1, wv = F.wave & 1;
      const int krow = 32 * wp + 8 * (c16 >> 2) + (c16 & 3);
      hbf16x8 a0[2], a1[2];
#pragma unroll
      for (int kt = 0; kt < 2; ++kt) { a0[kt] = *(const LAS hbf16x8*)(KDT + (krow + 4 * kt) * HP + 8 * g); a1[kt] = *(const LAS hbf16x8*)(KDT + (krow + 4 * kt) * HP + 32 + 8 * g); }
      bf16* lt = WSP(bf16, WS_HGL) + (size_t)u * 16384 + 32 * wp + 8 * g;
#pragma unroll
      for (int nn = 0; nn < 4; ++nn) { const int n = 4 * wv + nn;
          const hbf16x8 b0 = *(const LAS hbf16x8*)(VT + (16 * n + c16) * HP + 8 * g), b1 = *(const LAS hbf16x8*)(VT + (16 * n + c16) * HP + 32 + 8 * g);
          f32x4 acc[2];
#pragma unroll
          for (int kt = 0; kt < 2; ++kt) { acc[kt] = (f32x4){0.f, 0.f, 0.f, 0.f};
              acc[kt] = __builtin_amdgcn_mfma_f32_16x16x32_bf16(a0[kt], b0, acc[kt], 0, 0, 0); acc[kt] = __builtin_amdgcn_mfma_f32_16x16x32_bf16(a1[kt], b1, acc[kt], 0, 0, 0); }
          v4u o; o.x = pk2(acc[0][0], acc[0][1]); o.y = pk2(acc[0][2], acc[0][3]); o.z = pk2(acc[1][0], acc[1][1]); o.w = pk2(acc[1][2], acc[1][3]);
          *(GAS v4u*)(lt + (size_t)(16 * n + c16) * 128) = o; } }
    __syncthreads();
}
__device__ __forceinline__ void h2_phase(Frame& F) {
    const int gt = F.vcu * NTHR + F.tid, NGT = F.G * NTHR;
    for (int it = gt; it < 32 * 4096; it += NGT) {
        const int bh = it >> 12, e4 = it & 4095, k4 = e4 & 31;
        f32x4 st = (f32x4){0.f, 0.f, 0.f, 0.f};
        for (int c0 = 0; c0 < 32; c0 += 8) {
            f32x4 d[8]; v2u lw[8];
#pragma unroll
            for (int j = 0; j < 8; ++j) { const size_t u = (size_t)bh * 32 + c0 + j; d[j] = *((const GAS f32x4*)(WSP(float, WS_HGD) + u * 128) + k4); lw[j] = *((const GAS v2u*)(WSP(bf16, WS_HGL) + u * 16384) + e4); }
#pragma unroll
            for (int j = 0; j < 8; ++j) { const size_t u = (size_t)bh * 32 + c0 + j;
                v2u so; so.x = pk2(st[0], st[1]); so.y = pk2(st[2], st[3]);
                *((GAS v2u*)(WSP(bf16, WS_HGS) + u * 16384) + e4) = so;
                st[0] = d[j][0] * st[0] + bflo(lw[j].x); st[1] = d[j][1] * st[1] + bfhi(lw[j].x); st[2] = d[j][2] * st[2] + bflo(lw[j].y); st[3] = d[j][3] * st[3] + bfhi(lw[j].y); } }
    }
}
__device__ __forceinline__ void h3_unit(Frame& F, int layer, int u, const float* hgnorm, HgRaw<3>& R, int unext) {
    const int bh = u >> 5, c = u & 31, b = bh >> 3, h = bh & 7; const size_t r0 = (size_t)b * SEQ + c * 64;
    LAS bf16* QE = (LAS bf16*)(F.lds + RING_OFF); LAS bf16* QI = QE + 64 * QP; LAS bf16* KT = QI + 64 * QP; LAS bf16* VT = KT + 160 * QP; LAS bf16* PM = VT + 128 * HP;
    LAS float* TOT = (LAS float*)(PM + 64 * HP); LAS float* SS = TOT + 512;
    static_assert((2 * 64 * QP + 160 * QP + 128 * HP + 64 * HP) * 2 + 512 * 4 + 128 * 4 <= RING_BYTES, "H3 LDS");
    const int ch = F.tid & 127, sc = F.tid >> 7, g = F.lane >> 4, c16 = F.lane & 15;
    TSEC_BEGIN();
    LAS bf16* RF = KT; LAS bf16* RQ = KT + 64 * QP; LAS bf16* RV = QI;
    { const int col[3] = {C_HF, C_HQ, C_HV}; LAS bf16* const raw[3] = {RF, RQ, RV}; hg_put<3>(R, raw, F.tid); if (unext < 1024) hg_load<3>(R, hg_rowbase(F, unext), col, F.tid); }
    const int tb = F.wave & 3, vh = F.wave >> 2;
    hbf16x8 sfr[4][4];
    const int vrow = 64 * vh + 8 * (c16 >> 2) + (c16 & 3);
    { const bf16* st = WSP(bf16, WS_HGS) + (size_t)u * 16384 + (size_t)vrow * 128 + 8 * g;
#pragma unroll
      for (int ks = 0; ks < 4; ++ks)
#pragma unroll
          for (int n = 0; n < 4; ++n) sfr[ks][n] = *(const GAS hbf16x8*)(st + (size_t)(32 * (n >> 1) + 4 * (n & 1)) * 128 + 32 * ks); }
    const float lb = WSP(float, WS_LB)[layer * 1024 + h * 128 + ch];
    __syncthreads();
    float bl[16], kq[16], q[16]; float run = 0.f;
#pragma unroll
    for (int i = 0; i < 16; ++i) { float lf; hg_gate(lds_bf(RF + (16 * sc + i) * QP + ch), lb, lf, kq[i]); run += lf; bl[i] = run; q[i] = lds_bf(RQ + (16 * sc + i) * QP + ch); }
    TOT[sc * 128 + ch] = run;
    { v4u w0, w1; unsigned w[8];
#pragma unroll
      for (int i = 0; i < 8; ++i) w[i] = (unsigned)RV[(16 * sc + 2 * i) * QP + ch] | ((unsigned)RV[(16 * sc + 2 * i + 1) * QP + ch] << 16);
      w0.x = w[0]; w0.y = w[1]; w0.z = w[2]; w0.w = w[3]; w1.x = w[4]; w1.y = w[5]; w1.z = w[6]; w1.w = w[7];
      *(LAS v4u*)(VT + ch * HP + 16 * sc) = w0; *(LAS v4u*)(VT + ch * HP + 16 * sc + 8) = w1; }
    for (int i = F.tid; i < 64 * HP * 2 / 16; i += NTHR) ((LAS v4u*)PM)[i] = (v4u){0u, 0u, 0u, 0u};
    __syncthreads(); TSEC(1);
    { const float t0 = TOT[ch], t1 = TOT[128 + ch], t2 = TOT[256 + ch];
      float rr[4]; rr[0] = 0.f; rr[1] = t0; rr[2] = t0 + t1; rr[3] = rr[2] + t2;
      const float off = (sc == 0) ? rr[0] : ((sc == 1) ? rr[1] : ((sc == 2) ? rr[2] : rr[3]));
#pragma unroll
      for (int i = 0; i < 16; ++i) { const int t = 16 * sc + i; const float bt = off + bl[i];
          QE[t * QP + ch] = f2bf_hw(q[i] * __expf(bt)); QI[t * QP + ch] = f2bf_hw(q[i] * __expf(bl[i]));
#pragma unroll
          for (int ii = 0; ii < 4; ++ii) if (ii >= sc) KT[(8 * ii * (ii + 1) + t) * QP + ch] = f2bf_hw(kq[i] * __expf(rr[ii] - bt)); } }
    __syncthreads(); TSEC(2);
#pragma unroll
    for (int rep = 0; rep < 2; ++rep) { const int blk = F.wave + 8 * rep;
        if (blk < 10) { const int i = (blk >= 6) ? 3 : ((blk >= 3) ? 2 : ((blk >= 1) ? 1 : 0)), j = blk - (i * (i + 1)) / 2;
            f32x4 acc = (f32x4){0.f, 0.f, 0.f, 0.f};
#pragma unroll
            for (int ks = 0; ks < 4; ++ks) { const hbf16x8 a = *(const LAS hbf16x8*)(QI + (16 * i + c16) * QP + 32 * ks + 8 * g), bb = *(const LAS hbf16x8*)(KT + (8 * i * (i + 1) + 16 * j + c16) * QP + 32 * ks + 8 * g);
                acc = __builtin_amdgcn_mfma_f32_16x16x32_bf16(a, bb, acc, 0, 0, 0); }
#pragma unroll
            for (int r = 0; r < 4; ++r) { const int tl = 4 * g + r; const float val = (i == j && c16 > tl) ? 0.f : acc[r]; PM[(16 * i + tl) * HP + 16 * j + c16] = f2bf_hw(val); } } }
    __syncthreads(); TSEC(3);
    { f32x4 acc[4];
#pragma unroll
      for (int n = 0; n < 4; ++n) acc[n] = (f32x4){0.f, 0.f, 0.f, 0.f};
#pragma unroll
      for (int ks = 0; ks < 4; ++ks) { const hbf16x8 qb_ = *(const LAS hbf16x8*)(QE + (16 * tb + c16) * QP + 32 * ks + 8 * g);
#pragma unroll
          for (int n = 0; n < 4; ++n) acc[n] = __builtin_amdgcn_mfma_f32_16x16x32_bf16(sfr[ks][n], qb_, acc[n], 0, 0, 0); }
      const int nss = (tb >= 2) ? 2 : 1;
      for (int ss = 0; ss < nss; ++ss) { const hbf16x8 pb_ = *(const LAS hbf16x8*)(PM + (16 * tb + c16) * HP + 32 * ss + 8 * g);
#pragma unroll
          for (int n = 0; n < 4; ++n) { const hbf16x8 va_ = *(const LAS hbf16x8*)(VT + (vrow + 32 * (n >> 1) + 4 * (n & 1)) * HP + 32 * ss + 8 * g); acc[n] = __builtin_amdgcn_mfma_f32_16x16x32_bf16(va_, pb_, acc[n], 0, 0, 0); } }
      float s = 0.f;
#pragma unroll
      for (int n = 0; n < 4; ++n) s += (acc[n][0] * acc[n][0] + acc[n][1] * acc[n][1]) + (acc[n][2] * acc[n][2] + acc[n][3] * acc[n][3]);
      s += xor_lane<16>(s); s += xor_lane<32>(s);
      if (g == 0) SS[vh * 64 + 16 * tb + c16] = s;
      __syncthreads(); TSEC(4);
      { const int t = 16 * tb + c16; const float rstd = 1.0f / sqrtf((SS[t] + SS[64 + t]) * (1.f / 128.f) + EPS);
        const bf16* gp = WSP(bf16, WS_PROJ) + (r0 + t) * NPP + C_HG + h * 128 + 64 * vh + 8 * g; bf16* yo = WSP(bf16, WS_Y) + (r0 + t) * 1024 + h * 128 + 64 * vh + 8 * g;
        const float* gn = hgnorm + h * 128 + 64 * vh + 8 * g; v4u gwq[2]; f32x4 gvq[2][2];
#pragma unroll
        for (int p = 0; p < 2; ++p) { gwq[p] = *(const GAS v4u*)(gp + 32 * p); gvq[p][0] = *(const GAS f32x4*)(gn + 32 * p); gvq[p][1] = *(const GAS f32x4*)(gn + 32 * p + 4); }
#pragma unroll
        for (int p = 0; p < 2; ++p) { float z[8], o[8]; unpack8(gwq[p], z);
            const float gq[8] = {gvq[p][0].x, gvq[p][0].y, gvq[p][0].z, gvq[p][0].w, gvq[p][1].x, gvq[p][1].y, gvq[p][1].z, gvq[p][1].w};
#pragma unroll
            for (int k = 0; k < 8; ++k) o[k] = acc[2 * p + (k >> 2)][k & 3] * rstd * gq[k] * (z[k] * sigmoidf_(z[k]));
            *(GAS v4u*)(yo + 32 * p) = pack8(o); } } }
    asm volatile("s_waitcnt vmcnt(0)" ::: "memory"); __syncthreads(); TSEC(5);
}

__device__ __forceinline__ void h1_phase(Frame& F, int layer, int rank, int nranks) {
    int u = rank; if (u >= 1024) return;
    HgRaw<2> R; { const int col[2] = {C_HF, C_HV}; hg_load<2>(R, hg_rowbase(F, u), col, F.tid); }
    for (; u < 1024; u += nranks) h1_unit(F, layer, u, R, u + nranks);
}
__device__ __forceinline__ void h3_phase(Frame& F, int layer, const float* hgnorm, int rank, int nranks) {
    int u = rank; if (u >= 1024) return;
    HgRaw<3> R; { const int col[3] = {C_HF, C_HQ, C_HV}; hg_load<3>(R, hg_rowbase(F, u), col, F.tid); }
    for (; u < 1024; u += nranks) h3_unit(F, layer, u, hgnorm, R, u + nranks);
}

struct SchedPlain {
    pg8::TileOrder T; const char* A; const char* B; size_t ta, tb;
    __device__ __forceinline__ bool next(int i, pg8::Unit& u) const { int pm, pn; if (!T.tile(i, pm, pn)) return false; u.pm = pm; u.pn = pn; u.kind = 0; u.a = A + (size_t)pm * ta; u.b = B + (size_t)pn * tb; return true; }
};
struct SchedUp {
    pg8::TileOrder T; const char* Y; const char* W;
    __device__ __forceinline__ bool next(int i, pg8::Unit& u) const { const int ti = i / 3, br = i - 3 * ti; int pm, pn; if (!T.tile(ti, pm, pn)) return false; u.pm = pm; u.pn = pn; u.kind = br;
        u.a = Y + ((size_t)br * M * 1024 + (size_t)pm * 256 * 1024) * 2; u.b = W + ((size_t)br * DM + (size_t)pn * 256) * 1024 * 2; return true; }
};
struct SchedPool {
    int G, c; const char* A; const char* B;
    __device__ __forceinline__ bool next(int i, pg8::Unit& u) const { const int L = i * G + c; if (L >= 128) return false; u.pm = L >> 2; u.pn = L & 3; u.kind = 0;
        u.a = A + ((size_t)u.pm * 256 * 1024 + (size_t)u.pn * 256) * 2; u.b = B + (size_t)u.pn * 65536 * 2; return true; }
};
struct EpiProj {
    static constexpr int NST = 16;
    static constexpr bool PERM = true; bf16* O; bf16* G;
    __device__ __forceinline__ bool keep(const pg8::Unit&) const { return false; }
    __device__ __forceinline__ void operator()(pg8::f32x4 (&acc)[2][2][4][2], const pg8::Unit& u, int wr, int wc, int fr, int fq) const {
        const float sc = (u.pn < 4) ? QSCALE_HG : ((u.pn >= 20 && u.pn < 24) ? attn_body::C2 : 1.0f);
        const bool gate = u.pn >= 32;
        const int row0 = u.pm * 256 + wr * 64 + fr, col0 = u.pn * 256 + wc * 32 + 8 * fq;
#pragma unroll
        for (int ai = 0; ai < 2; ++ai)
#pragma unroll
            for (int m = 0; m < 4; ++m) { bf16* rowp = O + (size_t)(row0 + ai * 128 + m * 16) * NPP + col0;
#pragma unroll
                for (int bj = 0; bj < 2; ++bj) { pg8::f32x4 v0 = acc[ai][bj][m][0] * sc, v1 = acc[ai][bj][m][1] * sc;
                    if (gate) {
#pragma unroll
                        for (int j = 0; j < 4; ++j) { v0[j] = __builtin_amdgcn_exp2f(fminf(fmaxf(v0[j], -40.f), 40.f) * -1.4426950408889634f); v1[j] = __builtin_amdgcn_exp2f(fminf(fmaxf(v1[j], -40.f), 40.f) * -1.4426950408889634f); } }
                    pg8::u32x4 w; w.x = pg8::cvt_pk_bf16(v0[0], v0[1]); w.y = pg8::cvt_pk_bf16(v0[2], v0[3]); w.z = pg8::cvt_pk_bf16(v1[0], v1[1]); w.w = pg8::cvt_pk_bf16(v1[2], v1[3]);
                    if (gate) { const int k_ = (u.pn - 32) >> 4, po_ = (u.pn - 32) & 15; bf16* gq = G + ((size_t)((k_ * 32 + u.pm) * 16 + po_)) * 65536 + (wr * 4 + wc) * 8192 + (fq * 16 + fr) * 8; __builtin_nontemporal_store(w, (GAS pg8::u32x4*)(gq + ((ai * 4 + m) * 2 + bj) * 512)); } else *(GAS pg8::u32x4*)(rowp + bj * 128) = w; } }
    }
};
struct EpiPool {
    static constexpr int NST = 16;
    static constexpr bool PERM = true; bf16* O; const float* scale;
    __device__ __forceinline__ bool keep(const pg8::Unit&) const { return false; }
    __device__ __forceinline__ void operator()(pg8::f32x4 (&acc)[2][2][4][2], const pg8::Unit& u, int wr, int wc, int fr, int fq) const {
        const int row0 = u.pm * 256 + wr * 64 + fr, col0 = u.pn * 256 + wc * 32 + 8 * fq;
        pg8::f32x4 sv[2][2];
#pragma unroll
        for (int bj = 0; bj < 2; ++bj)
#pragma unroll
            for (int n = 0; n < 2; ++n) sv[bj][n] = *(const GAS pg8::f32x4*)(scale + col0 + bj * 128 + 4 * n);
#pragma unroll
        for (int ai = 0; ai < 2; ++ai)
#pragma unroll
            for (int m = 0; m < 4; ++m) { bf16* rowp = O + (size_t)(row0 + ai * 128 + m * 16) * 1024 + col0;
#pragma unroll
                for (int bj = 0; bj < 2; ++bj) { const pg8::f32x4 v0 = acc[ai][bj][m][0] * sv[bj][0], v1 = acc[ai][bj][m][1] * sv[bj][1];
                    pg8::u32x4 w; w.x = pg8::cvt_pk_bf16(v0[0], v0[1]); w.y = pg8::cvt_pk_bf16(v0[2], v0[3]); w.z = pg8::cvt_pk_bf16(v1[0], v1[1]); w.w = pg8::cvt_pk_bf16(v1[2], v1[3]);
                    *(GAS pg8::u32x4*)(rowp + bj * 128) = w; } }
    }
};
struct EpiUp {
    static constexpr int NST = 0;
    static constexpr bool PERM = true; const bf16* G; bf16* O;
    __device__ __forceinline__ bool keep(const pg8::Unit& u) const { return u.kind < 2; }
    __device__ __forceinline__ void operator()(pg8::f32x4 (&acc)[2][2][4][2], const pg8::Unit& u, int wr, int wc, int fr, int fq) const {
        const int row0 = u.pm * 256 + wr * 64 + fr, col0 = u.pn * 256 + wc * 32 + 8 * fq;
        const bf16* gp = G + ((size_t)((u.kind * 32 + u.pm) * 16 + u.pn)) * 65536 + (wr * 4 + wc) * 8192 + (fq * 16 + fr) * 8;
        if (u.kind < 2) {
#pragma unroll
            for (int ai = 0; ai < 2; ++ai) { v4u qa[8], qb[8];
#pragma unroll
                for (int i = 0; i < 8; ++i) { const int f = (ai * 8 + i) * 512; qa[i] = *(const GAS v4u*)(gp + f); qb[i] = *(const GAS v4u*)(gp + (size_t)32 * 16 * 65536 + f); }
#pragma unroll
                for (int i = 0; i < 8; ++i) { const int m = i >> 1, bj = i & 1; float za[8], zb[8]; unpack8(qa[i], za); unpack8(qb[i], zb);
#pragma unroll
                    for (int j = 0; j < 8; ++j) { const float r = (1.0f + zb[j]) * pg8::fast_rcp(1.0f + za[j]); acc[ai][bj][m][j >> 2][j & 3] *= r; } } }
        } else {
            v4u qc[16];
#pragma unroll
            for (int i = 0; i < 16; ++i) qc[i] = *(const GAS v4u*)(gp + i * 512);
#pragma unroll
            for (int i = 0; i < 16; ++i) { const int ai = i >> 3, m = (i >> 1) & 3, bj = i & 1; bf16* rowp = O + (size_t)(row0 + ai * 128 + m * 16) * DM + col0;
                float zc[8], o[8]; unpack8(qc[i], zc);
#pragma unroll
                for (int j = 0; j < 8; ++j) o[j] = acc[ai][bj][m][j >> 2][j & 3] * pg8::fast_rcp(1.0f + zc[j]);
                pg8::u32x4 w; w.x = pg8::cvt_pk_bf16(o[0], o[1]); w.y = pg8::cvt_pk_bf16(o[2], o[3]); w.z = pg8::cvt_pk_bf16(o[4], o[5]); w.w = pg8::cvt_pk_bf16(o[6], o[7]);
                *(GAS pg8::u32x4*)(rowp + bj * 128) = w; }
        }
    }
};
struct EpiZ {
    static constexpr int NST = 16;
    static constexpr bool PERM = true; bf16* C;
    __device__ __forceinline__ bool keep(const pg8::Unit&) const { return false; }
    __device__ __forceinline__ void operator()(pg8::f32x4 (&acc)[2][2][4][2], const pg8::Unit& u, int wr, int wc, int fr, int fq) const {
        const int row0 = u.pm * 256 + wr * 64 + fr, col0 = u.pn * 256 + wc * 32 + 8 * fq;
#pragma unroll
        for (int ai = 0; ai < 2; ++ai)
#pragma unroll
            for (int m = 0; m < 4; ++m) { bf16* rowp = C + (size_t)(row0 + ai * 128 + m * 16) * DM + col0;
#pragma unroll
                for (int bj = 0; bj < 2; ++bj) { const pg8::f32x4 v0 = acc[ai][bj][m][0], v1 = acc[ai][bj][m][1];
                    pg8::u32x4 w; w.x = pg8::cvt_pk_bf16(v0[0], v0[1]); w.y = pg8::cvt_pk_bf16(v0[2], v0[3]); w.z = pg8::cvt_pk_bf16(v1[0], v1[1]); w.w = pg8::cvt_pk_bf16(v1[2], v1[3]);
                    *(GAS pg8::u32x4*)(rowp + bj * 128) = w; } }
    }
};
struct EpiSwiglu {
    static constexpr int NST = 8;
    static constexpr bool PERM = true; bf16* O;
    __device__ __forceinline__ bool keep(const pg8::Unit&) const { return false; }
    __device__ __forceinline__ void operator()(pg8::f32x4 (&acc)[2][2][4][2], const pg8::Unit& u, int wr, int wc, int fr, int fq) const {
        const int row0 = u.pm * 256 + wr * 64 + fr, col0 = u.pn * 128 + wc * 32 + 8 * fq;
#pragma unroll
        for (int ai = 0; ai < 2; ++ai)
#pragma unroll
            for (int m = 0; m < 4; ++m) { bf16* rowp = O + (size_t)(row0 + ai * 128 + m * 16) * FFN + col0; float o[8];
#pragma unroll
                for (int j = 0; j < 8; ++j) { const float g = acc[ai][0][m][j >> 2][j & 3], up = acc[ai][1][m][j >> 2][j & 3]; o[j] = g * pg8::fast_rcp(1.0f + __expf(-g)) * up; }
                pg8::u32x4 w; w.x = pg8::cvt_pk_bf16(o[0], o[1]); w.y = pg8::cvt_pk_bf16(o[2], o[3]); w.z = pg8::cvt_pk_bf16(o[4], o[5]); w.w = pg8::cvt_pk_bf16(o[6], o[7]);
                *(GAS pg8::u32x4*)rowp = w; }
    }
};

#ifndef PH_ENABLE
#define PH_ENABLE 0xffff
#endif
#define PHE(b) ((PH_ENABLE >> (b)) & 1)
#ifndef PH_REPEAT
#define PH_REPEAT 0x0
#endif
#define PHR(b) ((PH_REPEAT >> (b)) & 1)
#ifndef TPROBE
#define TPROBE 0x0
#endif
#define TPROBE_FACTOR 4
#ifndef TSPREAD
#define TSPREAD 0x0
#endif
#define RUN(b, ...) do { if constexpr (PHE(b)) { __VA_ARGS__; } if constexpr (PHR(b)) { __syncthreads(); __VA_ARGS__; } } while (0)
#define IN(k) (lo <= (k) && (k) < hi)
#define PHASE_ENTER() do { int t_ = threadIdx.x, b_ = blockIdx.x, g_ = gridDim.x; unsigned char* w_ = args.ws; asm volatile("" : "+v"(t_), "+s"(w_), "+s"(b_), "+s"(g_)); F.tid = t_; F.lane = t_ & 63; F.wave = __builtin_amdgcn_readfirstlane(t_ >> 6); F.ws = w_; \
        bid = b_; F.G = g_; F.vcu = (g_ % 8 == 0) ? (b_ % 8) * (g_ / 8) + b_ / 8 : b_; } while (0)
#define INP(i) ({ int i_ = (i); asm volatile("" : "+s"(i_)); args.in[i_]; })
#define SEAM(k) do { if (N_LAUNCHES == 1 && IN(k) && IN((k) + 1)) { \
        if constexpr (((TSPREAD >> (k)) & 1) != 0) { if (threadIdx.x == 0) { const unsigned n_ = (unsigned)__builtin_amdgcn_s_memrealtime(); unsigned* c_ = (unsigned*)(args.ws + WS_CTL) + 8192 + 128 * (k); atomicMax(c_, n_); atomicMax(c_ + 64, ~n_); } } \
        XcdBarrier b_ = bar; unsigned* p_ = bar.bar; asm volatile("" : "+s"(p_)); b_.bar = p_; xcd_barrier(b_); if constexpr (PHR(15)) xcd_barrier(b_); } \
        if constexpr (((TSPREAD >> (k)) & 1) != 0) { unsigned* c_ = (unsigned*)(args.ws + WS_CTL) + 8192 + 128 * (k); const unsigned mx_ = __hip_atomic_load(c_, __ATOMIC_RELAXED, __HIP_MEMORY_SCOPE_AGENT), mn_ = ~__hip_atomic_load(c_ + 64, __ATOMIC_RELAXED, __HIP_MEMORY_SCOPE_AGENT); tp_acc += (unsigned long long)(mx_ - mn_); } \
        if constexpr (TPROBE != 0) { const unsigned long long now_ = __builtin_amdgcn_s_memrealtime(); if ((TPROBE >> (k)) & 1) tp_acc += now_ - tp_prev; tp_prev = now_; } } while (0)
template <int l> __device__ __forceinline__ void layer_program(Frame& F, const Args& args, const XcdBarrier& bar, const int lo, const int hi, unsigned char* lds, unsigned long long& tp_prev, unsigned long long& tp_acc) {
    int bid = (int)blockIdx.x;
        const int pb = 1 + PH_PER_LAYER * l;
        const float lambda_init = (l == 0) ? 0.2f : 0.35550906759f;
        if (IN(pb + 0)) { PHASE_ENTER();
            SchedPlain S; S.T.init(M / 256, NCOL / 256, F.G, bid); S.A = (const char*)WSP(bf16, WS_H); S.B = (const char*)(WSP(bf16, WS_WIN) + (size_t)l * NCOL * DM); S.ta = (size_t)256 * DM * 2; S.tb = (size_t)256 * DM * 2;
            EpiProj E{WSP(bf16, WS_PROJ), WSP(bf16, WS_GATE)};
            RUN(1, pg8::gemm_phase<EpiProj, SchedPlain, true, true>(F.lds + RING_OFF, DM, DM, DM, S, E));
            SEAM(pb + 0);
        }
        if (IN(pb + 1)) { PHASE_ENTER();
            const attn_body::AttnTensors AT{(const attn_body::bf16*)(WSP(bf16, WS_PROJ) + C_DQ), (const attn_body::bf16*)(WSP(bf16, WS_PROJ) + C_DK), (const attn_body::bf16*)(WSP(bf16, WS_PROJ) + C_DV), (attn_body::bf16*)WSP(bf16, WS_ATTO)};
            const attn_body::StaticOrder S((int)F.G, F.vcu);
            TSEC_BEGIN();
            const bool conv_first = ((F.vcu & 1) == 0);
            if (conv_first) { RUN(11, convert_group_deep<GRP_MIX>(F, args, l, F.vcu, F.G)); RUN(11, convert_group_deep<GRP_FFN>(F, args, l, F.vcu, F.G)); __syncthreads(); }
            RUN(2, attn_body::attn_phase<attn_body::StaticOrder>((char*)lds + RING_OFF, AT, S));
            __syncthreads(); TSEC(11);
            RUN(3, h1_phase(F, l, F.vcu, F.G); TSEC(12); pooled_phase(F, F.vcu, F.G); asm volatile("s_waitcnt vmcnt(0)" ::: "memory"); TSEC(13));
            if (!conv_first) { __syncthreads(); RUN(11, convert_group_deep<GRP_MIX>(F, args, l, F.vcu, F.G)); RUN(11, convert_group_deep<GRP_FFN>(F, args, l, F.vcu, F.G)); }
            SEAM(pb + 1);
        }
        if (IN(pb + 2)) { PHASE_ENTER();
            RUN(4, h2_phase(F); attn_combine_phase(F, INP(I_LAMBDA) + l * 256, INP(I_SUBLN) + l * 128, lambda_init));
            SchedPool S; S.G = F.G; S.c = bid; S.A = (const char*)WSP(bf16, WS_POOLED); S.B = (const char*)(WSP(bf16, WS_POOLW) + (size_t)l * 4 * 65536);
            EpiPool E{WSP(bf16, WS_Y) + (size_t)M * 1024, INP(I_POOLSC) + l * 1024};
            RUN(4, pg8::gemm_phase<EpiPool, SchedPool, true, true>(F.lds + RING_OFF, 256, 1024, 256, S, E));
            SEAM(pb + 2);
        }
        if (IN(pb + 3)) { PHASE_ENTER();
            RUN(5, h3_phase(F, l, INP(I_HGNORM) + l * 1024, F.vcu, F.G));
            SEAM(pb + 3);
        }
        if (IN(pb + 4)) { PHASE_ENTER();
            SchedUp S; S.T.init(M / 256, DM / 256, F.G, bid); S.Y = (const char*)WSP(bf16, WS_Y); S.W = (const char*)(WSP(bf16, WS_WUP) + (size_t)l * 3 * DM * 1024);
            EpiUp E{WSP(bf16, WS_GATE), WSP(bf16, WS_MERGED)};
            RUN(6, pg8::gemm_phase<EpiUp, SchedUp, true, true>(F.lds + RING_OFF, 1024, 1024, 1024, S, E));
            SEAM(pb + 4);
        }
        if (IN(pb + 5)) { PHASE_ENTER();
            SchedPlain S; S.T.init(M / 256, DM / 256, F.G, bid); S.A = (const char*)WSP(bf16, WS_MERGED); S.B = (const char*)(WSP(bf16, WS_WOUT) + (size_t)l * DM * DM); S.ta = (size_t)256 * DM * 2; S.tb = (size_t)256 * DM * 2;
            EpiZ E{WSP(bf16, WS_Z)};
            RUN(7, pg8::gemm_phase<EpiZ, SchedPlain, true, true>(F.lds + RING_OFF, DM, DM, DM, S, E));
            SEAM(pb + 5);
        }
        if (IN(pb + 6)) { PHASE_ENTER();
            if constexpr (l == 0) RUN(8, resnorm_phase<true, false>(F, INP(I_X), WSP(bf16, WS_XB), INP(I_NMPOST) + l * DM, INP(I_NFPRE) + l * DM));
            else RUN(8, resnorm_phase<false, false>(F, WSP(bf16, WS_XC), WSP(bf16, WS_XB), INP(I_NMPOST) + l * DM, INP(I_NFPRE) + l * DM));
            SEAM(pb + 6);
        }
        if (IN(pb + 7)) { PHASE_ENTER();
            SchedPlain S; S.T.init(M / 256, NGU / 256, F.G, bid); S.A = (const char*)WSP(bf16, WS_H); S.B = (const char*)(WSP(bf16, WS_WGU) + (size_t)l * NGU * DM); S.ta = (size_t)256 * DM * 2; S.tb = (size_t)256 * DM * 2;
            EpiSwiglu E{WSP(bf16, WS_PROJ)};
            RUN(9, pg8::gemm_phase<EpiSwiglu, SchedPlain, true, true>(F.lds + RING_OFF, DM, DM, DM, S, E));
            {
              const int full = (M / 256) * (NGU / 256) / F.G, rem = (M / 256) * (NGU / 256) - full * F.G, nidle = F.G - rem;
              if (rem == 0 || nidle < 32) { RUN(11, convert_group<GRP_DN>(F, args, l, F.vcu, F.G)); }
              else if (bid >= rem) { __syncthreads(); RUN(11, convert_group<GRP_DN>(F, args, l, bid - rem, nidle)); } }
            SEAM(pb + 7);
        }
        if (IN(pb + 8)) { PHASE_ENTER();
            SchedPlain S; S.T.init(M / 256, DM / 256, F.G, bid); S.A = (const char*)WSP(bf16, WS_PROJ); S.B = (const char*)(WSP(bf16, WS_WDN) + (size_t)l * DM * FFN); S.ta = (size_t)256 * FFN * 2; S.tb = (size_t)256 * FFN * 2;
            EpiZ E{WSP(bf16, WS_Z)};
            RUN(10, pg8::gemm_phase<EpiZ, SchedPlain, true, true>(F.lds + RING_OFF, FFN, FFN, FFN, S, E));
            SEAM(pb + 8);
        }
        if (IN(pb + 9)) { PHASE_ENTER();
            if constexpr (l + 1 < DEPTH) { RUN(11, convert_group<GRP_IN>(F, args, l + 1, F.vcu, F.G)); }
            if constexpr (l + 1 < DEPTH) RUN(8, resnorm_phase<false, false>(F, WSP(bf16, WS_XB), WSP(bf16, WS_XC), INP(I_NFPOST) + l * DM, INP(I_NMPRE) + (l + 1) * DM));
            else RUN(8, resnorm_phase<false, true>(F, WSP(bf16, WS_XB), args.out, INP(I_NFPOST) + l * DM, (const float*)nullptr));
            SEAM(pb + 9);
        }
    }
__global__ void __launch_bounds__(NTHR, 2) trunk_fwd(Args args) {
    extern __shared__ __attribute__((aligned(16))) unsigned char lds[];
    Frame F;
    F.lds = (LAS unsigned char*)lds;
    F.MISC = (volatile LAS unsigned*)(F.lds + MISC_OFF);
    F.tid = threadIdx.x; F.lane = F.tid & 63; F.wave = __builtin_amdgcn_readfirstlane(F.tid >> 6);
    F.G = gridDim.x; { const int bx = blockIdx.x; F.vcu = (F.G % 8 == 0) ? (bx % 8) * (F.G / 8) + bx / 8 : bx; }
    F.ws = args.ws; F.out = args.out;
    gu32* const ctl = (gu32*)(args.ws + WS_CTL);
    for (int u = F.tid; u < (LDS_BYTES - LDSCTL_OFF) / 4; u += NTHR) ((LAS unsigned*)(F.lds + LDSCTL_OFF))[u] = 0u;
    __syncthreads();
    XcdBarrier bar; bar.bar = (unsigned*)(ctl + CW_BAR); bar.x = 0; bar.st = nullptr;
    if (N_LAUNCHES == 1) bar = xcd_barrier_post((unsigned*)(ctl + CW_BAR), F.MISC + 8);
    const int lo = args.ph_lo, hi = args.ph_hi;
    int bid = (int)blockIdx.x;
    unsigned long long tp_prev = (TPROBE != 0) ? __builtin_amdgcn_s_memrealtime() : 0ull, tp_acc = 0ull;
    F.tsec_acc = 0ull; F.tsec_prev = 0ull;

    if (IN(0)) { PHASE_ENTER(); RUN(0, p0_prologue(F, args)); SEAM(0); }

    layer_program<0>(F, args, bar, lo, hi, lds, tp_prev, tp_acc);
    layer_program<1>(F, args, bar, lo, hi, lds, tp_prev, tp_acc);
    if constexpr (HSEC != 0) tp_acc += F.tsec_acc;
    if constexpr (TPROBE != 0 || TSPREAD != 0 || HSEC != 0) {
        const unsigned long long now_ = __builtin_amdgcn_s_memrealtime(); if ((TPROBE >> (NPHASES - 1)) & 1) tp_acc += now_ - tp_prev;
        if (blockIdx.x == 0) { const unsigned long long t0_ = __builtin_amdgcn_s_memrealtime(); while (__builtin_amdgcn_s_memrealtime() - t0_ < tp_acc * TPROBE_FACTOR) __builtin_amdgcn_s_sleep(8); } }
#undef IN
#undef SEAM
#undef PHASE_ENTER
#undef INP
}

extern "C" void kernel_launch(void* const* d_in, const int* in_sizes, int n_in, void* d_out, int out_size, void* d_ws, size_t ws_size, hipStream_t stream) {
    static int grid = 0;
    if (grid == 0) {
        if (n_in != 19 || in_sizes[0] != M * DM || out_size != M * DM || ws_size < WS_END) { fprintf(stderr, "kernel_launch: built for 19 inputs, x and out of %d floats, >= %zu bytes of workspace; got n_in %d, in0 %d, out %d, ws %zu; nothing launched\n", M * DM, (size_t)WS_END, n_in, n_in > 0 ? in_sizes[0] : -1, out_size, ws_size); grid = -1; return; }
        int dev = 0, cus = 0, per_cu = 0;
        if (hipGetDevice(&dev) != hipSuccess || hipDeviceGetAttribute(&cus, hipDeviceAttributeMultiprocessorCount, dev) != hipSuccess) { fprintf(stderr, "kernel_launch: hipGetDevice / hipDeviceGetAttribute failed; nothing launched\n"); grid = -1; return; }
        if (hipFuncSetAttribute((const void*)trunk_fwd, hipFuncAttributeMaxDynamicSharedMemorySize, LDS_BYTES) != hipSuccess) { fprintf(stderr, "kernel_launch: hipFuncSetAttribute failed; nothing launched\n"); grid = -1; return; }
        if (hipOccupancyMaxActiveBlocksPerMultiprocessor(&per_cu, (const void*)trunk_fwd, NTHR, LDS_BYTES) != hipSuccess || per_cu < 1)
            fprintf(stderr, "kernel_launch: note: the occupancy query reports %d workgroups per CU\n", per_cu);
        (void)hipGetLastError();
        grid = cus;
        if (grid != 256) fprintf(stderr, "kernel_launch: %d CUs; the attention unit order is built for 256\n", grid);
    }
    if (grid < 0) return;
    if (hipMemsetAsync((char*)d_ws + WS_CTL, 0, CTL_ZERO_BYTES, stream) != hipSuccess) { fprintf(stderr, "kernel_launch: hipMemsetAsync of the control words failed; nothing launched\n"); return; }
    Args a{};
    for (int i = 0; i < 19; ++i) a.in[i] = (const float*)d_in[i];
    a.out = (float*)d_out; a.ws = (unsigned char*)d_ws;
    for (int li = 0; li < N_LAUNCHES; ++li) {
        a.ph_lo = (N_LAUNCHES == 1) ? 0 : li; a.ph_hi = (N_LAUNCHES == 1) ? NPHASES : li + 1;
        hipLaunchKernelGGL(trunk_fwd, dim3(grid), dim3(NTHR), LDS_BYTES, stream, a);
        const hipError_t le = hipPeekAtLastError();
        if (le != hipSuccess) { fprintf(stderr, "kernel_launch: launch %d failed: %s\n", li, hipGetErrorName(le)); break; }
    }
}
```
